# Optimizing an MI355X kernel written in HIP

```python
import math
import jax, jax.numpy as jnp
from jax import lax
import numpy as np

D_MODEL = 1024
BATCH = 2
SEQ = 8192
DEPTH = 2

CTX_LEN = 256
GRID_W = 64
EPS = 1e-6
BRANCH = D_MODEL // 4
D_MIX = 4 * BRANCH
CONV_W = 4
GLA_HEADS = 4
GLA_DK = BRANCH // 8
GLA_DV = BRANCH // GLA_HEADS
GLA_GATE_RANK = 16
GLA_GATE_TAU = 16.0
GLA_CHUNK = 64
LRU_BLOCKS = 4
LRU_BLOCK_W = BRANCH // LRU_BLOCKS
LRU_C = 8.0
DIFF_HEADS = 4
DIFF_DV = BRANCH // DIFF_HEADS
DIFF_D = DIFF_DV // 2
Q_BLOCK = 128
ROPE_BASE = 10000.0
SSD_HEADS = 4
SSD_P = BRANCH // SSD_HEADS
SSD_GROUPS = 2
SSD_N = 64
SSD_CHUNK = 64
SSD_CONV_DIM = SSD_HEADS * SSD_P + 2 * SSD_GROUPS * SSD_N
GLA_SIZES = (GLA_HEADS * GLA_DK, GLA_HEADS * GLA_DK, GLA_HEADS * GLA_DV, GLA_GATE_RANK, GLA_GATE_RANK, BRANCH)
LRU_SIZES = (BRANCH, BRANCH)
DIFF_SIZES = (DIFF_HEADS * 2 * DIFF_D, DIFF_HEADS * 2 * DIFF_D, DIFF_HEADS * DIFF_DV, BRANCH)
SSD_SIZES = (SSD_CONV_DIM, SSD_HEADS, SSD_HEADS, BRANCH)
GROUP_SIZES = (sum(GLA_SIZES), sum(LRU_SIZES), sum(DIFF_SIZES), sum(SSD_SIZES))
D_IN = sum(GROUP_SIZES)

kernel_name = 'hybrid_gla_rglru_diffattn_ssd_block'


def split_sizes(u, sizes):
    idx = []
    acc = 0
    for s in sizes[:-1]:
        acc += s
        idx.append(acc)
    return jnp.split(u, idx, axis=-1)


def rmsnorm(x, w):
    xf = x.astype(jnp.float32)
    y = xf * lax.rsqrt(jnp.mean(xf * xf, axis=-1, keepdims=True) + EPS)
    return (y * w.astype(jnp.float32)).astype(x.dtype)


def dwconv(x, w, b):
    t = x.shape[1]
    left = CONV_W // 2
    xp = jnp.pad(x, ((0, 0), (left, CONV_W - 1 - left), (0, 0)))
    y = b + xp[:, 0:t] * w[0]
    for j in range(1, CONV_W):
        y = y + xp[:, j:j + t] * w[j]
    return y


def chunk_state_scan(decay, upd, s0):
    def step(s, inp):
        d, u = inp
        return d * s + u, s
    s_fin, s_in = lax.scan(step, s0, (decay, upd))
    return s_in, s_fin


def gla_chunked(q, k, v, log_a, s0):
    b, t, h, _ = q.shape
    n = t // GLA_CHUNK
    r = lambda a: a.reshape(b, n, GLA_CHUNK, h, a.shape[-1])
    q, k, v, log_a = r(q), r(k), r(v), r(log_a)
    g = jnp.cumsum(log_a.astype(jnp.float32), axis=2)
    g_last = g[:, :, -1:]
    qg = q * jnp.exp(g)
    kg = k * jnp.exp(-g)
    kd = k * jnp.exp(g_last - g)
    mask = jnp.tril(jnp.ones((GLA_CHUNK, GLA_CHUNK), dtype=bool))
    att = jnp.where(mask, jnp.einsum('bnihk,bnjhk->bnhij', qg, kg), 0.0)
    o = jnp.einsum('bnhij,bnjhv->bnihv', att, v)
    upd = jnp.einsum('bnjhk,bnjhv->nbhkv', kd, v)
    decay = jnp.exp(g_last[:, :, 0]).transpose(1, 0, 2, 3)[..., None]
    s_in, s_fin = chunk_state_scan(decay, upd, s0)
    o = o + jnp.einsum('bnihk,nbhkv->bnihv', qg, s_in)
    return o.reshape(b, t, h, -1), s_fin


def gla_dir(q, k, v, lr, w2, b2, s0, reverse):
    log_a = jax.nn.log_sigmoid((lr @ w2 + b2).astype(jnp.float32)) / GLA_GATE_TAU
    log_a = log_a.reshape(k.shape)
    if reverse:
        q, k, v, log_a = (jnp.flip(a, axis=1) for a in (q, k, v, log_a))
    o, s = gla_chunked(q, k, v, log_a, s0)
    if reverse:
        o = jnp.flip(o, axis=1)
    return o, s


def gla_mixer(u_ctx, u_lat, w2, b2, norm_w, with_ctx_out):
    def prep(u):
        b, t, _ = u.shape
        q, k, v, lr_f, lr_b, g = split_sizes(u, GLA_SIZES)
        q = q.reshape(b, t, GLA_HEADS, GLA_DK) * (GLA_DK ** -0.5)
        k = k.reshape(b, t, GLA_HEADS, GLA_DK)
        v = v.reshape(b, t, GLA_HEADS, GLA_DV)
        return q, k, v, lr_f, lr_b, g
    qc, kc, vc, lcf, lcb, gc = prep(u_ctx)
    ql, kl, vl, llf, llb, gl = prep(u_lat)
    s0 = jnp.zeros((u_ctx.shape[0], GLA_HEADS, GLA_DK, GLA_DV), jnp.float32)
    ocf, scf = gla_dir(qc, kc, vc, lcf, w2[0], b2[0], s0, False)
    ocb, scb = gla_dir(qc, kc, vc, lcb, w2[1], b2[1], s0, True)
    olf, _ = gla_dir(ql, kl, vl, llf, w2[0], b2[0], scf, False)
    olb, _ = gla_dir(ql, kl, vl, llb, w2[1], b2[1], scb, True)

    def finish(o, g):
        b, t = g.shape[:2]
        y = rmsnorm(o, norm_w).reshape(b, t, BRANCH) * jax.nn.silu(g)
        return y.astype(g.dtype)
    yc = finish(ocf + ocb, gc) if with_ctx_out else None
    return yc, finish(olf + olb, gl)


def lru_combine(e1, e2):
    a1, u1 = e1
    a2, u2 = e2
    return a1 * a2, a2 * u1 + u2


def rglru_dir(x, w_a, b_a, w_x, b_x, lam, h0, reverse):
    b, t, _ = x.shape
    xb = x.reshape(b, t, LRU_BLOCKS, LRU_BLOCK_W)
    r = jax.nn.sigmoid(jnp.einsum('btgi,gij->btgj', xb, w_a).reshape(b, t, BRANCH) + b_a)
    i = jax.nn.sigmoid(jnp.einsum('btgi,gij->btgj', xb, w_x).reshape(b, t, BRANCH) + b_x)
    log_a = -LRU_C * r.astype(jnp.float32) * jax.nn.softplus(-lam.astype(jnp.float32))
    a = jnp.exp(log_a)
    u = jnp.sqrt(-jnp.expm1(2.0 * log_a)) * (i * x).astype(jnp.float32)
    if reverse:
        a, u = jnp.flip(a, axis=1), jnp.flip(u, axis=1)
    u = u.at[:, 0].add(a[:, 0] * h0)
    _, h = lax.associative_scan(lru_combine, (a, u), axis=1)
    h_last = h[:, -1]
    if reverse:
        h = jnp.flip(h, axis=1)
    return h, h_last


def rglru_mixer(u_ctx, u_lat, conv_w, conv_b, w_a, b_a, w_x, b_x, lam, with_ctx_out):
    xc, gc = split_sizes(u_ctx, LRU_SIZES)
    xl, gl = split_sizes(u_lat, LRU_SIZES)
    xc = dwconv(xc, conv_w, conv_b)
    xl = dwconv(xl, conv_w, conv_b)
    h0 = jnp.zeros((xc.shape[0], BRANCH), jnp.float32)
    hcf, scf = rglru_dir(xc, w_a[0], b_a[0], w_x[0], b_x[0], lam[0], h0, False)
    hcb, scb = rglru_dir(xc, w_a[1], b_a[1], w_x[1], b_x[1], lam[1], h0, True)
    hlf, _ = rglru_dir(xl, w_a[0], b_a[0], w_x[0], b_x[0], lam[0], scf, False)
    hlb, _ = rglru_dir(xl, w_a[1], b_a[1], w_x[1], b_x[1], lam[1], scb, True)
    yl = ((hlf + hlb) * jax.nn.silu(gl)).astype(gl.dtype)
    yc = ((hcf + hcb) * jax.nn.silu(gc)).astype(gc.dtype) if with_ctx_out else None
    return yc, yl


def axial_rope_tables(rows):
    n_freq = DIFF_D // 4
    inv = ROPE_BASE ** (-jnp.arange(n_freq, dtype=jnp.float32) / n_freq)
    tpos = jnp.arange(rows * GRID_W)
    pos_r = (tpos // GRID_W).astype(jnp.float32)
    pos_c = (tpos % GRID_W).astype(jnp.float32)
    ang_r = pos_r[:, None] * inv
    ang_c = pos_c[:, None] * inv
    ang = jnp.concatenate([ang_r, ang_r, ang_c, ang_c], axis=-1)
    return jnp.cos(ang), jnp.sin(ang)


def rotate_half_axial(x):
    h = DIFF_D // 4
    xr = x.reshape(x.shape[:-1] + (2, 2, h))
    return jnp.concatenate([-xr[..., 1:2, :], xr[..., 0:1, :]], axis=-2).reshape(x.shape)


def apply_rope(x, cos, sin):
    cs = cos[:, None, None, :]
    sn = sin[:, None, None, :]
    return (x * cs + rotate_half_axial(x) * sn).astype(x.dtype)


def diff_attend(q, k, v, lam):
    s = jnp.einsum('bqhcd,bkhcd->bhcqk', q, k).astype(jnp.float32) * (DIFF_D ** -0.5)
    p = jax.nn.softmax(s, axis=-1)
    w = p[:, :, 0] - lam * p[:, :, 1]
    return jnp.einsum('bhqk,bkhv->bqhv', w.astype(v.dtype), v)


def diff_attn_mixer(u_ctx, u_lat, lam_vecs, subln_w, cos, sin, lam_init, with_ctx_out):
    def prep(u):
        b, t, _ = u.shape
        q, k, v, g = split_sizes(u, DIFF_SIZES)
        return (q.reshape(b, t, DIFF_HEADS, 2, DIFF_D), k.reshape(b, t, DIFF_HEADS, 2, DIFF_D),
                v.reshape(b, t, DIFF_HEADS, DIFF_DV), g)
    qc, kc, vc, gc = prep(u_ctx)
    ql, kl, vl, gl = prep(u_lat)
    lv = lam_vecs.astype(jnp.float32)
    lam = jnp.exp(jnp.sum(lv[0] * lv[1])) - jnp.exp(jnp.sum(lv[2] * lv[3])) + lam_init
    ql = apply_rope(ql, cos, sin)
    kl = apply_rope(kl, cos, sin)
    k_all = jnp.concatenate([kl, kc.astype(kl.dtype)], axis=1)
    v_all = jnp.concatenate([vl, vc.astype(vl.dtype)], axis=1)
    b, t = u_lat.shape[:2]
    nb = t // Q_BLOCK
    qb = jnp.moveaxis(ql.reshape(b, nb, Q_BLOCK, DIFF_HEADS, 2, DIFF_D), 1, 0)
    ol = lax.map(lambda qq: diff_attend(qq, k_all, v_all, lam), qb)
    ol = jnp.moveaxis(ol, 0, 1).reshape(b, t, DIFF_HEADS, DIFF_DV)

    def finish(o, g):
        bb, tt = g.shape[:2]
        y = (rmsnorm(o, subln_w) * (1.0 - lam_init)).reshape(bb, tt, BRANCH) * jax.nn.silu(g)
        return y.astype(g.dtype)
    yc = finish(diff_attend(qc, kc, vc, lam), gc) if with_ctx_out else None
    return yc, finish(ol, gl)


def ssd_chunked(x, dt, a, bm, cm, s0):
    b, t, h, p = x.shape
    n = t // SSD_CHUNK
    x = x.reshape(b, n, SSD_CHUNK, h, p)
    dt = dt.reshape(b, n, SSD_CHUNK, h)
    bm = bm.reshape(b, n, SSD_CHUNK, h, -1)
    cm = cm.reshape(b, n, SSD_CHUNK, h, -1)
    cum = jnp.cumsum(dt * a, axis=2)
    seg = cum[:, :, :, None, :] - cum[:, :, None, :, :]
    mask = jnp.tril(jnp.ones((SSD_CHUNK, SSD_CHUNK), dtype=bool))[:, :, None]
    decay_ls = jnp.exp(jnp.where(mask, seg, -jnp.inf))
    cb = jnp.einsum('bclhn,bcshn->bclsh', cm, bm)
    y = jnp.einsum('bclsh,bcsh,bcshp->bclhp', cb * decay_ls, dt, x)
    w_state = jnp.exp(cum[:, :, -1:] - cum) * dt
    upd = jnp.einsum('bcshn,bcsh,bcshp->cbhpn', bm, w_state, x)
    decay = jnp.exp(cum[:, :, -1]).transpose(1, 0, 2)[..., None, None]
    s_in, s_fin = chunk_state_scan(decay, upd, s0)
    y = y + jnp.einsum('bclhn,cbhpn,bclh->bclhp', cm, s_in, jnp.exp(cum))
    return y.reshape(b, t, h, p), s_fin


def ssd_dir(x, dt_raw, dt_bias, a_log, bm, cm, s0, reverse):
    dt = jax.nn.softplus(dt_raw.astype(jnp.float32) + dt_bias.astype(jnp.float32))
    a = -jnp.exp(a_log.astype(jnp.float32))
    if reverse:
        x, dt, bm, cm = (jnp.flip(z, axis=1) for z in (x, dt, bm, cm))
    y, s = ssd_chunked(x, dt, a, bm, cm, s0)
    if reverse:
        y = jnp.flip(y, axis=1)
    return y, s


def ssd_mixer(u_ctx, u_lat, conv_w, conv_b, dt_bias, a_log, d_skip, norm_w, with_ctx_out):
    rep = SSD_HEADS // SSD_GROUPS

    def prep(u):
        b, t, _ = u.shape
        xbc, dt_f, dt_b, z = split_sizes(u, SSD_SIZES)
        xbc = jax.nn.silu(dwconv(xbc, conv_w, conv_b))
        xs, bm, cm = split_sizes(xbc, (SSD_HEADS * SSD_P, SSD_GROUPS * SSD_N, SSD_GROUPS * SSD_N))
        xs = xs.reshape(b, t, SSD_HEADS, SSD_P)
        bm = jnp.repeat(bm.reshape(b, t, SSD_GROUPS, SSD_N), rep, axis=2)
        cm = jnp.repeat(cm.reshape(b, t, SSD_GROUPS, SSD_N), rep, axis=2)
        return xs, bm, cm, dt_f, dt_b, z
    xc, bc, cc, dcf, dcb, zc = prep(u_ctx)
    xl, bl, cl, dlf, dlb, zl = prep(u_lat)
    s0 = jnp.zeros((u_ctx.shape[0], SSD_HEADS, SSD_P, SSD_N), jnp.float32)
    ycf, scf = ssd_dir(xc, dcf, dt_bias[0], a_log[0], bc, cc, s0, False)
    ycb, scb = ssd_dir(xc, dcb, dt_bias[1], a_log[1], bc, cc, s0, True)
    ylf, _ = ssd_dir(xl, dlf, dt_bias[0], a_log[0], bl, cl, scf, False)
    ylb, _ = ssd_dir(xl, dlb, dt_bias[1], a_log[1], bl, cl, scb, True)

    def finish(yf, yb, xs, z):
        b, t = z.shape[:2]
        y = (yf + yb + d_skip[:, None] * xs).reshape(b, t, BRANCH)
        return rmsnorm(y.astype(z.dtype) * jax.nn.silu(z), norm_w)
    yc = finish(ycf, ycb, xc, zc) if with_ctx_out else None
    return yc, finish(ylf, ylb, xl, zl)


def setup_inputs(seed: int = 0) -> dict:
    key = jax.random.key(seed)
    ks = iter(jax.random.split(key, 40))
    f32 = jnp.float32

    def nrm(shape, scale):
        return jax.random.normal(next(ks), shape, f32) * scale

    L = DEPTH
    D = D_MODEL
    x = nrm((BATCH, SEQ, D), 1.0)
    c = nrm((BATCH, D), 1.0)
    ctx = nrm((BATCH, CTX_LEN, D), 1.0)
    c_ctx = nrm((D,), 1.0)
    w_mod = nrm((L, D, 3 * D), 0.3 * D ** -0.5)
    b_mod = nrm((L, 3 * D), 0.02)
    norm_w = 1.0 + nrm((L, D), 0.02)
    w_in = nrm((L, D, D_IN), D ** -0.5)
    w_out = nrm((L, D_MIX, D), D_MIX ** -0.5)
    gla_w2 = nrm((L, 2, GLA_GATE_RANK, GLA_HEADS * GLA_DK), GLA_GATE_RANK ** -0.5)
    gla_b2 = nrm((L, 2, GLA_HEADS * GLA_DK), 0.1)
    gla_norm_w = 1.0 + nrm((L, GLA_DV), 0.02)
    lru_conv_w = nrm((L, CONV_W, BRANCH), 0.5)
    lru_conv_b = nrm((L, BRANCH), 0.02)
    lru_wa = nrm((L, 2, LRU_BLOCKS, LRU_BLOCK_W, LRU_BLOCK_W), LRU_BLOCK_W ** -0.5)
    lru_ba = nrm((L, 2, BRANCH), 0.02)
    lru_wx = nrm((L, 2, LRU_BLOCKS, LRU_BLOCK_W, LRU_BLOCK_W), LRU_BLOCK_W ** -0.5)
    lru_bx = nrm((L, 2, BRANCH), 0.02)
    a_init = jax.random.uniform(next(ks), (L, 2, BRANCH), f32, 0.9, 0.999)
    lru_lam = jnp.log(a_init) - jnp.log1p(-a_init)
    diff_lam = nrm((L, 4, DIFF_D), 0.1)
    diff_subln_w = 1.0 + nrm((L, DIFF_DV), 0.02)
    ssd_conv_w = nrm((L, CONV_W, SSD_CONV_DIM), 0.5)
    ssd_conv_b = nrm((L, SSD_CONV_DIM), 0.02)
    dt0 = jnp.exp(jax.random.uniform(next(ks), (L, 2, SSD_HEADS), f32, math.log(1e-3), math.log(1e-1)))
    ssd_dt_bias = dt0 + jnp.log(-jnp.expm1(-dt0))
    ssd_a_log = jnp.log(jax.random.uniform(next(ks), (L, 2, SSD_HEADS), f32, 1.0, 16.0))
    ssd_d = 1.0 + nrm((L, SSD_HEADS), 0.1)
    ssd_norm_w = 1.0 + nrm((L, BRANCH), 0.02)
    final_norm_w = 1.0 + nrm((D,), 0.02)
    return {'x': x, 'c': c, 'ctx': ctx, 'c_ctx': c_ctx, 'w_mod': w_mod, 'b_mod': b_mod, 'norm_w': norm_w,
            'w_in': w_in, 'w_out': w_out, 'gla_w2': gla_w2, 'gla_b2': gla_b2, 'gla_norm_w': gla_norm_w,
            'lru_conv_w': lru_conv_w, 'lru_conv_b': lru_conv_b, 'lru_wa': lru_wa, 'lru_ba': lru_ba,
            'lru_wx': lru_wx, 'lru_bx': lru_bx, 'lru_lam': lru_lam, 'diff_lam': diff_lam,
            'diff_subln_w': diff_subln_w, 'ssd_conv_w': ssd_conv_w, 'ssd_conv_b': ssd_conv_b,
            'ssd_dt_bias': ssd_dt_bias, 'ssd_a_log': ssd_a_log, 'ssd_d': ssd_d, 'ssd_norm_w': ssd_norm_w,
            'final_norm_w': final_norm_w}


def reference(x, c, ctx, c_ctx, w_mod, b_mod, norm_w, w_in, w_out, gla_w2, gla_b2, gla_norm_w,
              lru_conv_w, lru_conv_b, lru_wa, lru_ba, lru_wx, lru_bx, lru_lam, diff_lam, diff_subln_w,
              ssd_conv_w, ssd_conv_b, ssd_dt_bias, ssd_a_log, ssd_d, ssd_norm_w, final_norm_w):
    rows = x.shape[1] // GRID_W
    cos, sin = axial_rope_tables(rows)
    h_lat, h_ctx = x, ctx
    silu_c = jax.nn.silu(c)
    silu_cc = jax.nn.silu(c_ctx)
    for l in range(DEPTH):
        last = l == DEPTH - 1
        lam_init = 0.8 - 0.6 * math.exp(-0.3 * l)
        mod_lat = (silu_c @ w_mod[l] + b_mod[l])[:, None, :]
        mod_ctx = silu_cc @ w_mod[l] + b_mod[l]
        shift_l, scale_l, gate_l = jnp.split(mod_lat, 3, axis=-1)
        shift_c, scale_c, gate_c = jnp.split(mod_ctx, 3, axis=-1)
        u_lat = (rmsnorm(h_lat, norm_w[l]) * (1.0 + scale_l) + shift_l) @ w_in[l]
        u_ctx = (rmsnorm(h_ctx, norm_w[l]) * (1.0 + scale_c) + shift_c) @ w_in[l]
        ga_c, gb_c, gc_c, gd_c = split_sizes(u_ctx, GROUP_SIZES)
        ga_l, gb_l, gc_l, gd_l = split_sizes(u_lat, GROUP_SIZES)
        ya_c, ya_l = gla_mixer(ga_c, ga_l, gla_w2[l], gla_b2[l], gla_norm_w[l], not last)
        yb_c, yb_l = rglru_mixer(gb_c, gb_l, lru_conv_w[l], lru_conv_b[l], lru_wa[l], lru_ba[l],
                                 lru_wx[l], lru_bx[l], lru_lam[l], not last)
        yc_c, yc_l = diff_attn_mixer(gc_c, gc_l, diff_lam[l], diff_subln_w[l], cos, sin, lam_init, not last)
        yd_c, yd_l = ssd_mixer(gd_c, gd_l, ssd_conv_w[l], ssd_conv_b[l], ssd_dt_bias[l], ssd_a_log[l],
                               ssd_d[l], ssd_norm_w[l], not last)
        y_lat = jnp.concatenate([ya_l, yb_l, yc_l, yd_l], axis=-1) @ w_out[l]
        h_lat = h_lat + gate_l * y_lat
        if not last:
            y_ctx = jnp.concatenate([ya_c, yb_c, yc_c, yd_c], axis=-1) @ w_out[l]
            h_ctx = h_ctx + gate_c * y_ctx
    return rmsnorm(h_lat, final_norm_w)
```

```cpp
#include <hip/hip_runtime.h>
#include <hip/hip_cooperative_groups.h>
#include <cstdio>
namespace cg = cooperative_groups;

#define DI __device__ __forceinline__
typedef unsigned short u16;
typedef __attribute__((ext_vector_type(8))) short bf16x8;
typedef __attribute__((ext_vector_type(16))) float f32x16;
typedef __attribute__((ext_vector_type(4))) unsigned u32x4;
typedef __bf16 bf2_t __attribute__((ext_vector_type(2)));
typedef float fl2_t __attribute__((ext_vector_type(2)));

#define MARK(n) asm volatile("; MARK " #n)
#define MFMA32(a, b, c) __builtin_amdgcn_mfma_f32_32x32x16_bf16((a), (b), (c), 0, 0, 0)

constexpr int T = 8192, D = 1024, UP = 3200, MLAT = 16384, MTOT = 16896, NKEY = 8448, NCH = 132;
constexpr int UA_Q = 0, UA_K = 128, UA_V = 256, UA_LRF = 512, UA_G = 544;
constexpr int UB_X = 800, UB_G = 1056;
constexpr int UC_Q = 1312, UC_K = 1568, UC_V = 1824, UC_G = 2080;
constexpr int UD_XBC = 2336, UD_DTF = 2848, UD_Z = 2856;
constexpr int NTHREADS = 512;
constexpr int LDS_BYTES = 147456;

constexpr size_t WS_WINT = 0;
constexpr size_t WS_WOUT = WS_WINT + (size_t)2 * UP * 1024 * 2;
constexpr size_t WS_MOD = WS_WOUT + (size_t)2 * 1024 * 1024 * 2;
constexpr size_t WS_ROPE = WS_MOD + (size_t)2 * 3 * 3072 * 4;
constexpr size_t WS_MISC = WS_ROPE + 8192;
constexpr size_t WS_XN = WS_MISC + 4096;
constexpr size_t WS_U = WS_XN + (size_t)MTOT * 1024 * 2;
constexpr size_t WS_HCTX = WS_U + (size_t)MTOT * UP * 2;
constexpr size_t WS_Q = WS_HCTX + (size_t)512 * 1024 * 4;
constexpr size_t WS_K = WS_Q + (size_t)16 * NKEY * 32 * 2;
constexpr size_t WS_VT = WS_K + (size_t)16 * NKEY * 32 * 2;
constexpr size_t WS_GLA = WS_VT + (size_t)8 * 64 * NKEY * 2;
constexpr size_t WS_GLAD = WS_GLA + (size_t)16 * NCH * 2048 * 4;
constexpr size_t WS_SSD = WS_GLAD + (size_t)16 * NCH * 32 * 4;
constexpr size_t WS_SSDD = WS_SSD + (size_t)16 * NCH * 4096 * 4;
constexpr size_t WS_LRUA = WS_SSDD + 16384;
constexpr size_t WS_LRUU = WS_LRUA + (size_t)4 * NCH * 256 * 4;
constexpr size_t WS_BAR = WS_LRUU + (size_t)4 * NCH * 256 * 4;
constexpr size_t WS_LRUW = WS_BAR + 16384;
constexpr size_t WS_END = WS_LRUW + (size_t)64 * 4096 * 2;
static_assert(WS_END <= (size_t)256 * 1024 * 1024, "workspace");

#define GAS __attribute__((address_space(1)))
struct Params {
  const GAS float *x, *c, *ctx, *c_ctx, *w_mod, *b_mod, *norm_w, *w_in, *w_out, *gla_w2, *gla_b2, *gla_norm_w, *lru_conv_w, *lru_conv_b,
      *lru_wa, *lru_ba, *lru_wx, *lru_bx, *lru_lam, *diff_lam, *diff_subln_w, *ssd_conv_w, *ssd_conv_b, *ssd_dt_bias, *ssd_a_log, *ssd_d,
      *ssd_norm_w, *final_norm_w;
  GAS float* out;
  GAS unsigned char* ws;
};

DI unsigned pk2(float a, float b) { fl2_t v = {a, b}; return __builtin_bit_cast(unsigned, __builtin_convertvector(v, bf2_t)); }
DI u16 f2bf(float a) { return (u16)(pk2(a, 0.f) & 0xffffu); }
DI float bf2f(u16 x) { return __uint_as_float(((unsigned)x) << 16); }
DI float bflo(unsigned x) { return __uint_as_float(x << 16); }
DI float bfhi(unsigned x) { return __uint_as_float(x & 0xffff0000u); }
DI bf16x8 mk8(unsigned a, unsigned b, unsigned c, unsigned d) { u32x4 v = {a, b, c, d}; return __builtin_bit_cast(bf16x8, v); }
DI bf16x8 pack8(float a0, float a1, float a2, float a3, float a4, float a5, float a6, float a7) { return mk8(pk2(a0, a1), pk2(a2, a3), pk2(a4, a5), pk2(a6, a7)); }
template <class T> DI T* gp(GAS T* p) { return (T*)p; }
DI int tidx() { int t = threadIdx.x; asm volatile("" : "+v"(t)); return t; }
DI int crow(int r, int hh) { return (r & 3) + 8 * (r >> 2) + 4 * hh; }
DI float siluf(float x) { return x * __builtin_amdgcn_rcpf(1.f + __expf(-x)); }
DI float sigmf(float x) { return __builtin_amdgcn_rcpf(1.f + __expf(-x)); }
DI float softplusf(float x) { return fmaxf(x, 0.f) + __logf(1.f + __expf(-fabsf(x))); }
DI float shx(float v, int m) { return __shfl_xor(v, m, 64); }
DI int blk_m0(int b, int cb) { return cb < 4 ? MLAT + b * 256 + cb * 64 : b * T + (cb - 4) * 64; }
DI int blk_ci(int cb, int dir) { return dir == 0 ? cb : (cb < 4 ? 3 - cb : 135 - cb); }

DI void p0_transpose(const float* src, int N, u16* dst, int k0, int n0, float* lds) {
  const int tid = tidx();
  float v[8];
#pragma unroll
  for (int i = 0; i < 8; ++i) { const int e = tid + i * NTHREADS, kk = e >> 6, n = n0 + (e & 63); v[i] = (n < N) ? src[(size_t)(k0 + kk) * N + n] : 0.f; }
#pragma unroll
  for (int i = 0; i < 8; ++i) { const int e = tid + i * NTHREADS; lds[(e >> 6) * 65 + (e & 63)] = v[i]; }
  __syncthreads();
#pragma unroll
  for (int e = tid; e < 2048; e += NTHREADS) { int nn = e >> 5, kp = (e & 31) * 2; *(unsigned*)(dst + (size_t)(n0 + nn) * 1024 + k0 + kp) = pk2(lds[kp * 65 + nn], lds[(kp + 1) * 65 + nn]); }
  __syncthreads();
}

DI void p0_mod(const Params& P, int l, int n0, float* lds) {
  const int tid = tidx(), col = tid & 63, kg = tid >> 6;
  for (int e = tid; e < 1024; e += NTHREADS) { lds[e] = siluf(P.c[e]); lds[1024 + e] = siluf(P.c[1024 + e]); lds[2048 + e] = siluf(P.c_ctx[e]); }
  __syncthreads();
  float a0 = 0.f, a1 = 0.f, a2 = 0.f;
  const float* wm = gp(P.w_mod + (size_t)l * 1024 * 3072 + n0 + col);
  for (int k0 = kg * 128; k0 < kg * 128 + 128; k0 += 16) {
    float w[16];
#pragma unroll
    for (int j = 0; j < 16; ++j) w[j] = wm[(size_t)(k0 + j) * 3072];
#pragma unroll
    for (int j = 0; j < 16; ++j) { a0 += lds[k0 + j] * w[j]; a1 += lds[1024 + k0 + j] * w[j]; a2 += lds[2048 + k0 + j] * w[j]; }
  }
  float* red = lds + 3072;
  red[(kg * 3 + 0) * 64 + col] = a0; red[(kg * 3 + 1) * 64 + col] = a1; red[(kg * 3 + 2) * 64 + col] = a2;
  __syncthreads();
  if (tid < 192) {
    int j = tid >> 6; float sacc = P.b_mod[l * 3072 + n0 + col];
    for (int g = 0; g < 8; ++g) sacc += red[(g * 3 + j) * 64 + col];
    ((float*)(P.ws + WS_MOD))[(l * 3 + j) * 3072 + n0 + col] = sacc;
  }
  __syncthreads();
}

DI void phase_p0(const Params& P, char* lds) {
  float* fl = (float*)lds;
  for (int t0 = blockIdx.x; t0 < 2273; t0 += gridDim.x) {
    if (t0 >= 2209) {
      const int mid = t0 - 2209, gate = mid & 1, ldg = mid >> 1, tid = tidx();
      const float* wsrc = gp((gate ? P.lru_wx : P.lru_wa) + (size_t)ldg * 4096);
      const int lane = tid & 63, ct = (tid >> 6) & 1, ks = tid >> 7, c31 = lane & 31, hh = lane >> 5;
      float v[8];
#pragma unroll
      for (int e = 0; e < 8; ++e) v[e] = wsrc[(ks * 16 + hh * 8 + e) * 64 + ct * 32 + c31];
      uint4 o; o.x = pk2(v[0], v[1]); o.y = pk2(v[2], v[3]); o.z = pk2(v[4], v[5]); o.w = pk2(v[6], v[7]);
      *(uint4*)((u16*)(P.ws + WS_LRUW) + (size_t)mid * 4096 + tid * 8) = o;
      continue;
    }
    const int t = t0 < 96 ? 2112 + t0 : (t0 < 2208 ? t0 - 96 : t0);
    if (t < 1600) { int l = t / 800, rem = t % 800; p0_transpose(gp(P.w_in + (size_t)l * 1024 * 3112), 3112, (u16*)(P.ws + WS_WINT) + (size_t)l * UP * 1024, (rem & 15) * 64, (rem >> 4) * 64, fl); }
    else if (t < 2112) { int t2 = t - 1600; int l = t2 >> 8, rem = t2 & 255; p0_transpose(gp(P.w_out + (size_t)l * 1024 * 1024), 1024, (u16*)(P.ws + WS_WOUT) + (size_t)l * 1024 * 1024, (rem & 15) * 64, (rem >> 4) * 64, fl); }
    else if (t < 2208) { int t2 = t - 2112; p0_mod(P, t2 / 48, (t2 % 48) * 64, fl); }
    else {
      float* rope = (float*)(P.ws + WS_ROPE);
      const int tid = tidx();
      for (int e = tid; e < 1024; e += NTHREADS) { int pos = e >> 3, f = e & 7; float inv = exp2f(-(float)f * (13.287712379549449f / 8.f)); float ang = (float)pos * inv; rope[e] = __cosf(ang); rope[1024 + e] = __sinf(ang); }
      if (tid < 64) ((unsigned*)(P.ws + WS_MISC))[tid] = 0u;
    }
  }
}

DI const float* h_row(const Params& P, int l, int m) {
  if (l == 0) return gp(m < MLAT ? P.x + (size_t)m * 1024 : P.ctx + (size_t)(m - MLAT) * 1024);
  return m < MLAT ? (const float*)(P.out + (size_t)m * 1024) : (const float*)(P.ws + WS_HCTX) + (size_t)(m - MLAT) * 1024;
}

DI void phase_norm(const Params& P, int l) {
  const int tid_ = tidx(); const int w = tid_ >> 6, lane = tid_ & 63;
  u16* xn = (u16*)(P.ws + WS_XN);
  for (int row = blockIdx.x * 8 + w; row < MTOT; row += gridDim.x * 8) {
    const float4* src = (const float4*)h_row(P, l, row);
    const int j = row < MLAT ? (row >> 13) : 2;
    const float* mod = (const float*)(P.ws + WS_MOD) + (l * 3 + j) * 3072;
    float4 v[4]; float ss = 0.f;
#pragma unroll
    for (int i = 0; i < 4; ++i) { v[i] = src[i * 64 + lane]; ss += v[i].x * v[i].x + v[i].y * v[i].y + v[i].z * v[i].z + v[i].w * v[i].w; }
#pragma unroll
    for (int s = 32; s >= 1; s >>= 1) ss += shx(ss, s);
    const float rstd = rsqrtf(ss * (1.f / 1024.f) + 1e-6f);
#pragma unroll
    for (int i = 0; i < 4; ++i) {
      const int k = (i * 64 + lane) * 4;
      float4 nw = *(const float4*)(P.norm_w + l * 1024 + k), sc = *(const float4*)(mod + 1024 + k), sh = *(const float4*)(mod + k);
      float y0 = v[i].x * rstd * nw.x * (1.f + sc.x) + sh.x, y1 = v[i].y * rstd * nw.y * (1.f + sc.y) + sh.y;
      float y2 = v[i].z * rstd * nw.z * (1.f + sc.z) + sh.z, y3 = v[i].w * rstd * nw.w * (1.f + sc.w) + sh.w;
      uint2 o; o.x = pk2(y0, y1); o.y = pk2(y2, y3);
      *(uint2*)(xn + (size_t)row * 1024 + k) = o;
    }
  }
}

DI void phase_final_norm(const Params& P) {
  const int tid_ = tidx(); const int w = tid_ >> 6, lane = tid_ & 63;
  for (int row = blockIdx.x * 8 + w; row < MLAT; row += gridDim.x * 8) {
    float4* src = (float4*)(P.out + (size_t)row * 1024);
    float4 v[4]; float ss = 0.f;
#pragma unroll
    for (int i = 0; i < 4; ++i) { v[i] = src[i * 64 + lane]; ss += v[i].x * v[i].x + v[i].y * v[i].y + v[i].z * v[i].z + v[i].w * v[i].w; }
#pragma unroll
    for (int s = 32; s >= 1; s >>= 1) ss += shx(ss, s);
    const float rstd = rsqrtf(ss * (1.f / 1024.f) + 1e-6f);
#pragma unroll
    for (int i = 0; i < 4; ++i) {
      float4 nw = *(const float4*)(P.final_norm_w + (i * 64 + lane) * 4);
      float4 o; o.x = v[i].x * rstd * nw.x; o.y = v[i].y * rstd * nw.y; o.z = v[i].z * rstd * nw.z; o.w = v[i].w * rstd * nw.w;
      src[i * 64 + lane] = o;
    }
  }
}

constexpr int GS = 72;
template <int EPI>
DI void gemm_phase(const Params& P, int l, const u16* A, const u16* Bt, int mtiles, int ntiles, char* lds) {
  const int tid = tidx(), w = tid >> 6, lane = tid & 63, c31 = lane & 31, hh = lane >> 5, wm = w >> 1, wn = w & 1;
  const int lrow = tid >> 3, lcol = (tid & 7) * 8;
  const int ntot = mtiles * ntiles;
  const bool swz = (gridDim.x == 256);
  const int xcd = blockIdx.x & 7, jloc = blockIdx.x >> 3;
  const int per = (ntot + 7) >> 3, qbeg = xcd * per, qend = min(ntot, qbeg + per);
  for (int it = 0;; ++it) {
    int tm, tn;
    if (swz) {
      const int q = qbeg + jloc + 32 * it;
      if (q >= qend) break;
      const int band = q / (4 * ntiles), within = q - band * 4 * ntiles;
      const int rows = min(4, mtiles - band * 4);
      tn = within / rows; tm = band * 4 + (within - tn * rows);
    } else {
      const int tile = blockIdx.x + it * gridDim.x;
      if (tile >= ntot) break;
      tm = tile / ntiles; tn = tile % ntiles;
    }
    const int m0 = tm * 256, n0 = tn * 128;
    f32x16 acc[2][2];
#pragma unroll
    for (int i = 0; i < 2; ++i)
#pragma unroll
      for (int j = 0; j < 2; ++j)
#pragma unroll
        for (int r = 0; r < 16; ++r) acc[i][j][r] = 0.f;
    const u16* ga = A + (size_t)(m0 + lrow) * 1024 + lcol;
    const u16* gb = Bt + (size_t)(n0 + lrow) * 1024 + lcol;
    uint4 ra0, ra1, ra2, ra3, rb0, rb1, rc0, rc1, rc2, rc3, rd0, rd1;
#define G_LOAD(A0, A1, A2, A3, B0, B1, ko) { A0 = *(const uint4*)(ga + (ko)); A1 = *(const uint4*)(ga + (size_t)64 * 1024 + (ko)); A2 = *(const uint4*)(ga + (size_t)128 * 1024 + (ko)); A3 = *(const uint4*)(ga + (size_t)192 * 1024 + (ko)); \
      B0 = *(const uint4*)(gb + (ko)); B1 = *(const uint4*)(gb + (size_t)64 * 1024 + (ko)); }
#define G_STORE(A0, A1, A2, A3, B0, B1, buf) { u16* nA = (u16*)(lds + (buf) * 55296); u16* nB = (u16*)(lds + (buf) * 55296 + 36864); \
      *(uint4*)(nA + (lrow) * GS + lcol) = A0; *(uint4*)(nA + (lrow + 64) * GS + lcol) = A1; *(uint4*)(nA + (lrow + 128) * GS + lcol) = A2; *(uint4*)(nA + (lrow + 192) * GS + lcol) = A3; \
      *(uint4*)(nB + (lrow) * GS + lcol) = B0; *(uint4*)(nB + (lrow + 64) * GS + lcol) = B1; }
#define G_READ(buf) { const u16* sA = (const u16*)(lds + (buf) * 55296); const u16* sB = (const u16*)(lds + (buf) * 55296 + 36864); \
      _Pragma("unroll") for (int ks = 0; ks < 4; ++ks) { \
        af[ks][0] = *(const bf16x8*)(sA + (wm * 64 + c31) * GS + ks * 16 + hh * 8); af[ks][1] = *(const bf16x8*)(sA + (wm * 64 + 32 + c31) * GS + ks * 16 + hh * 8); \
        bfr[ks][0] = *(const bf16x8*)(sB + (wn * 64 + c31) * GS + ks * 16 + hh * 8); bfr[ks][1] = *(const bf16x8*)(sB + (wn * 64 + 32 + c31) * GS + ks * 16 + hh * 8); } \
      __builtin_amdgcn_sched_barrier(0); }
#define G_MMA() { __builtin_amdgcn_sched_barrier(0); \
      _Pragma("unroll") for (int ks = 0; ks < 4; ++ks) { \
        acc[0][0] = MFMA32(af[ks][0], bfr[ks][0], acc[0][0]); acc[0][1] = MFMA32(af[ks][0], bfr[ks][1], acc[0][1]); \
        acc[1][0] = MFMA32(af[ks][1], bfr[ks][0], acc[1][0]); acc[1][1] = MFMA32(af[ks][1], bfr[ks][1], acc[1][1]); } \
      __builtin_amdgcn_sched_barrier(0); }
    bf16x8 af[4][2], bfr[4][2];
#define S0 ra0, ra1, ra2, ra3, rb0, rb1
#define S1 rc0, rc1, rc2, rc3, rd0, rd1
#define GX(M, ...) M(__VA_ARGS__)
#define TK(t) (min((t), 15) * 64)
    if (w < 4) {
      GX(G_LOAD, S0, 0); GX(G_LOAD, S1, 64);
      GX(G_STORE, S0, 0); GX(G_STORE, S1, 1);
      GX(G_LOAD, S0, 128); GX(G_LOAD, S1, 192);
      __syncthreads();
      G_READ(0);
#pragma unroll 1
      for (int kt = 0; kt < 16; kt += 2) {
        G_MMA();
        __syncthreads();
        G_READ(1);
        if (kt + 2 < 16) GX(G_STORE, S0, 0);
        GX(G_LOAD, S0, TK(kt + 4));
        __syncthreads();
        G_MMA();
        __syncthreads();
        if (kt + 2 < 16) { G_READ(0); }
        if (kt + 3 < 16) GX(G_STORE, S1, 1);
        GX(G_LOAD, S1, TK(kt + 5));
        __syncthreads();
      }
    } else {
      GX(G_LOAD, S0, 0);
      GX(G_STORE, S0, 0);
      GX(G_LOAD, S1, 64); GX(G_LOAD, S0, 128);
      __syncthreads();
#pragma unroll 1
      for (int kt = 0; kt < 16; kt += 2) {
        G_READ(0);
        GX(G_STORE, S1, 1);
        GX(G_LOAD, S1, TK(kt + 3));
        __syncthreads();
        G_MMA();
        __syncthreads();
        G_READ(1);
        if (kt + 2 < 16) GX(G_STORE, S0, 0);
        GX(G_LOAD, S0, TK(kt + 4));
        __syncthreads();
        G_MMA();
        __syncthreads();
      }
    }
#undef GX
#undef S0
#undef S1
#undef TK
#undef G_READ
#undef G_MMA
#undef G_LOAD
#undef G_STORE
#undef G_COMPUTE
    if (EPI == 0) {
      u16* st = (u16*)(lds + 55296 + w * 9216);
#pragma unroll
      for (int i = 0; i < 2; ++i)
#pragma unroll
        for (int j = 0; j < 2; ++j)
#pragma unroll
          for (int r = 0; r < 16; ++r) st[(i * 32 + crow(r, hh)) * 72 + j * 32 + c31] = f2bf(acc[i][j][r]);
      u16* U = (u16*)(P.ws + WS_U) + (size_t)(m0 + wm * 64) * UP + n0 + wn * 64;
#pragma unroll
      for (int q = 0; q < 8; ++q) {
        const int idx = q * 64 + lane, row = idx >> 3, part = idx & 7;
        *(uint4*)(U + (size_t)row * UP + part * 8) = *(const uint4*)(st + row * 72 + part * 8);
      }
      __syncthreads();
    } else {
      float* st = (float*)(lds + w * 17408);
#pragma unroll
      for (int i = 0; i < 2; ++i)
#pragma unroll
        for (int j = 0; j < 2; ++j)
#pragma unroll
          for (int r = 0; r < 16; ++r) st[(i * 32 + crow(r, hh)) * 68 + j * 32 + c31] = acc[i][j][r];
      const int mrow0 = m0 + wm * 64, ncol = n0 + wn * 64 + (lane & 15) * 4;
      const int jm = mrow0 < MLAT ? (mrow0 >> 13) : 2;
      const float4 gate = *(const float4*)((const float*)(P.ws + WS_MOD) + (l * 3 + jm) * 3072 + 2048 + ncol);
#pragma unroll
      for (int half = 0; half < 2; ++half) {
        float4 hv[8];
#pragma unroll
        for (int q = 0; q < 8; ++q) { const int row = (half * 8 + q) * 4 + (lane >> 4); hv[q] = *(const float4*)(h_row(P, l, mrow0 + row) + ncol); }
#pragma unroll
        for (int q = 0; q < 8; ++q) {
          const int row = (half * 8 + q) * 4 + (lane >> 4), m = mrow0 + row;
          const float4 a = *(const float4*)(st + row * 68 + (lane & 15) * 4);
          float4 o; o.x = hv[q].x + gate.x * a.x; o.y = hv[q].y + gate.y * a.y; o.z = hv[q].z + gate.z * a.z; o.w = hv[q].w + gate.w * a.w;
          float* dst = m < MLAT ? (float*)(P.out + (size_t)m * 1024 + ncol) : (float*)(P.ws + WS_HCTX) + (size_t)(m - MLAT) * 1024 + ncol;
          *(float4*)dst = o;
        }
      }
      __syncthreads();
    }
  }
}

DI void attn_prep(const Params& P, int l, int unit, char* lds) {
  const int tid = tidx(); const int gid = unit * NTHREADS + tid;
  const int m = gid >> 3, h = (gid >> 1) & 3, c = gid & 1;
  const u16* urow = (const u16*)(P.ws + WS_U) + (size_t)m * UP;
  float q[32], k[32];
  {
    const uint4* qs = (const uint4*)(urow + UC_Q + h * 64 + c * 32); const uint4* ks = (const uint4*)(urow + UC_K + h * 64 + c * 32);
#pragma unroll
    for (int i = 0; i < 4; ++i) {
      uint4 a = qs[i], b = ks[i];
      q[i * 8 + 0] = bflo(a.x); q[i * 8 + 1] = bfhi(a.x); q[i * 8 + 2] = bflo(a.y); q[i * 8 + 3] = bfhi(a.y); q[i * 8 + 4] = bflo(a.z); q[i * 8 + 5] = bfhi(a.z); q[i * 8 + 6] = bflo(a.w); q[i * 8 + 7] = bfhi(a.w);
      k[i * 8 + 0] = bflo(b.x); k[i * 8 + 1] = bfhi(b.x); k[i * 8 + 2] = bflo(b.y); k[i * 8 + 3] = bfhi(b.y); k[i * 8 + 4] = bflo(b.z); k[i * 8 + 5] = bfhi(b.z); k[i * 8 + 6] = bflo(b.w); k[i * 8 + 7] = bfhi(b.w);
    }
  }
  const bool lat = m < MLAT;
  const int b = lat ? (m >> 13) : ((m - MLAT) >> 8), t = lat ? (m & 8191) : ((m - MLAT) & 255);
  if (lat) {
    const float* rc = (const float*)(P.ws + WS_ROPE); const float* rs = rc + 1024;
#pragma unroll
    for (int a = 0; a < 2; ++a) {
      const int pos = a ? (t & 63) : (t >> 6);
#pragma unroll
      for (int f = 0; f < 8; ++f) {
        const float cs = rc[pos * 8 + f], sn = rs[pos * 8 + f];
        float x0 = q[a * 16 + f], x1 = q[a * 16 + 8 + f]; q[a * 16 + f] = x0 * cs - x1 * sn; q[a * 16 + 8 + f] = x1 * cs + x0 * sn;
        x0 = k[a * 16 + f]; x1 = k[a * 16 + 8 + f]; k[a * 16 + f] = x0 * cs - x1 * sn; k[a * 16 + 8 + f] = x1 * cs + x0 * sn;
      }
    }
  }
  const int pos = lat ? t : 8192 + t;
  const float QS = 0.17677669529663687f * 1.4426950408889634f;
  float k2 = 0.f;
  u16* qd = (u16*)(P.ws + WS_Q) + ((size_t)((b * 4 + h) * 2 + c) * NKEY + pos) * 32;
  u16* kd = (u16*)(P.ws + WS_K) + ((size_t)((b * 4 + h) * 2 + c) * NKEY + pos) * 32;
#pragma unroll
  for (int i = 0; i < 4; ++i) {
    uint4 a, bb;
    a.x = pk2(q[i * 8 + 0] * QS, q[i * 8 + 1] * QS); a.y = pk2(q[i * 8 + 2] * QS, q[i * 8 + 3] * QS); a.z = pk2(q[i * 8 + 4] * QS, q[i * 8 + 5] * QS); a.w = pk2(q[i * 8 + 6] * QS, q[i * 8 + 7] * QS);
    bb.x = pk2(k[i * 8 + 0], k[i * 8 + 1]); bb.y = pk2(k[i * 8 + 2], k[i * 8 + 3]); bb.z = pk2(k[i * 8 + 4], k[i * 8 + 5]); bb.w = pk2(k[i * 8 + 6], k[i * 8 + 7]);
    ((uint4*)qd)[i] = a; ((uint4*)kd)[i] = bb;
  }
#pragma unroll
  for (int i = 0; i < 32; ++i) k2 += k[i] * k[i];
  k2 = fmaxf(k2, shx(k2, 8)); k2 = fmaxf(k2, shx(k2, 16)); k2 = fmaxf(k2, shx(k2, 32));
  float* kred = (float*)(lds + 40960);
  if ((tid & 63) < 8) kred[(tid >> 6) * 8 + (tid & 7)] = k2;
  {
    u16* vt = (u16*)lds;
    const uint4* vs = (const uint4*)(urow + UC_V + h * 64 + c * 32);
    const int p64 = pos & 63, within = p64 & 15, hh = (within >> 2) & 1, jj = ((within >> 3) << 2) | (within & 3);
    const int col = (p64 & ~15) + 8 * hh + jj;
    u16* vd = vt + (h * 64 + c * 32) * 72 + col;
#pragma unroll
    for (int i = 0; i < 4; ++i) {
      uint4 a = vs[i];
      vd[(i * 8 + 0) * 72] = (u16)(a.x & 0xffff); vd[(i * 8 + 1) * 72] = (u16)(a.x >> 16);
      vd[(i * 8 + 2) * 72] = (u16)(a.y & 0xffff); vd[(i * 8 + 3) * 72] = (u16)(a.y >> 16);
      vd[(i * 8 + 4) * 72] = (u16)(a.z & 0xffff); vd[(i * 8 + 5) * 72] = (u16)(a.z >> 16);
      vd[(i * 8 + 6) * 72] = (u16)(a.w & 0xffff); vd[(i * 8 + 7) * 72] = (u16)(a.w >> 16);
    }
    __syncthreads();
    const int m0u = unit * 64;
    const int bu = m0u < MLAT ? (m0u >> 13) : ((m0u - MLAT) >> 8), pos0 = m0u < MLAT ? (m0u & 8191) : 8192 + ((m0u - MLAT) & 255);
    u16* Vg = (u16*)(P.ws + WS_VT) + (size_t)(bu * 4) * 64 * NKEY + pos0;
#pragma unroll
    for (int q = 0; q < 4; ++q) {
      const int idx = tid + q * NTHREADS, row = idx >> 3, part = idx & 7;
      *(uint4*)(Vg + (size_t)row * NKEY + part * 8) = *(const uint4*)(vt + row * 72 + part * 8);
    }
    if (tid < 8) {
      float mx = 0.f;
#pragma unroll
      for (int w8 = 0; w8 < 8; ++w8) mx = fmaxf(mx, kred[w8 * 8 + tid]);
      atomicMax((unsigned*)(P.ws + WS_MISC) + ((l * 2 + bu) * 4 + (tid >> 1)) * 2 + (tid & 1), __float_as_uint(mx));
    }
    __syncthreads();
  }
}

constexpr int QP = 136, GP = 129, GLA_SG = 2 * 64 * QP * 2 + 64 * 256 * 2, GLA_SLR = GLA_SG + 2 * 64 * GP * 4;
DI void gla_stage(const Params& P, int l, int b, int cb, char* lds) {
  u16* sq = (u16*)lds; u16* sk = sq + 64 * QP; u16* sv = sk + 64 * QP; float* sg = (float*)(lds + GLA_SG); float* slr = (float*)(lds + GLA_SLR);
  const int tid = tidx(), m0 = blk_m0(b, cb);
  const u16* U = (const u16*)(P.ws + WS_U);
#pragma unroll
  for (int e = tid; e < 1024; e += NTHREADS) {
    int t = e >> 4, part = e & 15; const u16* row = U + (size_t)(m0 + t) * UP;
    *(uint4*)(sq + t * QP + part * 8) = *(const uint4*)(row + UA_Q + part * 8);
    *(uint4*)(sk + t * QP + part * 8) = *(const uint4*)(row + UA_K + part * 8);
  }
#pragma unroll
  for (int e = tid; e < 2048; e += NTHREADS) { int t = e >> 5, part = e & 31; *(uint4*)(sv + t * 256 + part * 8) = *(const uint4*)(U + (size_t)(m0 + t) * UP + UA_V + part * 8); }
  {
    int t = tid >> 3, part = tid & 7;
    uint2 v = *(const uint2*)(U + (size_t)(m0 + t) * UP + UA_LRF + part * 4);
    int dir = part >> 2, r0 = (part & 3) * 4; float* d = slr + (dir * 64 + t) * 16 + r0;
    d[0] = bflo(v.x); d[1] = bfhi(v.x); d[2] = bflo(v.y); d[3] = bfhi(v.y);
  }
  __syncthreads();
  {
    const int hk = tid & 127, tq = tid >> 7;
#pragma unroll
    for (int dir = 0; dir < 2; ++dir) {
      float wv[16];
#pragma unroll
      for (int r = 0; r < 16; ++r) wv[r] = P.gla_w2[((l * 2 + dir) * 16 + r) * 128 + hk];
      const float bb = P.gla_b2[(l * 2 + dir) * 128 + hk];
      for (int t = tq; t < 64; t += 4) {
        const float* lr = slr + (dir * 64 + t) * 16; float z = bb;
#pragma unroll
        for (int r = 0; r < 16; ++r) z += lr[r] * wv[r];
        const float ls = fminf(z, 0.f) - __logf(1.f + __expf(-fabsf(z)));
        sg[(dir * 64 + t) * GP + hk] = ls * (1.f / 16.f);
      }
    }
  }
  __syncthreads();
  if (tid < 256) {
    const int dir = tid >> 7, hk = tid & 127; float s = 0.f;
    float* col = sg + dir * 64 * GP + hk; float v[64];
#pragma unroll
    for (int t = 0; t < 64; ++t) v[t] = col[t * GP];
    if (dir == 0) {
#pragma unroll
      for (int t = 0; t < 64; ++t) { s += v[t]; col[t * GP] = s; }
    } else {
#pragma unroll
      for (int t = 63; t >= 0; --t) { s += v[t]; col[t * GP] = s; }
    }
  }
  __syncthreads();
}

DI void gla_local(const Params& P, int l, int b, int cb, char* lds) {
  gla_stage(P, l, b, cb, lds);
  const u16* sk = (const u16*)lds + 64 * QP; const u16* sv = sk + 64 * QP; const float* sg = (const float*)(lds + GLA_SG);
  const int tid = tidx(), w = tid >> 6, lane = tid & 63, c31 = lane & 31, hh = lane >> 5, dir = w >> 2, h = w & 3;
  const float* g = sg + dir * 64 * GP;
  const float glast = g[(dir ? 0 : 63) * GP + h * 32 + c31];
  f32x16 acc[2];
#pragma unroll
  for (int r = 0; r < 16; ++r) { acc[0][r] = 0.f; acc[1][r] = 0.f; }
#pragma unroll
  for (int ks = 0; ks < 4; ++ks) {
    float av[8];
#pragma unroll
    for (int e = 0; e < 8; ++e) { const int j = ks * 16 + hh * 8 + e; av[e] = bf2f(sk[j * QP + h * 32 + c31]) * __expf(glast - g[j * GP + h * 32 + c31]); }
    const bf16x8 a = pack8(av[0], av[1], av[2], av[3], av[4], av[5], av[6], av[7]);
#pragma unroll
    for (int vt = 0; vt < 2; ++vt) {
      bf16x8 bv;
#pragma unroll
      for (int e = 0; e < 8; ++e) bv[e] = (short)sv[(ks * 16 + hh * 8 + e) * 256 + h * 64 + vt * 32 + c31];
      acc[vt] = MFMA32(a, bv, acc[vt]);
    }
  }
  const int seq = (b * 2 + dir) * 4 + h, ci = blk_ci(cb, dir);
  u16* dst = (u16*)(P.ws + WS_GLA) + (size_t)(seq * NCH + ci) * 2048;
#pragma unroll
  for (int vt = 0; vt < 2; ++vt)
#pragma unroll
    for (int r = 0; r < 16; ++r) dst[crow(r, hh) * 64 + vt * 32 + c31] = f2bf(acc[vt][r]);
  if (hh == 0) ((float*)(P.ws + WS_GLAD))[(seq * NCH + ci) * 32 + c31] = __expf(glast);
  __syncthreads();
}

DI void gla_out(const Params& P, int l, int b, int cb, char* lds) {
  gla_stage(P, l, b, cb, lds);
  const u16* sq = (const u16*)lds; const u16* sk = sq + 64 * QP; const u16* sv = sk + 64 * QP; const float* sg = (const float*)(lds + GLA_SG);
  const int tid = tidx(), w = tid >> 6, lane = tid & 63, c31 = lane & 31, hh = lane >> 5, dir = w >> 2, h = w & 3;
  const float* g = sg + dir * 64 * GP;
  const int seq = (b * 2 + dir) * 4 + h, ci = blk_ci(cb, dir), m0 = blk_m0(b, cb);
  const u16* Sin = (const u16*)(P.ws + WS_GLA) + (size_t)(seq * NCH + ci) * 2048;
  f32x16 o[2][2];
#pragma unroll
  for (int a = 0; a < 2; ++a)
#pragma unroll
    for (int bb = 0; bb < 2; ++bb)
#pragma unroll
      for (int r = 0; r < 16; ++r) o[a][bb][r] = 0.f;
  bf16x8 qg[2][2];
#pragma unroll
  for (int it = 0; it < 2; ++it)
#pragma unroll
    for (int ks = 0; ks < 2; ++ks) {
      float v[8]; const int i = it * 32 + c31;
#pragma unroll
      for (int e = 0; e < 8; ++e) { const int kk = h * 32 + ks * 16 + hh * 8 + e; v[e] = bf2f(sq[i * QP + kk]) * __expf(g[i * GP + kk]) * 0.17677669529663687f; }
      qg[it][ks] = pack8(v[0], v[1], v[2], v[3], v[4], v[5], v[6], v[7]);
    }
#pragma unroll
  for (int ks = 0; ks < 2; ++ks)
#pragma unroll
    for (int vt = 0; vt < 2; ++vt) {
      bf16x8 sa;
#pragma unroll
      for (int e = 0; e < 8; ++e) sa[e] = (short)Sin[(ks * 16 + hh * 8 + e) * 64 + vt * 32 + c31];
#pragma unroll
      for (int it = 0; it < 2; ++it) o[vt][it] = MFMA32(sa, qg[it][ks], o[vt][it]);
    }
#pragma unroll
  for (int jt = 0; jt < 2; ++jt) {
    bf16x8 kg[2];
#pragma unroll
    for (int ks = 0; ks < 2; ++ks) {
      float v[8]; const int j = jt * 32 + c31;
#pragma unroll
      for (int e = 0; e < 8; ++e) { const int kk = h * 32 + ks * 16 + hh * 8 + e; v[e] = bf2f(sk[j * QP + kk]) * __expf(-g[j * GP + kk]); }
      kg[ks] = pack8(v[0], v[1], v[2], v[3], v[4], v[5], v[6], v[7]);
    }
#pragma unroll
    for (int it = 0; it < 2; ++it) {
      const bool skip = dir == 0 ? (jt > it) : (jt < it);
      if (skip) continue;
      f32x16 s;
#pragma unroll
      for (int r = 0; r < 16; ++r) s[r] = 0.f;
      s = MFMA32(kg[0], qg[it][0], s); s = MFMA32(kg[1], qg[it][1], s);
      const int i = it * 32 + c31;
#pragma unroll
      for (int r = 0; r < 16; ++r) { const int j = jt * 32 + crow(r, hh); const bool keep = dir == 0 ? (j <= i) : (j >= i); s[r] = keep ? s[r] : 0.f; }
      const bf16x8 p0 = pack8(s[0], s[1], s[2], s[3], s[4], s[5], s[6], s[7]), p1 = pack8(s[8], s[9], s[10], s[11], s[12], s[13], s[14], s[15]);
#pragma unroll
      for (int s2 = 0; s2 < 2; ++s2)
#pragma unroll
        for (int vt = 0; vt < 2; ++vt) {
          bf16x8 va;
#pragma unroll
          for (int e = 0; e < 8; ++e) { const int j = jt * 32 + 16 * s2 + 8 * (e >> 2) + 4 * hh + (e & 3); va[e] = (short)sv[j * 256 + h * 64 + vt * 32 + c31]; }
          o[vt][it] = MFMA32(va, s2 ? p1 : p0, o[vt][it]);
        }
    }
  }
  __syncthreads();
  float* xb = (float*)(lds + GLA_SG);
  if (dir == 1) {
#pragma unroll
    for (int vt = 0; vt < 2; ++vt)
#pragma unroll
      for (int it = 0; it < 2; ++it)
#pragma unroll
        for (int r = 0; r < 16; ++r) xb[(it * 32 + c31) * 257 + h * 64 + vt * 32 + crow(r, hh)] = o[vt][it][r];
  }
  __syncthreads();
  if (dir == 0) {
#pragma unroll
    for (int vt = 0; vt < 2; ++vt)
#pragma unroll
      for (int it = 0; it < 2; ++it)
#pragma unroll
        for (int r = 0; r < 16; ++r) xb[(it * 32 + c31) * 257 + h * 64 + vt * 32 + crow(r, hh)] += o[vt][it][r];
  }
  __syncthreads();
  {
    const u16* U = (const u16*)(P.ws + WS_U); u16* Y = (u16*)(P.ws + WS_XN);
#pragma unroll
    for (int q = 0; q < 4; ++q) {
      const int idx = tid + q * NTHREADS, row = idx >> 5, ch0 = (idx & 31) * 8; const size_t m = (size_t)(m0 + row);
      const uint4 gv = *(const uint4*)(U + m * UP + UA_G + ch0);
      float v[8]; float ss = 0.f;
#pragma unroll
      for (int e = 0; e < 8; ++e) { v[e] = xb[row * 257 + ch0 + e]; ss += v[e] * v[e]; }
      ss += shx(ss, 1); ss += shx(ss, 2); ss += shx(ss, 4);
      const float rstd = rsqrtf(ss * (1.f / 64.f) + 1e-6f);
      const float4 n0 = *(const float4*)(P.gla_norm_w + l * 64 + (ch0 & 63)), n1 = *(const float4*)(P.gla_norm_w + l * 64 + (ch0 & 63) + 4);
      uint4 ov;
      ov.x = pk2(v[0] * rstd * n0.x * siluf(bflo(gv.x)), v[1] * rstd * n0.y * siluf(bfhi(gv.x)));
      ov.y = pk2(v[2] * rstd * n0.z * siluf(bflo(gv.y)), v[3] * rstd * n0.w * siluf(bfhi(gv.y)));
      ov.z = pk2(v[4] * rstd * n1.x * siluf(bflo(gv.z)), v[5] * rstd * n1.y * siluf(bfhi(gv.z)));
      ov.w = pk2(v[6] * rstd * n1.z * siluf(bflo(gv.w)), v[7] * rstd * n1.w * siluf(bfhi(gv.w)));
      *(uint4*)(Y + m * 1024 + ch0) = ov;
    }
  }
  __syncthreads();
}

constexpr int SXP = 520;
DI void ssd_stage(const Params& P, int l, int b, int cb, char* lds) {
  u16* sx = (u16*)lds; float* scum = (float*)(lds + 132352); float* sdt = scum + 512;
  const int tid = tidx(), m0 = blk_m0(b, cb);
  const u16* U = (const u16*)(P.ws + WS_U);
  const int tseq0 = cb < 4 ? cb * 64 : (cb - 4) * 64, slen = cb < 4 ? 256 : T, mseq0 = cb < 4 ? MLAT + b * 256 : b * T;
  {
    const int ch0 = (tid & 63) * 8;
    float wt[4][8], bs[8];
    { const float4 b0 = *(const float4*)(P.ssd_conv_b + l * 512 + ch0), b1 = *(const float4*)(P.ssd_conv_b + l * 512 + ch0 + 4);
      bs[0] = b0.x; bs[1] = b0.y; bs[2] = b0.z; bs[3] = b0.w; bs[4] = b1.x; bs[5] = b1.y; bs[6] = b1.z; bs[7] = b1.w; }
#pragma unroll
    for (int j = 0; j < 4; ++j) {
      const float* wj = gp(P.ssd_conv_w + (l * 4 + j) * 512 + ch0); const float4 w0 = *(const float4*)wj, w1 = *(const float4*)(wj + 4);
      wt[j][0] = w0.x; wt[j][1] = w0.y; wt[j][2] = w0.z; wt[j][3] = w0.w; wt[j][4] = w1.x; wt[j][5] = w1.y; wt[j][6] = w1.z; wt[j][7] = w1.w;
    }
#pragma unroll 2
    for (int t = tid >> 6; t < 64; t += 8) {
      float acc[8];
#pragma unroll
      for (int i = 0; i < 8; ++i) acc[i] = bs[i];
#pragma unroll
      for (int j = 0; j < 4; ++j) {
        const int ts = tseq0 + t - 2 + j;
        if (ts >= 0 && ts < slen) {
          const uint4 v = *(const uint4*)(U + (size_t)(mseq0 + ts) * UP + UD_XBC + ch0);
          acc[0] += bflo(v.x) * wt[j][0]; acc[1] += bfhi(v.x) * wt[j][1]; acc[2] += bflo(v.y) * wt[j][2]; acc[3] += bfhi(v.y) * wt[j][3];
          acc[4] += bflo(v.z) * wt[j][4]; acc[5] += bfhi(v.z) * wt[j][5]; acc[6] += bflo(v.w) * wt[j][6]; acc[7] += bfhi(v.w) * wt[j][7];
        }
      }
      uint4 o; o.x = pk2(siluf(acc[0]), siluf(acc[1])); o.y = pk2(siluf(acc[2]), siluf(acc[3])); o.z = pk2(siluf(acc[4]), siluf(acc[5])); o.w = pk2(siluf(acc[6]), siluf(acc[7]));
      *(uint4*)(sx + t * SXP + ch0) = o;
    }
  }
  {
    const int dir = tid >> 8, t = (tid >> 2) & 63, hd = tid & 3;
    const float raw = bf2f(U[(size_t)(m0 + t) * UP + UD_DTF + dir * 4 + hd]);
    const float dt = softplusf(raw + P.ssd_dt_bias[(l * 2 + dir) * 4 + hd]);
    const float a = -__expf(P.ssd_a_log[(l * 2 + dir) * 4 + hd]);
    sdt[(dir * 64 + t) * 4 + hd] = dt; scum[(dir * 64 + t) * 4 + hd] = dt * a;
  }
  __syncthreads();
  if (tid < 8) {
    const int dir = tid >> 2, hd = tid & 3; float s = 0.f;
    float* col = scum + dir * 256 + hd; float v[64];
#pragma unroll
    for (int t = 0; t < 64; ++t) v[t] = col[t * 4];
    if (dir == 0) {
#pragma unroll
      for (int t = 0; t < 64; ++t) { s += v[t]; col[t * 4] = s; }
    } else {
#pragma unroll
      for (int t = 63; t >= 0; --t) { s += v[t]; col[t * 4] = s; }
    }
  }
  __syncthreads();
}

DI void ssd_local(const Params& P, int l, int b, int cb, char* lds) {
  ssd_stage(P, l, b, cb, lds);
  const u16* sx = (const u16*)lds; const float* scum = (const float*)(lds + 132352); const float* sdt = scum + 512;
  const int tid = tidx(), w = tid >> 6, lane = tid & 63, c31 = lane & 31, hh = lane >> 5, dir = w >> 2, h = w & 3, grp = h >> 1;
  const float cl = scum[(dir * 64 + (dir ? 0 : 63)) * 4 + h];
  f32x16 acc[2][2];
#pragma unroll
  for (int a = 0; a < 2; ++a)
#pragma unroll
    for (int bb = 0; bb < 2; ++bb)
#pragma unroll
      for (int r = 0; r < 16; ++r) acc[a][bb][r] = 0.f;
#pragma unroll
  for (int ks = 0; ks < 4; ++ks) {
    float wgt[8];
#pragma unroll
    for (int e = 0; e < 8; ++e) { const int s = ks * 16 + hh * 8 + e; wgt[e] = __expf(cl - scum[(dir * 64 + s) * 4 + h]) * sdt[(dir * 64 + s) * 4 + h]; }
    bf16x8 bn[2];
#pragma unroll
    for (int nt = 0; nt < 2; ++nt)
#pragma unroll
      for (int e = 0; e < 8; ++e) bn[nt][e] = (short)sx[(ks * 16 + hh * 8 + e) * SXP + 256 + grp * 64 + nt * 32 + c31];
#pragma unroll
    for (int pt = 0; pt < 2; ++pt) {
      float v[8];
#pragma unroll
      for (int e = 0; e < 8; ++e) v[e] = bf2f(sx[(ks * 16 + hh * 8 + e) * SXP + h * 64 + pt * 32 + c31]) * wgt[e];
      const bf16x8 a = pack8(v[0], v[1], v[2], v[3], v[4], v[5], v[6], v[7]);
#pragma unroll
      for (int nt = 0; nt < 2; ++nt) acc[pt][nt] = MFMA32(a, bn[nt], acc[pt][nt]);
    }
  }
  const int seq = (b * 2 + dir) * 4 + h, ci = blk_ci(cb, dir);
  u16* dst = (u16*)(P.ws + WS_SSD) + (size_t)(seq * NCH + ci) * 4096;
#pragma unroll
  for (int pt = 0; pt < 2; ++pt)
#pragma unroll
    for (int nt = 0; nt < 2; ++nt)
#pragma unroll
      for (int r = 0; r < 16; ++r) dst[(pt * 32 + crow(r, hh)) * 64 + nt * 32 + c31] = f2bf(acc[pt][nt][r]);
  if (lane == 0) ((float*)(P.ws + WS_SSDD))[seq * NCH + ci] = __expf(cl);
  __syncthreads();
}

DI void ssd_out(const Params& P, int l, int b, int cb, char* lds) {
  ssd_stage(P, l, b, cb, lds);
  const u16* sx = (const u16*)lds; float* xb = (float*)(lds + 66560); const float* scum = (const float*)(lds + 132352); const float* sdt = scum + 512; float* ssq = (float*)(lds + 136448);
  const int tid = tidx(), w = tid >> 6, lane = tid & 63, c31 = lane & 31, hh = lane >> 5, dir = w >> 2, h = w & 3, grp = h >> 1;
  const int seq = (b * 2 + dir) * 4 + h, ci = blk_ci(cb, dir), m0 = blk_m0(b, cb);
  const u16* Sin = (const u16*)(P.ws + WS_SSD) + (size_t)(seq * NCH + ci) * 4096;
  f32x16 y[2][2];
#pragma unroll
  for (int a = 0; a < 2; ++a)
#pragma unroll
    for (int bb = 0; bb < 2; ++bb)
#pragma unroll
      for (int r = 0; r < 16; ++r) y[a][bb][r] = 0.f;
#pragma unroll
  for (int lt = 0; lt < 2; ++lt) {
    const int tl = lt * 32 + c31;
    const float cuml = scum[(dir * 64 + tl) * 4 + h];
    const float ecl = __expf(cuml);
#pragma unroll
    for (int ks = 0; ks < 4; ++ks) {
      const uint4 cv = *(const uint4*)(sx + tl * SXP + 384 + grp * 64 + ks * 16 + hh * 8);
      const bf16x8 cmf = pack8(bflo(cv.x) * ecl, bfhi(cv.x) * ecl, bflo(cv.y) * ecl, bfhi(cv.y) * ecl, bflo(cv.z) * ecl, bfhi(cv.z) * ecl, bflo(cv.w) * ecl, bfhi(cv.w) * ecl);
#pragma unroll
      for (int pt = 0; pt < 2; ++pt) {
        const bf16x8 sa = *(const bf16x8*)(Sin + (pt * 32 + c31) * 64 + ks * 16 + hh * 8);
        y[pt][lt] = MFMA32(sa, cmf, y[pt][lt]);
      }
    }
#pragma unroll
    for (int st = 0; st < 2; ++st) {
      const bool skip = dir == 0 ? (st > lt) : (st < lt);
      if (skip) continue;
      f32x16 cbt;
#pragma unroll
      for (int r = 0; r < 16; ++r) cbt[r] = 0.f;
#pragma unroll
      for (int ks = 0; ks < 4; ++ks) {
        const bf16x8 bmf = *(const bf16x8*)(sx + (st * 32 + c31) * SXP + 256 + grp * 64 + ks * 16 + hh * 8);
        const bf16x8 cmf = *(const bf16x8*)(sx + tl * SXP + 384 + grp * 64 + ks * 16 + hh * 8);
        cbt = MFMA32(bmf, cmf, cbt);
      }
#pragma unroll
      for (int r = 0; r < 16; ++r) {
        const int s = st * 32 + crow(r, hh); const bool keep = dir == 0 ? (s <= tl) : (s >= tl);
        const float dec = __expf(fminf(cuml - scum[(dir * 64 + s) * 4 + h], 0.f)) * sdt[(dir * 64 + s) * 4 + h];
        cbt[r] = keep ? cbt[r] * dec : 0.f;
      }
      const bf16x8 p0 = pack8(cbt[0], cbt[1], cbt[2], cbt[3], cbt[4], cbt[5], cbt[6], cbt[7]), p1 = pack8(cbt[8], cbt[9], cbt[10], cbt[11], cbt[12], cbt[13], cbt[14], cbt[15]);
#pragma unroll
      for (int s2 = 0; s2 < 2; ++s2)
#pragma unroll
        for (int pt = 0; pt < 2; ++pt) {
          bf16x8 xa;
#pragma unroll
          for (int e = 0; e < 8; ++e) { const int s = st * 32 + 16 * s2 + 8 * (e >> 2) + 4 * hh + (e & 3); xa[e] = (short)sx[s * SXP + h * 64 + pt * 32 + c31]; }
          y[pt][lt] = MFMA32(xa, s2 ? p1 : p0, y[pt][lt]);
        }
    }
  }
  if (dir == 1) {
#pragma unroll
    for (int pt = 0; pt < 2; ++pt)
#pragma unroll
      for (int lt = 0; lt < 2; ++lt)
#pragma unroll
        for (int r = 0; r < 16; ++r) xb[(lt * 32 + c31) * 257 + h * 64 + pt * 32 + crow(r, hh)] = y[pt][lt][r];
  }
  __syncthreads();
  if (dir == 0) {
    const float dsk = P.ssd_d[l * 4 + h];
#pragma unroll
    for (int lt = 0; lt < 2; ++lt) {
      const int tl = lt * 32 + c31;
#pragma unroll
      for (int pt = 0; pt < 2; ++pt)
#pragma unroll
        for (int r = 0; r < 16; ++r) {
          const int p = pt * 32 + crow(r, hh);
          xb[tl * 257 + h * 64 + p] += y[pt][lt][r] + dsk * bf2f(sx[tl * SXP + h * 64 + p]);
        }
    }
  }
  __syncthreads();
  {
    const u16* U = (const u16*)(P.ws + WS_U); u16* Y = (u16*)(P.ws + WS_XN);
#pragma unroll
    for (int q = 0; q < 4; ++q) {
      const int idx = tid + q * NTHREADS, row = idx >> 5, ch0 = (idx & 31) * 8; const size_t m = (size_t)(m0 + row);
      const uint4 zv = *(const uint4*)(U + m * UP + UD_Z + ch0);
      const float zz[8] = {bflo(zv.x), bfhi(zv.x), bflo(zv.y), bfhi(zv.y), bflo(zv.z), bfhi(zv.z), bflo(zv.w), bfhi(zv.w)};
      float v[8]; float ss = 0.f;
#pragma unroll
      for (int e = 0; e < 8; ++e) { v[e] = xb[row * 257 + ch0 + e] * siluf(zz[e]); ss += v[e] * v[e]; }
      ss += shx(ss, 1); ss += shx(ss, 2); ss += shx(ss, 4); ss += shx(ss, 8); ss += shx(ss, 16);
      const float rstd = rsqrtf(ss * (1.f / 256.f) + 1e-6f);
      const float4 n0 = *(const float4*)(P.ssd_norm_w + l * 256 + ch0), n1 = *(const float4*)(P.ssd_norm_w + l * 256 + ch0 + 4);
      uint4 ov;
      ov.x = pk2(v[0] * rstd * n0.x, v[1] * rstd * n0.y); ov.y = pk2(v[2] * rstd * n0.z, v[3] * rstd * n0.w);
      ov.z = pk2(v[4] * rstd * n1.x, v[5] * rstd * n1.y); ov.w = pk2(v[6] * rstd * n1.z, v[7] * rstd * n1.w);
      *(uint4*)(Y + m * 1024 + 768 + ch0) = ov;
    }
  }
  __syncthreads();
}

constexpr int LXP = 264;
DI float neg_expm1f(float x) { return x > -0.01f ? -x * (1.f + x * (0.5f + x * (1.f / 6.f))) : 1.f - __expf(x); }

DI void lru_stage(const Params& P, int l, int b, int cb, char* lds) {
  u16* sxc = (u16*)lds;
  const int tid = tidx();
  const u16* U = (const u16*)(P.ws + WS_U);
  const int tseq0 = cb < 4 ? cb * 64 : (cb - 4) * 64, slen = cb < 4 ? 256 : T, mseq0 = cb < 4 ? MLAT + b * 256 : b * T;
  {
    const int ch0 = (tid & 31) * 8;
    float wt[4][8], bs[8];
    { const float4 b0 = *(const float4*)(P.lru_conv_b + l * 256 + ch0), b1 = *(const float4*)(P.lru_conv_b + l * 256 + ch0 + 4);
      bs[0] = b0.x; bs[1] = b0.y; bs[2] = b0.z; bs[3] = b0.w; bs[4] = b1.x; bs[5] = b1.y; bs[6] = b1.z; bs[7] = b1.w; }
#pragma unroll
    for (int j = 0; j < 4; ++j) {
      const float* wj = gp(P.lru_conv_w + (l * 4 + j) * 256 + ch0); const float4 w0 = *(const float4*)wj, w1 = *(const float4*)(wj + 4);
      wt[j][0] = w0.x; wt[j][1] = w0.y; wt[j][2] = w0.z; wt[j][3] = w0.w; wt[j][4] = w1.x; wt[j][5] = w1.y; wt[j][6] = w1.z; wt[j][7] = w1.w;
    }
#pragma unroll 2
    for (int t = tid >> 5; t < 64; t += 16) {
      float acc[8];
#pragma unroll
      for (int i = 0; i < 8; ++i) acc[i] = bs[i];
#pragma unroll
      for (int j = 0; j < 4; ++j) {
        const int ts = tseq0 + t - 2 + j;
        if (ts >= 0 && ts < slen) {
          const uint4 v = *(const uint4*)(U + (size_t)(mseq0 + ts) * UP + UB_X + ch0);
          acc[0] += bflo(v.x) * wt[j][0]; acc[1] += bfhi(v.x) * wt[j][1]; acc[2] += bflo(v.y) * wt[j][2]; acc[3] += bfhi(v.y) * wt[j][3];
          acc[4] += bflo(v.z) * wt[j][4]; acc[5] += bfhi(v.z) * wt[j][5]; acc[6] += bflo(v.w) * wt[j][6]; acc[7] += bfhi(v.w) * wt[j][7];
        }
      }
      uint4 o; o.x = pk2(acc[0], acc[1]); o.y = pk2(acc[2], acc[3]); o.z = pk2(acc[4], acc[5]); o.w = pk2(acc[6], acc[7]);
      *(uint4*)(sxc + t * LXP + ch0) = o;
    }
  }
  __syncthreads();
}

DI void lru_gates(const Params& P, int l, int dir, int g, int ct, const u16* sxc, f32x16 (&av)[2], f32x16 (&uv)[2]) {
  const int lane = tidx() & 63, c31 = lane & 31, hh = lane >> 5;
#pragma unroll
  for (int a = 0; a < 2; ++a)
#pragma unroll
    for (int r = 0; r < 16; ++r) { av[a][r] = 0.f; uv[a][r] = 0.f; }
  const u16* wfa_p = (const u16*)(P.ws + WS_LRUW) + (size_t)((((l * 2 + dir) * 4 + g) * 2 + 0) * 4096) + (ct * 64 + lane) * 8;
  const u16* wfx_p = wfa_p + 4096;
#pragma unroll
  for (int ks = 0; ks < 4; ++ks) {
    const bf16x8 wfa = *(const bf16x8*)(wfa_p + ks * 1024), wfx = *(const bf16x8*)(wfx_p + ks * 1024);
#pragma unroll
    for (int tt = 0; tt < 2; ++tt) {
      const bf16x8 xa = *(const bf16x8*)(sxc + (tt * 32 + c31) * LXP + g * 64 + ks * 16 + hh * 8);
      av[tt] = MFMA32(xa, wfa, av[tt]); uv[tt] = MFMA32(xa, wfx, uv[tt]);
    }
  }
  const int ch = g * 64 + ct * 32 + c31;
  const float ba = P.lru_ba[(l * 2 + dir) * 256 + ch], bx = P.lru_bx[(l * 2 + dir) * 256 + ch];
  const float sp = softplusf(-P.lru_lam[(l * 2 + dir) * 256 + ch]);
#pragma unroll
  for (int tt = 0; tt < 2; ++tt)
#pragma unroll
    for (int r = 0; r < 16; ++r) {
      const float rg = sigmf(av[tt][r] + ba), ig = sigmf(uv[tt][r] + bx);
      const float la = -8.f * rg * sp;
      const float xv = bf2f(sxc[(tt * 32 + crow(r, hh)) * LXP + ch]);
      av[tt][r] = __expf(la);
      uv[tt][r] = __builtin_amdgcn_sqrtf(neg_expm1f(2.f * la)) * ig * xv;
    }
}

template <int REV>
DI void lru_scan(f32x16 (&av)[2], f32x16 (&uv)[2], float& hc, float& ap) {
  const int hh = (tidx() & 63) >> 5;
  const bool first = (hh == (REV ? 1 : 0));
  ap = 1.f;
#pragma unroll
  for (int tti = 0; tti < 2; ++tti) {
    const int tt = REV ? 1 - tti : tti;
#pragma unroll
    for (int ii = 0; ii < 4; ++ii) {
      const int i = REV ? 3 - ii : ii;
      float GA = 1.f, GU = 0.f;
#pragma unroll
      for (int ee = 0; ee < 4; ++ee) { const int r = 4 * i + (REV ? 3 - ee : ee); GU = av[tt][r] * GU + uv[tt][r]; GA *= av[tt][r]; }
      const float PA = shx(GA, 32), PU = shx(GU, 32);
      float hcur = first ? hc : PA * hc + PU;
#pragma unroll
      for (int ee = 0; ee < 4; ++ee) { const int r = 4 * i + (REV ? 3 - ee : ee); hcur = av[tt][r] * hcur + uv[tt][r]; uv[tt][r] = hcur; }
      const float pairA = GA * PA, pairU = first ? PA * GU + PU : GA * PU + GU;
      hc = pairA * hc + pairU; ap *= pairA;
    }
  }
}

DI void lru_local(const Params& P, int l, int b, int cb, char* lds) {
  lru_stage(P, l, b, cb, lds);
  const int tid = tidx(), w = tid >> 6, lane = tid & 63, c31 = lane & 31, hh = lane >> 5, dir = w >> 2, g = w & 3;
  const int ci = blk_ci(cb, dir);
#pragma unroll 1
  for (int ct = 0; ct < 2; ++ct) {
    f32x16 av[2], uv[2];
    lru_gates(P, l, dir, g, ct, (const u16*)lds, av, uv);
    float hc = 0.f, ap;
    if (dir) lru_scan<1>(av, uv, hc, ap); else lru_scan<0>(av, uv, hc, ap);
    if (hh == 0) {
      const int ch = g * 64 + ct * 32 + c31;
      ((float*)(P.ws + WS_LRUA))[((b * 2 + dir) * NCH + ci) * 256 + ch] = ap;
      ((float*)(P.ws + WS_LRUU))[((b * 2 + dir) * NCH + ci) * 256 + ch] = hc;
    }
  }
  __syncthreads();
}

DI void lru_out(const Params& P, int l, int b, int cb, char* lds) {
  lru_stage(P, l, b, cb, lds);
  const int tid = tidx(), w = tid >> 6, lane = tid & 63, c31 = lane & 31, hh = lane >> 5, dir = w >> 2, g = w & 3;
  const int ci = blk_ci(cb, dir), m0 = blk_m0(b, cb);
  float* xb = (float*)(lds + 34816);
  f32x16 hres[2][2];
#pragma unroll
  for (int ct = 0; ct < 2; ++ct) {
    f32x16 av[2], uv[2];
    lru_gates(P, l, dir, g, ct, (const u16*)lds, av, uv);
    float hc = ((const float*)(P.ws + WS_LRUU))[((b * 2 + dir) * NCH + ci) * 256 + g * 64 + ct * 32 + c31], ap;
    if (dir) lru_scan<1>(av, uv, hc, ap); else lru_scan<0>(av, uv, hc, ap);
    if (dir == 1) {
#pragma unroll
      for (int tt = 0; tt < 2; ++tt)
#pragma unroll
        for (int r = 0; r < 16; ++r) xb[(tt * 32 + crow(r, hh)) * 257 + g * 64 + ct * 32 + c31] = uv[tt][r];
    }
    hres[ct][0] = uv[0]; hres[ct][1] = uv[1];
  }
  __syncthreads();
  if (dir == 0) {
#pragma unroll
    for (int ct = 0; ct < 2; ++ct)
#pragma unroll
      for (int tt = 0; tt < 2; ++tt)
#pragma unroll
        for (int r = 0; r < 16; ++r) xb[(tt * 32 + crow(r, hh)) * 257 + g * 64 + ct * 32 + c31] += hres[ct][tt][r];
  }
  __syncthreads();
  {
    const u16* U = (const u16*)(P.ws + WS_U); u16* Y = (u16*)(P.ws + WS_XN);
#pragma unroll
    for (int q = 0; q < 4; ++q) {
      const int idx = tid + q * NTHREADS, row = idx >> 5, ch0 = (idx & 31) * 8; const size_t m = (size_t)(m0 + row);
      const uint4 gv = *(const uint4*)(U + m * UP + UB_G + ch0);
      const float* xr = xb + row * 257 + ch0;
      uint4 ov;
      ov.x = pk2(xr[0] * siluf(bflo(gv.x)), xr[1] * siluf(bfhi(gv.x))); ov.y = pk2(xr[2] * siluf(bflo(gv.y)), xr[3] * siluf(bfhi(gv.y)));
      ov.z = pk2(xr[4] * siluf(bflo(gv.z)), xr[5] * siluf(bfhi(gv.z))); ov.w = pk2(xr[6] * siluf(bflo(gv.w)), xr[7] * siluf(bfhi(gv.w)));
      *(uint4*)(Y + m * 1024 + 256 + ch0) = ov;
    }
  }
  __syncthreads();
}

template <int PS, int DS>
DI void scan_bf16(u16* p, const float* d) {
  float s = 0.f;
  u16 ua[22], ub[22]; float da[22], db[22];
#pragma unroll
  for (int j = 0; j < 22; ++j) { ua[j] = p[(size_t)j * PS]; da[j] = d[j * DS]; }
#pragma unroll 1
  for (int g = 0; g < 6; g += 2) {
#pragma unroll
    for (int j = 0; j < 22; ++j) { ub[j] = p[(size_t)((g + 1) * 22 + j) * PS]; db[j] = d[((g + 1) * 22 + j) * DS]; }
#pragma unroll
    for (int j = 0; j < 22; ++j) { p[(size_t)(g * 22 + j) * PS] = f2bf(s); s = da[j] * s + bf2f(ua[j]); }
    if (g + 2 < 6) {
#pragma unroll
      for (int j = 0; j < 22; ++j) { ua[j] = p[(size_t)((g + 2) * 22 + j) * PS]; da[j] = d[((g + 2) * 22 + j) * DS]; }
    }
#pragma unroll
    for (int j = 0; j < 22; ++j) { p[(size_t)((g + 1) * 22 + j) * PS] = f2bf(s); s = db[j] * s + bf2f(ub[j]); }
  }
}

DI void phase_scans(const Params& P) {
  const int tid_ = tidx(); const int w = tid_ >> 6, lane = tid_ & 63;
  for (int unit = blockIdx.x + gridDim.x * w; unit < 1552; unit += gridDim.x * 8) {
    if (unit < 512) {
      const int item = unit * 64 + lane, seq = item >> 11, kv = item & 2047;
      scan_bf16<2048, 32>((u16*)(P.ws + WS_GLA) + (size_t)seq * NCH * 2048 + kv, (const float*)(P.ws + WS_GLAD) + seq * NCH * 32 + (kv >> 6));
    } else if (unit < 1536) {
      const int item = (unit - 512) * 64 + lane, seq = item >> 12, pn = item & 4095;
      scan_bf16<4096, 1>((u16*)(P.ws + WS_SSD) + (size_t)seq * NCH * 4096 + pn, (const float*)(P.ws + WS_SSDD) + seq * NCH);
    } else {
      const int item = (unit - 1536) * 64 + lane, bd = item >> 8, ch = item & 255;
      float* pu = (float*)(P.ws + WS_LRUU) + (size_t)bd * NCH * 256 + ch; const float* pa = (const float*)(P.ws + WS_LRUA) + (size_t)bd * NCH * 256 + ch;
      float s = 0.f;
      for (int c0 = 0; c0 < NCH; c0 += 12) {
        float uu[12], dd[12];
#pragma unroll
        for (int j = 0; j < 12; ++j) { uu[j] = pu[(c0 + j) * 256]; dd[j] = pa[(c0 + j) * 256]; }
#pragma unroll
        for (int j = 0; j < 12; ++j) { pu[(c0 + j) * 256] = s; s = dd[j] * s + uu[j]; }
      }
    }
  }
}

DI void attn_tile(const Params& P, int l, int b, int h, int qpos0, int key0, int ntile, float lam, float lam_init, char* lds) {
  const int tid = tidx(), w = tid >> 6, lane = tid & 63, c31 = lane & 31, hh = lane >> 5;
  const u16* Qg = (const u16*)(P.ws + WS_Q) + (size_t)((b * 4 + h) * 2) * NKEY * 32;
  const u16* Kg = (const u16*)(P.ws + WS_K) + (size_t)((b * 4 + h) * 2) * NKEY * 32;
  const u16* Vg = (const u16*)(P.ws + WS_VT) + (size_t)((b * 4 + h) * 64) * NKEY;
  const int qp = qpos0 + w * 32 + c31;
  bf16x8 qf[2][2]; float bq[2];
#pragma unroll
  for (int c = 0; c < 2; ++c)
#pragma unroll
    for (int ks = 0; ks < 2; ++ks) qf[c][ks] = *(const bf16x8*)(Qg + ((size_t)c * NKEY + qp) * 32 + ks * 16 + hh * 8);
#pragma unroll
  for (int c = 0; c < 2; ++c) {
    float s = 0.f;
#pragma unroll
    for (int ks = 0; ks < 2; ++ks)
#pragma unroll
      for (int e = 0; e < 8; ++e) { const float v = bf2f((u16)qf[c][ks][e]); s += v * v; }
    s += shx(s, 32);
    const float km = ((const float*)(P.ws + WS_MISC))[((l * 2 + b) * 4 + h) * 2 + c];
    bq[c] = sqrtf(s * km) * 1.002f + 1e-3f;
  }
  u16* sK = (u16*)lds; u16* sV = (u16*)(lds + 20480);
  const int kc = tid >> 8, kr = (tid >> 2) & 63, kpart = tid & 3, vdv = tid >> 3, vpart = tid & 7;
  const u16* kp = Kg + ((size_t)kc * NKEY + key0 + kr) * 32 + kpart * 8;
  const u16* vp = Vg + (size_t)vdv * NKEY + key0 + vpart * 8;
  uint4 rk = *(const uint4*)kp, rv = *(const uint4*)vp;
  *(uint4*)(sK + (kc * 64 + kr) * 40 + kpart * 8) = rk; *(uint4*)(sV + vdv * 72 + vpart * 8) = rv;
  __syncthreads();
  f32x16 O[2][2]; float ls[2] = {0.f, 0.f};
#pragma unroll
  for (int a = 0; a < 2; ++a)
#pragma unroll
    for (int bb = 0; bb < 2; ++bb)
#pragma unroll
      for (int r = 0; r < 16; ++r) O[a][bb][r] = 0.f;
  if (__builtin_amdgcn_readfirstlane(tid) >= 256) __builtin_amdgcn_s_setprio(1);
#pragma unroll 1
  for (int kt = 0; kt < ntile; ++kt) {
    const int cur = kt & 1;
    if (kt + 1 < ntile) { rk = *(const uint4*)(kp + (size_t)(kt + 1) * 2048); rv = *(const uint4*)(vp + (kt + 1) * 64); }
    const u16* cK = sK + cur * 5120; const u16* cV = sV + cur * 4608;
#pragma unroll
    for (int kt2 = 0; kt2 < 2; ++kt2) {
      const bf16x8 ka0 = *(const bf16x8*)(cK + (kt2 * 32 + c31) * 40 + hh * 8), ka1 = *(const bf16x8*)(cK + (kt2 * 32 + c31) * 40 + 16 + hh * 8);
      const bf16x8 kb0 = *(const bf16x8*)(cK + (64 + kt2 * 32 + c31) * 40 + hh * 8), kb1 = *(const bf16x8*)(cK + (64 + kt2 * 32 + c31) * 40 + 16 + hh * 8);
      f32x16 Sa, Sb;
#pragma unroll
      for (int r = 0; r < 16; ++r) { Sa[r] = -bq[0]; Sb[r] = -bq[1]; }
      Sa = MFMA32(ka0, qf[0][0], Sa); Sb = MFMA32(kb0, qf[1][0], Sb);
      Sa = MFMA32(ka1, qf[0][1], Sa); Sb = MFMA32(kb1, qf[1][1], Sb);
      const bf16x8 v00 = *(const bf16x8*)(cV + (c31) * 72 + (kt2 * 2) * 16 + hh * 8), v01 = *(const bf16x8*)(cV + (c31) * 72 + (kt2 * 2 + 1) * 16 + hh * 8);
      const bf16x8 v10 = *(const bf16x8*)(cV + (32 + c31) * 72 + (kt2 * 2) * 16 + hh * 8), v11 = *(const bf16x8*)(cV + (32 + c31) * 72 + (kt2 * 2 + 1) * 16 + hh * 8);
      {
        float p[16];
#pragma unroll
        for (int r = 0; r < 16; ++r) { p[r] = __builtin_amdgcn_exp2f(Sa[r]); ls[0] += p[r]; }
        const bf16x8 p0 = pack8(p[0], p[1], p[2], p[3], p[4], p[5], p[6], p[7]), p1 = pack8(p[8], p[9], p[10], p[11], p[12], p[13], p[14], p[15]);
        O[0][0] = MFMA32(v00, p0, O[0][0]); O[0][1] = MFMA32(v10, p0, O[0][1]);
        O[0][0] = MFMA32(v01, p1, O[0][0]); O[0][1] = MFMA32(v11, p1, O[0][1]);
      }
      {
        float p[16];
#pragma unroll
        for (int r = 0; r < 16; ++r) { p[r] = __builtin_amdgcn_exp2f(Sb[r]); ls[1] += p[r]; }
        const bf16x8 p0 = pack8(p[0], p[1], p[2], p[3], p[4], p[5], p[6], p[7]), p1 = pack8(p[8], p[9], p[10], p[11], p[12], p[13], p[14], p[15]);
        O[1][0] = MFMA32(v00, p0, O[1][0]); O[1][1] = MFMA32(v10, p0, O[1][1]);
        O[1][0] = MFMA32(v01, p1, O[1][0]); O[1][1] = MFMA32(v11, p1, O[1][1]);
      }
    }
    if (kt + 1 < ntile) { *(uint4*)(sK + (cur ^ 1) * 5120 + (kc * 64 + kr) * 40 + kpart * 8) = rk; *(uint4*)(sV + (cur ^ 1) * 4608 + vdv * 72 + vpart * 8) = rv; }
    __syncthreads();
  }
  __builtin_amdgcn_s_setprio(0);
  ls[0] += shx(ls[0], 32); ls[1] += shx(ls[1], 32);
  const float i0 = 1.f / ls[0], i1 = lam / ls[1];
  float ss = 0.f;
#pragma unroll
  for (int dt = 0; dt < 2; ++dt)
#pragma unroll
    for (int r = 0; r < 16; ++r) { const float o = O[0][dt][r] * i0 - O[1][dt][r] * i1; O[0][dt][r] = o; ss += o * o; }
  ss += shx(ss, 32);
  const float rstd = rsqrtf(ss * (1.f / 64.f) + 1e-6f) * (1.f - lam_init);
  const size_t m = (qpos0 < 8192) ? (size_t)(b * T + qp) : (size_t)(MLAT + b * 256 + (qp - 8192));
  const u16* U = (const u16*)(P.ws + WS_U); u16* Y = (u16*)(P.ws + WS_XN);
#pragma unroll
  for (int dt = 0; dt < 2; ++dt)
#pragma unroll
    for (int q4 = 0; q4 < 4; ++q4) {
      const int d0 = dt * 32 + 8 * q4 + 4 * hh;
      const uint2 gv = *(const uint2*)(U + m * UP + UC_G + h * 64 + d0);
      const float4 nw = *(const float4*)(P.diff_subln_w + l * 64 + d0);
      const float y0 = O[0][dt][4 * q4 + 0] * rstd * nw.x * siluf(bflo(gv.x)), y1 = O[0][dt][4 * q4 + 1] * rstd * nw.y * siluf(bfhi(gv.x));
      const float y2 = O[0][dt][4 * q4 + 2] * rstd * nw.z * siluf(bflo(gv.y)), y3 = O[0][dt][4 * q4 + 3] * rstd * nw.w * siluf(bfhi(gv.y));
      uint2 ov; ov.x = pk2(y0, y1); ov.y = pk2(y2, y3);
      *(uint2*)(Y + m * 1024 + 512 + h * 64 + d0) = ov;
    }
  __syncthreads();
}

DI void phase_attn(const Params& P, int l, char* lds) {
  const int lane = tidx() & 63;
  const float lam_init = 0.8f - 0.6f * __expf(-0.3f * (float)l);
  float a = 0.f, bsum = 0.f;
  if (lane < 32) { const float* lv = gp(P.diff_lam + l * 128); a = lv[lane] * lv[32 + lane]; bsum = lv[64 + lane] * lv[96 + lane]; }
#pragma unroll
  for (int s = 32; s >= 1; s >>= 1) { a += shx(a, s); bsum += shx(bsum, s); }
  const float lam = __expf(a) - __expf(bsum) + lam_init;
  const int ntask = (l == 0) ? 264 : 256;
  for (int id0 = blockIdx.x; id0 < ntask; id0 += gridDim.x) {
    int tb, th, tq0, tk0, tn;
    if (id0 < 256) {
      const int id = (gridDim.x == 256) ? ((id0 & 7) * 32 + (id0 >> 3)) : id0;
      tb = id >> 7; th = (id >> 5) & 3; tq0 = (id & 31) * 256; tk0 = 0; tn = 132;
    } else {
      const int id = id0 - 256;
      tb = id >> 2; th = id & 3; tq0 = 8192; tk0 = 8192; tn = 4;
    }
    attn_tile(P, l, tb, th, tq0, tk0, tn, lam, lam_init, lds);
  }
}

#define XB_TMO      128
#define XB_XCNT(j)  (256  + 64 * (j))
#define XB_XSUB(j)  (1280 + 64 * (j))
#define XB_XGEN(j)  (2304 + 64 * (j))
#define XB_TOP      3328
#define XB_TOPGEN   3392
#define XCD_BAR_WORDS 3456
#define XB_SPIN_CAP (1u << 18)
#define LAS __attribute__((address_space(3)))
DI unsigned xb_ld(unsigned* p) { return __hip_atomic_load(p, __ATOMIC_RELAXED, __HIP_MEMORY_SCOPE_AGENT); }
DI unsigned xb_add(unsigned* p, unsigned v) { return __hip_atomic_fetch_add(p, v, __ATOMIC_RELAXED, __HIP_MEMORY_SCOPE_AGENT); }
DI unsigned xb_xcc_id() { return (unsigned)__builtin_amdgcn_s_getreg((3 << 11) | 20) & 0xFu; }
#define XB_SPIN(cond, bar) do { unsigned _sp = 0; while (cond) { __builtin_amdgcn_s_sleep(1); \
    if ((++_sp & 255u) == 0u) { if (xb_ld(&(bar)[XB_TMO])) break; if (_sp > XB_SPIN_CAP) { atomicAdd(&(bar)[XB_TMO], 1u); break; } } } } while (0)
struct XcdBarrier { unsigned* bar; unsigned x; volatile LAS unsigned* st; };
DI XcdBarrier xcd_barrier_post(unsigned* bar, volatile LAS unsigned* st) {
  XcdBarrier b; b.bar = bar; b.x = xb_xcc_id(); b.st = st;
  if (threadIdx.x == 0) (void)xb_add(&bar[XB_XCNT(b.x)], 1u);
  return b;
}
DI void xcd_barrier_complete(unsigned* bar, unsigned x, unsigned& nloc, unsigned& nx) {
  const unsigned G = gridDim.x * gridDim.y * gridDim.z;
  unsigned sum, cnt, mine, sp = 0u;
  for (;;) {
    sum = 0u; cnt = 0u; mine = 0u;
#pragma unroll
    for (unsigned j = 0; j < 16; ++j) { const unsigned c = xb_ld(&bar[XB_XCNT(j)]); sum += c; cnt += (c > 0u) ? 1u : 0u; mine = (j == x) ? c : mine; }
    if (sum == G) break;
    __builtin_amdgcn_s_sleep(1);
    if ((++sp & 255u) == 0u) { if (xb_ld(&bar[XB_TMO])) break; if (sp > XB_SPIN_CAP) { atomicAdd(&bar[XB_TMO], 1u); break; } }
  }
  nloc = mine > 0u ? mine : 1u; nx = cnt > 0u ? cnt : 1u;
}
DI void xcd_barrier(const XcdBarrier& b) {
  asm volatile("s_waitcnt vmcnt(0)" ::: "memory");
  __syncthreads();
  if (threadIdx.x == 0) {
    unsigned* bar = b.bar;
    __builtin_amdgcn_s_waitcnt(0);
    unsigned nloc = b.st[0], nx = b.st[1];
    if (nloc == 0u) { xcd_barrier_complete(bar, b.x, nloc, nx); b.st[0] = nloc; b.st[1] = nx; }
    const unsigned old = xb_add(&bar[XB_XSUB(b.x)], 1u);
    const unsigned gen = old / nloc;
    if (old + 1u == (gen + 1u) * nloc) {
      __builtin_amdgcn_fence(__ATOMIC_RELEASE, "agent");
      asm volatile("s_waitcnt vmcnt(0)" ::: "memory");
      const unsigned og = xb_add(&bar[XB_TOP], 1u);
      const unsigned tg = og / nx;
      if (og + 1u == (tg + 1u) * nx) xb_add(&bar[XB_TOPGEN], 1u);
      else XB_SPIN(xb_ld(&bar[XB_TOPGEN]) == tg, bar);
      __builtin_amdgcn_fence(__ATOMIC_ACQUIRE, "agent");
      xb_add(&bar[XB_XGEN(b.x)], 1u);
      asm volatile("s_waitcnt vmcnt(0)" ::: "memory");
    } else {
      XB_SPIN(xb_ld(&bar[XB_XGEN(b.x)]) == gen, bar);
      __builtin_amdgcn_fence(__ATOMIC_ACQUIRE, "agent");
      asm volatile("s_waitcnt vmcnt(0)" ::: "memory");
    }
  }
  __syncthreads();
}

__global__ void __launch_bounds__(NTHREADS) fwd_megakernel(Params Parg) {
  extern __shared__ __attribute__((aligned(16))) char lds[];
  __shared__ Params sP;
  __shared__ uint4 xb_words;
  if (threadIdx.x == 0) { sP = Parg; xb_words = make_uint4(0u, 0u, 0u, 0u); }
  __syncthreads();
  const Params& P = sP;
  cg::grid_group grid = cg::this_grid();
  if (blockDim.x == 12345u) grid.sync();
  (void)xcd_barrier_post((unsigned*)(Parg.ws + WS_BAR), (volatile LAS unsigned*)&xb_words);
#define GRID_BAR() do { XcdBarrier xb_; xb_.bar = (unsigned*)(P.ws + WS_BAR); xb_.x = xb_xcc_id(); xb_.st = (volatile LAS unsigned*)&xb_words; xcd_barrier(xb_); } while (0)
  MARK(0); phase_p0(P, lds);
  GRID_BAR();
#pragma unroll 1
  for (int l = 0; l < 2; ++l) {
    MARK(1); phase_norm(P, l);
    GRID_BAR(); MARK(2);
    gemm_phase<0>(P, l, (const u16*)(P.ws + WS_XN), (const u16*)(P.ws + WS_WINT) + (size_t)l * UP * 1024, 66, 25, lds);
    GRID_BAR();
    MARK(3);
    for (int t = blockIdx.x; t < 1056; t += gridDim.x) {
      const int ty = t / 264, idx = t % 264, b = idx / 132, cb = idx % 132;
      if (ty == 0) ssd_local(P, l, b, cb, lds);
      else if (ty == 1) lru_local(P, l, b, cb, lds);
      else if (ty == 2) gla_local(P, l, b, cb, lds);
      else attn_prep(P, l, idx, lds);
    }
    GRID_BAR();
    MARK(4); phase_scans(P);
    MARK(5); phase_attn(P, l, lds); MARK(6);
    GRID_BAR();
    {
      const int per = (l == 0) ? 264 : 256;
      for (int t = blockIdx.x; t < 3 * per; t += gridDim.x) {
        const int ty = t / per, idx = t % per;
        const int b = (l == 0) ? idx / 132 : (idx >> 7), cb = (l == 0) ? idx % 132 : 4 + (idx & 127);
        if (ty == 0) ssd_out(P, l, b, cb, lds);
        else if (ty == 1) lru_out(P, l, b, cb, lds);
        else gla_out(P, l, b, cb, lds);
      }
    }
    GRID_BAR();
    MARK(7); gemm_phase<1>(P, l, (const u16*)(P.ws + WS_XN), (const u16*)(P.ws + WS_WOUT) + (size_t)l * 1024 * 1024, l == 0 ? 66 : 64, 8, lds);
    GRID_BAR();
  }
  MARK(8); phase_final_norm(P);
}

extern "C" void kernel_launch(void* const* d_in, const int* in_sizes, int n_in, void* d_out, int out_size, void* d_ws, size_t ws_size, hipStream_t stream) {
  static int grid_blocks = 0;
  if (!grid_blocks) {
    int dev = 0, cus = 0, per_cu = 0;
    hipGetDevice(&dev);
    hipDeviceGetAttribute(&cus, hipDeviceAttributeMultiprocessorCount, dev);
    hipFuncSetAttribute((const void*)fwd_megakernel, hipFuncAttributeMaxDynamicSharedMemorySize, LDS_BYTES);
    hipOccupancyMaxActiveBlocksPerMultiprocessor(&per_cu, (const void*)fwd_megakernel, NTHREADS, LDS_BYTES);
    if (per_cu < 1) { fprintf(stderr, "occupancy query returned %d\n", per_cu); per_cu = 1; }
    if (per_cu > 1) per_cu = 1;
    grid_blocks = cus * per_cu;
  }
  Params p{};
  const float** pf = (const float**)&p;
  for (int i = 0; i < 28; ++i) pf[i] = (const float*)d_in[i];
  pf[28] = (const float*)d_out; pf[29] = (const float*)d_ws;
  hipMemsetAsync((char*)d_ws + WS_BAR, 0, XCD_BAR_WORDS * 4, stream);
  void* args[] = {&p};
  hipError_t e = hipLaunchCooperativeKernel((const void*)fwd_megakernel, dim3(grid_blocks), dim3(NTHREADS), args, LDS_BYTES, stream);
  if (e != hipSuccess) fprintf(stderr, "cooperative launch failed: %s (grid %d)\n", hipGetErrorString(e), grid_blocks);
}
```

```cpp
#include <hip/hip_runtime.h>
#include <hip/hip_cooperative_groups.h>
#include <cstdio>
namespace cg = cooperative_groups;

#define DI __device__ __forceinline__
typedef unsigned short u16;
typedef __attribute__((ext_vector_type(8))) short bf16x8;
typedef __attribute__((ext_vector_type(16))) float f32x16;
typedef __attribute__((ext_vector_type(4))) unsigned u32x4;
typedef __bf16 bf2_t __attribute__((ext_vector_type(2)));
typedef float fl2_t __attribute__((ext_vector_type(2)));

#define MARK(n) asm volatile("; MARK " #n)
#define MFMA32(a, b, c) __builtin_amdgcn_mfma_f32_32x32x16_bf16((a), (b), (c), 0, 0, 0)

constexpr int T = 8192, D = 1024, UP = 3200, MLAT = 16384, MTOT = 16896, NKEY = 8448, NCH = 132;
constexpr int UA_Q = 0, UA_K = 128, UA_V = 256, UA_LRF = 512, UA_G = 544;
constexpr int UB_X = 800, UB_G = 1056;
constexpr int UC_Q = 1312, UC_K = 1568, UC_V = 1824, UC_G = 2080;
constexpr int UD_XBC = 2336, UD_DTF = 2848, UD_Z = 2856;
constexpr int NTHREADS = 512;
constexpr int LDS_BYTES = 147456;

constexpr size_t WS_WINT = 0;
constexpr size_t WS_WOUT = WS_WINT + (size_t)2 * UP * 1024 * 2;
constexpr size_t WS_MOD = WS_WOUT + (size_t)2 * 1024 * 1024 * 2;
constexpr size_t WS_ROPE = WS_MOD + (size_t)2 * 3 * 3072 * 4;
constexpr size_t WS_MISC = WS_ROPE + 8192;
constexpr size_t WS_XN = WS_MISC + 4096;
constexpr size_t WS_U = WS_XN + (size_t)MTOT * 1024 * 2;
constexpr size_t WS_HCTX = WS_U + (size_t)MTOT * UP * 2;
constexpr size_t WS_Q = WS_HCTX + (size_t)512 * 1024 * 4;
constexpr size_t WS_K = WS_Q + (size_t)16 * NKEY * 32 * 2;
constexpr size_t WS_VT = WS_K + (size_t)16 * NKEY * 32 * 2;
constexpr size_t WS_GLA = WS_VT + (size_t)8 * 64 * NKEY * 2;
constexpr size_t WS_GLAD = WS_GLA + (size_t)16 * NCH * 2048 * 4;
constexpr size_t WS_SSD = WS_GLAD + (size_t)16 * NCH * 32 * 4;
constexpr size_t WS_SSDD = WS_SSD + (size_t)16 * NCH * 4096 * 4;
constexpr size_t WS_LRUA = WS_SSDD + 16384;
constexpr size_t WS_LRUU = WS_LRUA + (size_t)4 * NCH * 256 * 4;
constexpr size_t WS_BAR = WS_LRUU + (size_t)4 * NCH * 256 * 4;
constexpr size_t WS_LRUW = WS_BAR + 16384;
constexpr size_t WS_END = WS_LRUW + (size_t)64 * 4096 * 2;
static_assert(WS_END <= (size_t)256 * 1024 * 1024, "workspace");

#define GAS __attribute__((address_space(1)))
struct Params {
  const GAS float *x, *c, *ctx, *c_ctx, *w_mod, *b_mod, *norm_w, *w_in, *w_out, *gla_w2, *gla_b2, *gla_norm_w, *lru_conv_w, *lru_conv_b,
      *lru_wa, *lru_ba, *lru_wx, *lru_bx, *lru_lam, *diff_lam, *diff_subln_w, *ssd_conv_w, *ssd_conv_b, *ssd_dt_bias, *ssd_a_log, *ssd_d,
      *ssd_norm_w, *final_norm_w;
  GAS float* out;
  GAS unsigned char* ws;
};

DI unsigned pk2(float a, float b) { fl2_t v = {a, b}; return __builtin_bit_cast(unsigned, __builtin_convertvector(v, bf2_t)); }
DI u16 f2bf(float a) { return (u16)(pk2(a, 0.f) & 0xffffu); }
DI float bf2f(u16 x) { return __uint_as_float(((unsigned)x) << 16); }
DI float bflo(unsigned x) { return __uint_as_float(x << 16); }
DI float bfhi(unsigned x) { return __uint_as_float(x & 0xffff0000u); }
DI bf16x8 mk8(unsigned a, unsigned b, unsigned c, unsigned d) { u32x4 v = {a, b, c, d}; return __builtin_bit_cast(bf16x8, v); }
DI bf16x8 pack8(float a0, float a1, float a2, float a3, float a4, float a5, float a6, float a7) { return mk8(pk2(a0, a1), pk2(a2, a3), pk2(a4, a5), pk2(a6, a7)); }
template <class T> DI T* gp(GAS T* p) { return (T*)p; }
typedef __attribute__((ext_vector_type(4))) float f32x4_t;
DI float4 ld_nt(const float4* p) { const f32x4_t v = __builtin_nontemporal_load((const f32x4_t*)p); return make_float4(v.x, v.y, v.z, v.w); }
DI int tidx() { int t = threadIdx.x; asm volatile("" : "+v"(t)); return t; }
DI int crow(int r, int hh) { return (r & 3) + 8 * (r >> 2) + 4 * hh; }
DI float siluf(float x) { return x * __builtin_amdgcn_rcpf(1.f + __expf(-x)); }
DI float sigmf(float x) { return __builtin_amdgcn_rcpf(1.f + __expf(-x)); }
DI float softplusf(float x) { return fmaxf(x, 0.f) + __logf(1.f + __expf(-fabsf(x))); }
DI float shx(float v, int m) { return __shfl_xor(v, m, 64); }
DI int blk_m0(int b, int cb) { return cb < 4 ? MLAT + b * 256 + cb * 64 : b * T + (cb - 4) * 64; }
DI int blk_ci(int cb, int dir) { return dir == 0 ? cb : (cb < 4 ? 3 - cb : 135 - cb); }

DI void p0_transpose(const float* src, int N, u16* dst, int k0, int n0, float* lds) {
  const int tid = tidx();
  float v[8];
#pragma unroll
  for (int i = 0; i < 8; ++i) { const int e = tid + i * NTHREADS, kk = e >> 6, n = n0 + (e & 63); v[i] = (n < N) ? src[(size_t)(k0 + kk) * N + n] : 0.f; }
#pragma unroll
  for (int i = 0; i < 8; ++i) { const int e = tid + i * NTHREADS; lds[(e >> 6) * 65 + (e & 63)] = v[i]; }
  __syncthreads();
#pragma unroll
  for (int e = tid; e < 2048; e += NTHREADS) { int nn = e >> 5, kp = (e & 31) * 2; *(unsigned*)(dst + (size_t)(n0 + nn) * 1024 + k0 + kp) = pk2(lds[kp * 65 + nn], lds[(kp + 1) * 65 + nn]); }
  __syncthreads();
}

DI void p0_mod(const Params& P, int l, int n0, float* lds) {
  const int tid = tidx(), col = tid & 63, kg = tid >> 6;
  for (int e = tid; e < 1024; e += NTHREADS) { lds[e] = siluf(P.c[e]); lds[1024 + e] = siluf(P.c[1024 + e]); lds[2048 + e] = siluf(P.c_ctx[e]); }
  __syncthreads();
  float a0 = 0.f, a1 = 0.f, a2 = 0.f;
  const float* wm = gp(P.w_mod + (size_t)l * 1024 * 3072 + n0 + col);
  for (int k0 = kg * 128; k0 < kg * 128 + 128; k0 += 16) {
    float w[16];
#pragma unroll
    for (int j = 0; j < 16; ++j) w[j] = wm[(size_t)(k0 + j) * 3072];
#pragma unroll
    for (int j = 0; j < 16; ++j) { a0 += lds[k0 + j] * w[j]; a1 += lds[1024 + k0 + j] * w[j]; a2 += lds[2048 + k0 + j] * w[j]; }
  }
  float* red = lds + 3072;
  red[(kg * 3 + 0) * 64 + col] = a0; red[(kg * 3 + 1) * 64 + col] = a1; red[(kg * 3 + 2) * 64 + col] = a2;
  __syncthreads();
  if (tid < 192) {
    int j = tid >> 6; float sacc = P.b_mod[l * 3072 + n0 + col];
    for (int g = 0; g < 8; ++g) sacc += red[(g * 3 + j) * 64 + col];
    ((float*)(P.ws + WS_MOD))[(l * 3 + j) * 3072 + n0 + col] = sacc;
  }
  __syncthreads();
}

DI void phase_p0(const Params& P, char* lds) {
  float* fl = (float*)lds;
  for (int t0 = blockIdx.x; t0 < 2273; t0 += gridDim.x) {
    if (t0 >= 2209) {
      const int mid = t0 - 2209, gate = mid & 1, ldg = mid >> 1, tid = tidx();
      const float* wsrc = gp((gate ? P.lru_wx : P.lru_wa) + (size_t)ldg * 4096);
      const int lane = tid & 63, ct = (tid >> 6) & 1, ks = tid >> 7, c31 = lane & 31, hh = lane >> 5;
      float v[8];
#pragma unroll
      for (int e = 0; e < 8; ++e) v[e] = wsrc[(ks * 16 + hh * 8 + e) * 64 + ct * 32 + c31];
      uint4 o; o.x = pk2(v[0], v[1]); o.y = pk2(v[2], v[3]); o.z = pk2(v[4], v[5]); o.w = pk2(v[6], v[7]);
      *(uint4*)((u16*)(P.ws + WS_LRUW) + (size_t)mid * 4096 + tid * 8) = o;
      continue;
    }
    const int t = t0 < 96 ? 2112 + t0 : (t0 < 2208 ? t0 - 96 : t0);
    if (t < 1600) { int l = t / 800, rem = t % 800; p0_transpose(gp(P.w_in + (size_t)l * 1024 * 3112), 3112, (u16*)(P.ws + WS_WINT) + (size_t)l * UP * 1024, (rem & 15) * 64, (rem >> 4) * 64, fl); }
    else if (t < 2112) { int t2 = t - 1600; int l = t2 >> 8, rem = t2 & 255; p0_transpose(gp(P.w_out + (size_t)l * 1024 * 1024), 1024, (u16*)(P.ws + WS_WOUT) + (size_t)l * 1024 * 1024, (rem & 15) * 64, (rem >> 4) * 64, fl); }
    else if (t < 2208) { int t2 = t - 2112; p0_mod(P, t2 / 48, (t2 % 48) * 64, fl); }
    else {
      float* rope = (float*)(P.ws + WS_ROPE);
      const int tid = tidx();
      for (int e = tid; e < 1024; e += NTHREADS) { int pos = e >> 3, f = e & 7; float inv = exp2f(-(float)f * (13.287712379549449f / 8.f)); float ang = (float)pos * inv; rope[e] = __cosf(ang); rope[1024 + e] = __sinf(ang); }
      if (tid < 64) ((unsigned*)(P.ws + WS_MISC))[tid] = 0u;
    }
  }
}

DI const float* h_row(const Params& P, int l, int m) {
  if (l == 0) return gp(m < MLAT ? P.x + (size_t)m * 1024 : P.ctx + (size_t)(m - MLAT) * 1024);
  return m < MLAT ? (const float*)(P.out + (size_t)m * 1024) : (const float*)(P.ws + WS_HCTX) + (size_t)(m - MLAT) * 1024;
}

DI void phase_norm(const Params& P, int l) {
  const int tid_ = tidx(); const int w = tid_ >> 6, lane = tid_ & 63;
  u16* xn = (u16*)(P.ws + WS_XN);
  for (int row = blockIdx.x * 8 + w; row < MTOT; row += gridDim.x * 8) {
    const float4* src = (const float4*)h_row(P, l, row);
    const int j = row < MLAT ? (row >> 13) : 2;
    const float* mod = (const float*)(P.ws + WS_MOD) + (l * 3 + j) * 3072;
    float4 v[4]; float ss = 0.f;
#pragma unroll
    for (int i = 0; i < 4; ++i) { v[i] = ld_nt(src + i * 64 + lane); ss += v[i].x * v[i].x + v[i].y * v[i].y + v[i].z * v[i].z + v[i].w * v[i].w; }
#pragma unroll
    for (int s = 32; s >= 1; s >>= 1) ss += shx(ss, s);
    const float rstd = rsqrtf(ss * (1.f / 1024.f) + 1e-6f);
#pragma unroll
    for (int i = 0; i < 4; ++i) {
      const int k = (i * 64 + lane) * 4;
      float4 nw = *(const float4*)(P.norm_w + l * 1024 + k), sc = *(const float4*)(mod + 1024 + k), sh = *(const float4*)(mod + k);
      float y0 = v[i].x * rstd * nw.x * (1.f + sc.x) + sh.x, y1 = v[i].y * rstd * nw.y * (1.f + sc.y) + sh.y;
      float y2 = v[i].z * rstd * nw.z * (1.f + sc.z) + sh.z, y3 = v[i].w * rstd * nw.w * (1.f + sc.w) + sh.w;
      uint2 o; o.x = pk2(y0, y1); o.y = pk2(y2, y3);
      *(uint2*)(xn + (size_t)row * 1024 + k) = o;
    }
  }
}

DI void phase_final_norm(const Params& P) {
  const int tid_ = tidx(); const int w = tid_ >> 6, lane = tid_ & 63;
  for (int row = blockIdx.x * 8 + w; row < MLAT; row += gridDim.x * 8) {
    float4* src = (float4*)(P.out + (size_t)row * 1024);
    float4 v[4]; float ss = 0.f;
#pragma unroll
    for (int i = 0; i < 4; ++i) { v[i] = ld_nt(src + i * 64 + lane); ss += v[i].x * v[i].x + v[i].y * v[i].y + v[i].z * v[i].z + v[i].w * v[i].w; }
#pragma unroll
    for (int s = 32; s >= 1; s >>= 1) ss += shx(ss, s);
    const float rstd = rsqrtf(ss * (1.f / 1024.f) + 1e-6f);
#pragma unroll
    for (int i = 0; i < 4; ++i) {
      float4 nw = *(const float4*)(P.final_norm_w + (i * 64 + lane) * 4);
      float4 o; o.x = v[i].x * rstd * nw.x; o.y = v[i].y * rstd * nw.y; o.z = v[i].z * rstd * nw.z; o.w = v[i].w * rstd * nw.w;
      src[i * 64 + lane] = o;
    }
  }
}

constexpr int GS = 72;
template <int EPI>
DI void gemm_phase(const Params& P, int l, const u16* A, const u16* Bt, int mtiles, int ntiles, char* lds) {
  const int tid = tidx(), w = tid >> 6, lane = tid & 63, c31 = lane & 31, hh = lane >> 5, wm = w >> 1, wn = w & 1;
  const int lrow = tid >> 3, lcol = (tid & 7) * 8;
  const int ntot = mtiles * ntiles;
  const bool swz = (gridDim.x == 256);
  const int xcd = blockIdx.x & 7, jloc = blockIdx.x >> 3;
  const int per = (ntot + 7) >> 3, qbeg = xcd * per, qend = min(ntot, qbeg + per);
  for (int it = 0;; ++it) {
    int tm, tn;
    if (swz) {
      const int q = qbeg + jloc + 32 * it;
      if (q >= qend) break;
      const int band = q / (4 * ntiles), within = q - band * 4 * ntiles;
      const int rows = min(4, mtiles - band * 4);
      tn = within / rows; tm = band * 4 + (within - tn * rows);
    } else {
      const int tile = blockIdx.x + it * gridDim.x;
      if (tile >= ntot) break;
      tm = tile / ntiles; tn = tile % ntiles;
    }
    const int m0 = tm * 256, n0 = tn * 128;
    f32x16 acc[2][2];
#pragma unroll
    for (int i = 0; i < 2; ++i)
#pragma unroll
      for (int j = 0; j < 2; ++j)
#pragma unroll
        for (int r = 0; r < 16; ++r) acc[i][j][r] = 0.f;
    const u16* ga = A + (size_t)(m0 + lrow) * 1024 + lcol;
    const u16* gb = Bt + (size_t)(n0 + lrow) * 1024 + lcol;
    uint4 ra0, ra1, ra2, ra3, rb0, rb1, rc0, rc1, rc2, rc3, rd0, rd1;
#define G_LOAD(A0, A1, A2, A3, B0, B1, ko) { A0 = *(const uint4*)(ga + (ko)); A1 = *(const uint4*)(ga + (size_t)64 * 1024 + (ko)); A2 = *(const uint4*)(ga + (size_t)128 * 1024 + (ko)); A3 = *(const uint4*)(ga + (size_t)192 * 1024 + (ko)); \
      B0 = *(const uint4*)(gb + (ko)); B1 = *(const uint4*)(gb + (size_t)64 * 1024 + (ko)); }
#define G_STORE(A0, A1, A2, A3, B0, B1, buf) { u16* nA = (u16*)(lds + (buf) * 55296); u16* nB = (u16*)(lds + (buf) * 55296 + 36864); \
      *(uint4*)(nA + (lrow) * GS + lcol) = A0; *(uint4*)(nA + (lrow + 64) * GS + lcol) = A1; *(uint4*)(nA + (lrow + 128) * GS + lcol) = A2; *(uint4*)(nA + (lrow + 192) * GS + lcol) = A3; \
      *(uint4*)(nB + (lrow) * GS + lcol) = B0; *(uint4*)(nB + (lrow + 64) * GS + lcol) = B1; }
#define G_READ(buf) { const u16* sA = (const u16*)(lds + (buf) * 55296); const u16* sB = (const u16*)(lds + (buf) * 55296 + 36864); \
      _Pragma("unroll") for (int ks = 0; ks < 4; ++ks) { \
        af[ks][0] = *(const bf16x8*)(sA + (wm * 64 + c31) * GS + ks * 16 + hh * 8); af[ks][1] = *(const bf16x8*)(sA + (wm * 64 + 32 + c31) * GS + ks * 16 + hh * 8); \
        bfr[ks][0] = *(const bf16x8*)(sB + (wn * 64 + c31) * GS + ks * 16 + hh * 8); bfr[ks][1] = *(const bf16x8*)(sB + (wn * 64 + 32 + c31) * GS + ks * 16 + hh * 8); } \
      __builtin_amdgcn_sched_barrier(0); }
#define G_MMA() { __builtin_amdgcn_sched_barrier(0); \
      _Pragma("unroll") for (int ks = 0; ks < 4; ++ks) { \
        acc[0][0] = MFMA32(af[ks][0], bfr[ks][0], acc[0][0]); acc[0][1] = MFMA32(af[ks][0], bfr[ks][1], acc[0][1]); \
        acc[1][0] = MFMA32(af[ks][1], bfr[ks][0], acc[1][0]); acc[1][1] = MFMA32(af[ks][1], bfr[ks][1], acc[1][1]); } \
      __builtin_amdgcn_sched_barrier(0); }
    bf16x8 af[4][2], bfr[4][2];
#define S0 ra0, ra1, ra2, ra3, rb0, rb1
#define S1 rc0, rc1, rc2, rc3, rd0, rd1
#define GX(M, ...) M(__VA_ARGS__)
#define TK(t) (min((t), 15) * 64)
    if (w < 4) {
      GX(G_LOAD, S0, 0); GX(G_LOAD, S1, 64);
      GX(G_STORE, S0, 0); GX(G_STORE, S1, 1);
      GX(G_LOAD, S0, 128); GX(G_LOAD, S1, 192);
      __syncthreads();
      G_READ(0);
#pragma unroll 1
      for (int kt = 0; kt < 16; kt += 2) {
        G_MMA();
        __syncthreads();
        G_READ(1);
        if (kt + 2 < 16) GX(G_STORE, S0, 0);
        GX(G_LOAD, S0, TK(kt + 4));
        __syncthreads();
        G_MMA();
        __syncthreads();
        if (kt + 2 < 16) { G_READ(0); }
        if (kt + 3 < 16) GX(G_STORE, S1, 1);
        GX(G_LOAD, S1, TK(kt + 5));
        __syncthreads();
      }
    } else {
      GX(G_LOAD, S0, 0);
      GX(G_STORE, S0, 0);
      GX(G_LOAD, S1, 64); GX(G_LOAD, S0, 128);
      __syncthreads();
#pragma unroll 1
      for (int kt = 0; kt < 16; kt += 2) {
        G_READ(0);
        GX(G_STORE, S1, 1);
        GX(G_LOAD, S1, TK(kt + 3));
        __syncthreads();
        G_MMA();
        __syncthreads();
        G_READ(1);
        if (kt + 2 < 16) GX(G_STORE, S0, 0);
        GX(G_LOAD, S0, TK(kt + 4));
        __syncthreads();
        G_MMA();
        __syncthreads();
      }
    }
#undef GX
#undef S0
#undef S1
#undef TK
#undef G_READ
#undef G_MMA
#undef G_LOAD
#undef G_STORE
#undef G_COMPUTE
    if (EPI == 0) {
      u16* st = (u16*)(lds + 55296 + w * 9216);
#pragma unroll
      for (int i = 0; i < 2; ++i)
#pragma unroll
        for (int j = 0; j < 2; ++j)
#pragma unroll
          for (int r = 0; r < 16; ++r) st[(i * 32 + crow(r, hh)) * 72 + j * 32 + c31] = f2bf(acc[i][j][r]);
      u16* U = (u16*)(P.ws + WS_U) + (size_t)(m0 + wm * 64) * UP + n0 + wn * 64;
#pragma unroll
      for (int q = 0; q < 8; ++q) {
        const int idx = q * 64 + lane, row = idx >> 3, part = idx & 7;
        *(uint4*)(U + (size_t)row * UP + part * 8) = *(const uint4*)(st + row * 72 + part * 8);
      }
      __syncthreads();
    } else {
      float* st = (float*)(lds + w * 17408);
#pragma unroll
      for (int i = 0; i < 2; ++i)
#pragma unroll
        for (int j = 0; j < 2; ++j)
#pragma unroll
          for (int r = 0; r < 16; ++r) st[(i * 32 + crow(r, hh)) * 68 + j * 32 + c31] = acc[i][j][r];
      const int mrow0 = m0 + wm * 64, ncol = n0 + wn * 64 + (lane & 15) * 4;
      const int jm = mrow0 < MLAT ? (mrow0 >> 13) : 2;
      const float4 gate = *(const float4*)((const float*)(P.ws + WS_MOD) + (l * 3 + jm) * 3072 + 2048 + ncol);
#pragma unroll
      for (int half = 0; half < 2; ++half) {
        float4 hv[8];
#pragma unroll
        for (int q = 0; q < 8; ++q) { const int row = (half * 8 + q) * 4 + (lane >> 4); hv[q] = ld_nt((const float4*)(h_row(P, l, mrow0 + row) + ncol)); }
#pragma unroll
        for (int q = 0; q < 8; ++q) {
          const int row = (half * 8 + q) * 4 + (lane >> 4), m = mrow0 + row;
          const float4 a = *(const float4*)(st + row * 68 + (lane & 15) * 4);
          float4 o; o.x = hv[q].x + gate.x * a.x; o.y = hv[q].y + gate.y * a.y; o.z = hv[q].z + gate.z * a.z; o.w = hv[q].w + gate.w * a.w;
          float* dst = m < MLAT ? (float*)(P.out + (size_t)m * 1024 + ncol) : (float*)(P.ws + WS_HCTX) + (size_t)(m - MLAT) * 1024 + ncol;
          *(float4*)dst = o;
        }
      }
      __syncthreads();
    }
  }
}

DI void attn_prep(const Params& P, int l, int unit, char* lds) {
  const int tid = tidx(); const int gid = unit * NTHREADS + tid;
  const int m = gid >> 3, h = (gid >> 1) & 3, c = gid & 1;
  const u16* urow = (const u16*)(P.ws + WS_U) + (size_t)m * UP;
  float q[32], k[32];
  {
    const uint4* qs = (const uint4*)(urow + UC_Q + h * 64 + c * 32); const uint4* ks = (const uint4*)(urow + UC_K + h * 64 + c * 32);
#pragma unroll
    for (int i = 0; i < 4; ++i) {
      uint4 a = qs[i], b = ks[i];
      q[i * 8 + 0] = bflo(a.x); q[i * 8 + 1] = bfhi(a.x); q[i * 8 + 2] = bflo(a.y); q[i * 8 + 3] = bfhi(a.y); q[i * 8 + 4] = bflo(a.z); q[i * 8 + 5] = bfhi(a.z); q[i * 8 + 6] = bflo(a.w); q[i * 8 + 7] = bfhi(a.w);
      k[i * 8 + 0] = bflo(b.x); k[i * 8 + 1] = bfhi(b.x); k[i * 8 + 2] = bflo(b.y); k[i * 8 + 3] = bfhi(b.y); k[i * 8 + 4] = bflo(b.z); k[i * 8 + 5] = bfhi(b.z); k[i * 8 + 6] = bflo(b.w); k[i * 8 + 7] = bfhi(b.w);
    }
  }
  const bool lat = m < MLAT;
  const int b = lat ? (m >> 13) : ((m - MLAT) >> 8), t = lat ? (m & 8191) : ((m - MLAT) & 255);
  if (lat) {
    const float* rc = (const float*)(P.ws + WS_ROPE); const float* rs = rc + 1024;
#pragma unroll
    for (int a = 0; a < 2; ++a) {
      const int pos = a ? (t & 63) : (t >> 6);
#pragma unroll
      for (int f = 0; f < 8; ++f) {
        const float cs = rc[pos * 8 + f], sn = rs[pos * 8 + f];
        float x0 = q[a * 16 + f], x1 = q[a * 16 + 8 + f]; q[a * 16 + f] = x0 * cs - x1 * sn; q[a * 16 + 8 + f] = x1 * cs + x0 * sn;
        x0 = k[a * 16 + f]; x1 = k[a * 16 + 8 + f]; k[a * 16 + f] = x0 * cs - x1 * sn; k[a * 16 + 8 + f] = x1 * cs + x0 * sn;
      }
    }
  }
  const int pos = lat ? t : 8192 + t;
  const float QS = 0.17677669529663687f * 1.4426950408889634f;
  float k2 = 0.f;
  u16* qd = (u16*)(P.ws + WS_Q) + ((size_t)((b * 4 + h) * 2 + c) * NKEY + pos) * 32;
  u16* kd = (u16*)(P.ws + WS_K) + ((size_t)((b * 4 + h) * 2 + c) * NKEY + pos) * 32;
#pragma unroll
  for (int i = 0; i < 4; ++i) {
    uint4 a, bb;
    a.x = pk2(q[i * 8 + 0] * QS, q[i * 8 + 1] * QS); a.y = pk2(q[i * 8 + 2] * QS, q[i * 8 + 3] * QS); a.z = pk2(q[i * 8 + 4] * QS, q[i * 8 + 5] * QS); a.w = pk2(q[i * 8 + 6] * QS, q[i * 8 + 7] * QS);
    bb.x = pk2(k[i * 8 + 0], k[i * 8 + 1]); bb.y = pk2(k[i * 8 + 2], k[i * 8 + 3]); bb.z = pk2(k[i * 8 + 4], k[i * 8 + 5]); bb.w = pk2(k[i * 8 + 6], k[i * 8 + 7]);
    ((uint4*)qd)[i] = a; ((uint4*)kd)[i] = bb;
  }
#pragma unroll
  for (int i = 0; i < 32; ++i) k2 += k[i] * k[i];
  k2 = fmaxf(k2, shx(k2, 8)); k2 = fmaxf(k2, shx(k2, 16)); k2 = fmaxf(k2, shx(k2, 32));
  float* kred = (float*)(lds + 40960);
  if ((tid & 63) < 8) kred[(tid >> 6) * 8 + (tid & 7)] = k2;
  {
    u16* vt = (u16*)lds;
    const uint4* vs = (const uint4*)(urow + UC_V + h * 64 + c * 32);
    const int p64 = pos & 63, within = p64 & 15, hh = (within >> 2) & 1, jj = ((within >> 3) << 2) | (within & 3);
    const int col = (p64 & ~15) + 8 * hh + jj;
    u16* vd = vt + (h * 64 + c * 32) * 72 + col;
#pragma unroll
    for (int i = 0; i < 4; ++i) {
      uint4 a = vs[i];
      vd[(i * 8 + 0) * 72] = (u16)(a.x & 0xffff); vd[(i * 8 + 1) * 72] = (u16)(a.x >> 16);
      vd[(i * 8 + 2) * 72] = (u16)(a.y & 0xffff); vd[(i * 8 + 3) * 72] = (u16)(a.y >> 16);
      vd[(i * 8 + 4) * 72] = (u16)(a.z & 0xffff); vd[(i * 8 + 5) * 72] = (u16)(a.z >> 16);
      vd[(i * 8 + 6) * 72] = (u16)(a.w & 0xffff); vd[(i * 8 + 7) * 72] = (u16)(a.w >> 16);
    }
    __syncthreads();
    const int m0u = unit * 64;
    const int bu = m0u < MLAT ? (m0u >> 13) : ((m0u - MLAT) >> 8), pos0 = m0u < MLAT ? (m0u & 8191) : 8192 + ((m0u - MLAT) & 255);
    u16* Vg = (u16*)(P.ws + WS_VT) + (size_t)(bu * 4) * 64 * NKEY + pos0;
#pragma unroll
    for (int q = 0; q < 4; ++q) {
      const int idx = tid + q * NTHREADS, row = idx >> 3, part = idx & 7;
      *(uint4*)(Vg + (size_t)row * NKEY + part * 8) = *(const uint4*)(vt + row * 72 + part * 8);
    }
    if (tid < 8) {
      float mx = 0.f;
#pragma unroll
      for (int w8 = 0; w8 < 8; ++w8) mx = fmaxf(mx, kred[w8 * 8 + tid]);
      atomicMax((unsigned*)(P.ws + WS_MISC) + ((l * 2 + bu) * 4 + (tid >> 1)) * 2 + (tid & 1), __float_as_uint(mx));
    }
    __syncthreads();
  }
}

constexpr int QP = 136, GP = 129, GLA_SG = 2 * 64 * QP * 2 + 64 * 256 * 2, GLA_SLR = GLA_SG + 2 * 64 * GP * 4;
DI void gla_stage(const Params& P, int l, int b, int cb, char* lds) {
  u16* sq = (u16*)lds; u16* sk = sq + 64 * QP; u16* sv = sk + 64 * QP; float* sg = (float*)(lds + GLA_SG); float* slr = (float*)(lds + GLA_SLR);
  const int tid = tidx(), m0 = blk_m0(b, cb);
  const u16* U = (const u16*)(P.ws + WS_U);
#pragma unroll
  for (int e = tid; e < 1024; e += NTHREADS) {
    int t = e >> 4, part = e & 15; const u16* row = U + (size_t)(m0 + t) * UP;
    *(uint4*)(sq + t * QP + part * 8) = *(const uint4*)(row + UA_Q + part * 8);
    *(uint4*)(sk + t * QP + part * 8) = *(const uint4*)(row + UA_K + part * 8);
  }
#pragma unroll
  for (int e = tid; e < 2048; e += NTHREADS) { int t = e >> 5, part = e & 31; *(uint4*)(sv + t * 256 + part * 8) = *(const uint4*)(U + (size_t)(m0 + t) * UP + UA_V + part * 8); }
  {
    int t = tid >> 3, part = tid & 7;
    uint2 v = *(const uint2*)(U + (size_t)(m0 + t) * UP + UA_LRF + part * 4);
    int dir = part >> 2, r0 = (part & 3) * 4; float* d = slr + (dir * 64 + t) * 16 + r0;
    d[0] = bflo(v.x); d[1] = bfhi(v.x); d[2] = bflo(v.y); d[3] = bfhi(v.y);
  }
  __syncthreads();
  {
    const int hk = tid & 127, tq = tid >> 7;
#pragma unroll
    for (int dir = 0; dir < 2; ++dir) {
      float wv[16];
#pragma unroll
      for (int r = 0; r < 16; ++r) wv[r] = P.gla_w2[((l * 2 + dir) * 16 + r) * 128 + hk];
      const float bb = P.gla_b2[(l * 2 + dir) * 128 + hk];
      for (int t = tq; t < 64; t += 4) {
        const float* lr = slr + (dir * 64 + t) * 16; float z = bb;
#pragma unroll
        for (int r = 0; r < 16; ++r) z += lr[r] * wv[r];
        const float ls = fminf(z, 0.f) - __logf(1.f + __expf(-fabsf(z)));
        sg[(dir * 64 + t) * GP + hk] = ls * (1.f / 16.f);
      }
    }
  }
  __syncthreads();
  if (tid < 256) {
    const int dir = tid >> 7, hk = tid & 127; float s = 0.f;
    float* col = sg + dir * 64 * GP + hk; float v[64];
#pragma unroll
    for (int t = 0; t < 64; ++t) v[t] = col[t * GP];
    if (dir == 0) {
#pragma unroll
      for (int t = 0; t < 64; ++t) { s += v[t]; col[t * GP] = s; }
    } else {
#pragma unroll
      for (int t = 63; t >= 0; --t) { s += v[t]; col[t * GP] = s; }
    }
  }
  __syncthreads();
}

DI void gla_local(const Params& P, int l, int b, int cb, char* lds) {
  gla_stage(P, l, b, cb, lds);
  const u16* sk = (const u16*)lds + 64 * QP; const u16* sv = sk + 64 * QP; const float* sg = (const float*)(lds + GLA_SG);
  const int tid = tidx(), w = tid >> 6, lane = tid & 63, c31 = lane & 31, hh = lane >> 5, dir = w >> 2, h = w & 3;
  const float* g = sg + dir * 64 * GP;
  const float glast = g[(dir ? 0 : 63) * GP + h * 32 + c31];
  f32x16 acc[2];
#pragma unroll
  for (int r = 0; r < 16; ++r) { acc[0][r] = 0.f; acc[1][r] = 0.f; }
#pragma unroll
  for (int ks = 0; ks < 4; ++ks) {
    float av[8];
#pragma unroll
    for (int e = 0; e < 8; ++e) { const int j = ks * 16 + hh * 8 + e; av[e] = bf2f(sk[j * QP + h * 32 + c31]) * __expf(glast - g[j * GP + h * 32 + c31]); }
    const bf16x8 a = pack8(av[0], av[1], av[2], av[3], av[4], av[5], av[6], av[7]);
#pragma unroll
    for (int vt = 0; vt < 2; ++vt) {
      bf16x8 bv;
#pragma unroll
      for (int e = 0; e < 8; ++e) bv[e] = (short)sv[(ks * 16 + hh * 8 + e) * 256 + h * 64 + vt * 32 + c31];
      acc[vt] = MFMA32(a, bv, acc[vt]);
    }
  }
  const int seq = (b * 2 + dir) * 4 + h, ci = blk_ci(cb, dir);
  u16* dst = (u16*)(P.ws + WS_GLA) + (size_t)(seq * NCH + ci) * 2048;
#pragma unroll
  for (int vt = 0; vt < 2; ++vt)
#pragma unroll
    for (int r = 0; r < 16; ++r) dst[crow(r, hh) * 64 + vt * 32 + c31] = f2bf(acc[vt][r]);
  if (hh == 0) ((float*)(P.ws + WS_GLAD))[(seq * NCH + ci) * 32 + c31] = __expf(glast);
  __syncthreads();
}

DI void gla_out(const Params& P, int l, int b, int cb, char* lds) {
  gla_stage(P, l, b, cb, lds);
  const u16* sq = (const u16*)lds; const u16* sk = sq + 64 * QP; const u16* sv = sk + 64 * QP; const float* sg = (const float*)(lds + GLA_SG);
  const int tid = tidx(), w = tid >> 6, lane = tid & 63, c31 = lane & 31, hh = lane >> 5, dir = w >> 2, h = w & 3;
  const float* g = sg + dir * 64 * GP;
  const int seq = (b * 2 + dir) * 4 + h, ci = blk_ci(cb, dir), m0 = blk_m0(b, cb);
  const u16* Sin = (const u16*)(P.ws + WS_GLA) + (size_t)(seq * NCH + ci) * 2048;
  f32x16 o[2][2];
#pragma unroll
  for (int a = 0; a < 2; ++a)
#pragma unroll
    for (int bb = 0; bb < 2; ++bb)
#pragma unroll
      for (int r = 0; r < 16; ++r) o[a][bb][r] = 0.f;
  bf16x8 qg[2][2];
#pragma unroll
  for (int it = 0; it < 2; ++it)
#pragma unroll
    for (int ks = 0; ks < 2; ++ks) {
      float v[8]; const int i = it * 32 + c31;
#pragma unroll
      for (int e = 0; e < 8; ++e) { const int kk = h * 32 + ks * 16 + hh * 8 + e; v[e] = bf2f(sq[i * QP + kk]) * __expf(g[i * GP + kk]) * 0.17677669529663687f; }
      qg[it][ks] = pack8(v[0], v[1], v[2], v[3], v[4], v[5], v[6], v[7]);
    }
#pragma unroll
  for (int ks = 0; ks < 2; ++ks)
#pragma unroll
    for (int vt = 0; vt < 2; ++vt) {
      bf16x8 sa;
#pragma unroll
      for (int e = 0; e < 8; ++e) sa[e] = (short)Sin[(ks * 16 + hh * 8 + e) * 64 + vt * 32 + c31];
#pragma unroll
      for (int it = 0; it < 2; ++it) o[vt][it] = MFMA32(sa, qg[it][ks], o[vt][it]);
    }
#pragma unroll
  for (int jt = 0; jt < 2; ++jt) {
    bf16x8 kg[2];
#pragma unroll
    for (int ks = 0; ks < 2; ++ks) {
      float v[8]; const int j = jt * 32 + c31;
#pragma unroll
      for (int e = 0; e < 8; ++e) { const int kk = h * 32 + ks * 16 + hh * 8 + e; v[e] = bf2f(sk[j * QP + kk]) * __expf(-g[j * GP + kk]); }
      kg[ks] = pack8(v[0], v[1], v[2], v[3], v[4], v[5], v[6], v[7]);
    }
#pragma unroll
    for (int it = 0; it < 2; ++it) {
      const bool skip = dir == 0 ? (jt > it) : (jt < it);
      if (skip) continue;
      f32x16 s;
#pragma unroll
      for (int r = 0; r < 16; ++r) s[r] = 0.f;
      s = MFMA32(kg[0], qg[it][0], s); s = MFMA32(kg[1], qg[it][1], s);
      const int i = it * 32 + c31;
#pragma unroll
      for (int r = 0; r < 16; ++r) { const int j = jt * 32 + crow(r, hh); const bool keep = dir == 0 ? (j <= i) : (j >= i); s[r] = keep ? s[r] : 0.f; }
      const bf16x8 p0 = pack8(s[0], s[1], s[2], s[3], s[4], s[5], s[6], s[7]), p1 = pack8(s[8], s[9], s[10], s[11], s[12], s[13], s[14], s[15]);
#pragma unroll
      for (int s2 = 0; s2 < 2; ++s2)
#pragma unroll
        for (int vt = 0; vt < 2; ++vt) {
          bf16x8 va;
#pragma unroll
          for (int e = 0; e < 8; ++e) { const int j = jt * 32 + 16 * s2 + 8 * (e >> 2) + 4 * hh + (e & 3); va[e] = (short)sv[j * 256 + h * 64 + vt * 32 + c31]; }
          o[vt][it] = MFMA32(va, s2 ? p1 : p0, o[vt][it]);
        }
    }
  }
  __syncthreads();
  float* xb = (float*)(lds + GLA_SG);
  if (dir == 1) {
#pragma unroll
    for (int vt = 0; vt < 2; ++vt)
#pragma unroll
      for (int it = 0; it < 2; ++it)
#pragma unroll
        for (int r = 0; r < 16; ++r) xb[(it * 32 + c31) * 257 + h * 64 + vt * 32 + crow(r, hh)] = o[vt][it][r];
  }
  __syncthreads();
  if (dir == 0) {
#pragma unroll
    for (int vt = 0; vt < 2; ++vt)
#pragma unroll
      for (int it = 0; it < 2; ++it)
#pragma unroll
        for (int r = 0; r < 16; ++r) xb[(it * 32 + c31) * 257 + h * 64 + vt * 32 + crow(r, hh)] += o[vt][it][r];
  }
  __syncthreads();
  {
    const u16* U = (const u16*)(P.ws + WS_U); u16* Y = (u16*)(P.ws + WS_XN);
#pragma unroll
    for (int q = 0; q < 4; ++q) {
      const int idx = tid + q * NTHREADS, row = idx >> 5, ch0 = (idx & 31) * 8; const size_t m = (size_t)(m0 + row);
      const uint4 gv = *(const uint4*)(U + m * UP + UA_G + ch0);
      float v[8]; float ss = 0.f;
#pragma unroll
      for (int e = 0; e < 8; ++e) { v[e] = xb[row * 257 + ch0 + e]; ss += v[e] * v[e]; }
      ss += shx(ss, 1); ss += shx(ss, 2); ss += shx(ss, 4);
      const float rstd = rsqrtf(ss * (1.f / 64.f) + 1e-6f);
      const float4 n0 = *(const float4*)(P.gla_norm_w + l * 64 + (ch0 & 63)), n1 = *(const float4*)(P.gla_norm_w + l * 64 + (ch0 & 63) + 4);
      uint4 ov;
      ov.x = pk2(v[0] * rstd * n0.x * siluf(bflo(gv.x)), v[1] * rstd * n0.y * siluf(bfhi(gv.x)));
      ov.y = pk2(v[2] * rstd * n0.z * siluf(bflo(gv.y)), v[3] * rstd * n0.w * siluf(bfhi(gv.y)));
      ov.z = pk2(v[4] * rstd * n1.x * siluf(bflo(gv.z)), v[5] * rstd * n1.y * siluf(bfhi(gv.z)));
      ov.w = pk2(v[6] * rstd * n1.z * siluf(bflo(gv.w)), v[7] * rstd * n1.w * siluf(bfhi(gv.w)));
      *(uint4*)(Y + m * 1024 + ch0) = ov;
    }
  }
  __syncthreads();
}

constexpr int SXP = 520;
DI void ssd_stage(const Params& P, int l, int b, int cb, char* lds) {
  u16* sx = (u16*)lds; float* scum = (float*)(lds + 132352); float* sdt = scum + 512;
  const int tid = tidx(), m0 = blk_m0(b, cb);
  const u16* U = (const u16*)(P.ws + WS_U);
  const int tseq0 = cb < 4 ? cb * 64 : (cb - 4) * 64, slen = cb < 4 ? 256 : T, mseq0 = cb < 4 ? MLAT + b * 256 : b * T;
  {
    const int ch0 = (tid & 63) * 8;
    float wt[4][8], bs[8];
    { const float4 b0 = *(const float4*)(P.ssd_conv_b + l * 512 + ch0), b1 = *(const float4*)(P.ssd_conv_b + l * 512 + ch0 + 4);
      bs[0] = b0.x; bs[1] = b0.y; bs[2] = b0.z; bs[3] = b0.w; bs[4] = b1.x; bs[5] = b1.y; bs[6] = b1.z; bs[7] = b1.w; }
#pragma unroll
    for (int j = 0; j < 4; ++j) {
      const float* wj = gp(P.ssd_conv_w + (l * 4 + j) * 512 + ch0); const float4 w0 = *(const float4*)wj, w1 = *(const float4*)(wj + 4);
      wt[j][0] = w0.x; wt[j][1] = w0.y; wt[j][2] = w0.z; wt[j][3] = w0.w; wt[j][4] = w1.x; wt[j][5] = w1.y; wt[j][6] = w1.z; wt[j][7] = w1.w;
    }
#pragma unroll 2
    for (int t = tid >> 6; t < 64; t += 8) {
      float acc[8];
#pragma unroll
      for (int i = 0; i < 8; ++i) acc[i] = bs[i];
#pragma unroll
      for (int j = 0; j < 4; ++j) {
        const int ts = tseq0 + t - 2 + j;
        if (ts >= 0 && ts < slen) {
          const uint4 v = *(const uint4*)(U + (size_t)(mseq0 + ts) * UP + UD_XBC + ch0);
          acc[0] += bflo(v.x) * wt[j][0]; acc[1] += bfhi(v.x) * wt[j][1]; acc[2] += bflo(v.y) * wt[j][2]; acc[3] += bfhi(v.y) * wt[j][3];
          acc[4] += bflo(v.z) * wt[j][4]; acc[5] += bfhi(v.z) * wt[j][5]; acc[6] += bflo(v.w) * wt[j][6]; acc[7] += bfhi(v.w) * wt[j][7];
        }
      }
      uint4 o; o.x = pk2(siluf(acc[0]), siluf(acc[1])); o.y = pk2(siluf(acc[2]), siluf(acc[3])); o.z = pk2(siluf(acc[4]), siluf(acc[5])); o.w = pk2(siluf(acc[6]), siluf(acc[7]));
      *(uint4*)(sx + t * SXP + ch0) = o;
    }
  }
  {
    const int dir = tid >> 8, t = (tid >> 2) & 63, hd = tid & 3;
    const float raw = bf2f(U[(size_t)(m0 + t) * UP + UD_DTF + dir * 4 + hd]);
    const float dt = softplusf(raw + P.ssd_dt_bias[(l * 2 + dir) * 4 + hd]);
    const float a = -__expf(P.ssd_a_log[(l * 2 + dir) * 4 + hd]);
    sdt[(dir * 64 + t) * 4 + hd] = dt; scum[(dir * 64 + t) * 4 + hd] = dt * a;
  }
  __syncthreads();
  if (tid < 8) {
    const int dir = tid >> 2, hd = tid & 3; float s = 0.f;
    float* col = scum + dir * 256 + hd; float v[64];
#pragma unroll
    for (int t = 0; t < 64; ++t) v[t] = col[t * 4];
    if (dir == 0) {
#pragma unroll
      for (int t = 0; t < 64; ++t) { s += v[t]; col[t * 4] = s; }
    } else {
#pragma unroll
      for (int t = 63; t >= 0; --t) { s += v[t]; col[t * 4] = s; }
    }
  }
  __syncthreads();
}

DI void ssd_local(const Params& P, int l, int b, int cb, char* lds) {
  ssd_stage(P, l, b, cb, lds);
  const u16* sx = (const u16*)lds; const float* scum = (const float*)(lds + 132352); const float* sdt = scum + 512;
  const int tid = tidx(), w = tid >> 6, lane = tid & 63, c31 = lane & 31, hh = lane >> 5, dir = w >> 2, h = w & 3, grp = h >> 1;
  const float cl = scum[(dir * 64 + (dir ? 0 : 63)) * 4 + h];
  f32x16 acc[2][2];
#pragma unroll
  for (int a = 0; a < 2; ++a)
#pragma unroll
    for (int bb = 0; bb < 2; ++bb)
#pragma unroll
      for (int r = 0; r < 16; ++r) acc[a][bb][r] = 0.f;
#pragma unroll
  for (int ks = 0; ks < 4; ++ks) {
    float wgt[8];
#pragma unroll
    for (int e = 0; e < 8; ++e) { const int s = ks * 16 + hh * 8 + e; wgt[e] = __expf(cl - scum[(dir * 64 + s) * 4 + h]) * sdt[(dir * 64 + s) * 4 + h]; }
    bf16x8 bn[2];
#pragma unroll
    for (int nt = 0; nt < 2; ++nt)
#pragma unroll
      for (int e = 0; e < 8; ++e) bn[nt][e] = (short)sx[(ks * 16 + hh * 8 + e) * SXP + 256 + grp * 64 + nt * 32 + c31];
#pragma unroll
    for (int pt = 0; pt < 2; ++pt) {
      float v[8];
#pragma unroll
      for (int e = 0; e < 8; ++e) v[e] = bf2f(sx[(ks * 16 + hh * 8 + e) * SXP + h * 64 + pt * 32 + c31]) * wgt[e];
      const bf16x8 a = pack8(v[0], v[1], v[2], v[3], v[4], v[5], v[6], v[7]);
#pragma unroll
      for (int nt = 0; nt < 2; ++nt) acc[pt][nt] = MFMA32(a, bn[nt], acc[pt][nt]);
    }
  }
  const int seq = (b * 2 + dir) * 4 + h, ci = blk_ci(cb, dir);
  u16* dst = (u16*)(P.ws + WS_SSD) + (size_t)(seq * NCH + ci) * 4096;
#pragma unroll
  for (int pt = 0; pt < 2; ++pt)
#pragma unroll
    for (int nt = 0; nt < 2; ++nt)
#pragma unroll
      for (int r = 0; r < 16; ++r) dst[(pt * 32 + crow(r, hh)) * 64 + nt * 32 + c31] = f2bf(acc[pt][nt][r]);
  if (lane == 0) ((float*)(P.ws + WS_SSDD))[seq * NCH + ci] = __expf(cl);
  __syncthreads();
}

DI void ssd_out(const Params& P, int l, int b, int cb, char* lds) {
  ssd_stage(P, l, b, cb, lds);
  const u16* sx = (const u16*)lds; float* xb = (float*)(lds + 66560); const float* scum = (const float*)(lds + 132352); const float* sdt = scum + 512; float* ssq = (float*)(lds + 136448);
  const int tid = tidx(), w = tid >> 6, lane = tid & 63, c31 = lane & 31, hh = lane >> 5, dir = w >> 2, h = w & 3, grp = h >> 1;
  const int seq = (b * 2 + dir) * 4 + h, ci = blk_ci(cb, dir), m0 = blk_m0(b, cb);
  const u16* Sin = (const u16*)(P.ws + WS_SSD) + (size_t)(seq * NCH + ci) * 4096;
  f32x16 y[2][2];
#pragma unroll
  for (int a = 0; a < 2; ++a)
#pragma unroll
    for (int bb = 0; bb < 2; ++bb)
#pragma unroll
      for (int r = 0; r < 16; ++r) y[a][bb][r] = 0.f;
#pragma unroll
  for (int lt = 0; lt < 2; ++lt) {
    const int tl = lt * 32 + c31;
    const float cuml = scum[(dir * 64 + tl) * 4 + h];
    const float ecl = __expf(cuml);
#pragma unroll
    for (int ks = 0; ks < 4; ++ks) {
      const uint4 cv = *(const uint4*)(sx + tl * SXP + 384 + grp * 64 + ks * 16 + hh * 8);
      const bf16x8 cmf = pack8(bflo(cv.x) * ecl, bfhi(cv.x) * ecl, bflo(cv.y) * ecl, bfhi(cv.y) * ecl, bflo(cv.z) * ecl, bfhi(cv.z) * ecl, bflo(cv.w) * ecl, bfhi(cv.w) * ecl);
#pragma unroll
      for (int pt = 0; pt < 2; ++pt) {
        const bf16x8 sa = *(const bf16x8*)(Sin + (pt * 32 + c31) * 64 + ks * 16 + hh * 8);
        y[pt][lt] = MFMA32(sa, cmf, y[pt][lt]);
      }
    }
#pragma unroll
    for (int st = 0; st < 2; ++st) {
      const bool skip = dir == 0 ? (st > lt) : (st < lt);
      if (skip) continue;
      f32x16 cbt;
#pragma unroll
      for (int r = 0; r < 16; ++r) cbt[r] = 0.f;
#pragma unroll
      for (int ks = 0; ks < 4; ++ks) {
        const bf16x8 bmf = *(const bf16x8*)(sx + (st * 32 + c31) * SXP + 256 + grp * 64 + ks * 16 + hh * 8);
        const bf16x8 cmf = *(const bf16x8*)(sx + tl * SXP + 384 + grp * 64 + ks * 16 + hh * 8);
        cbt = MFMA32(bmf, cmf, cbt);
      }
#pragma unroll
      for (int r = 0; r < 16; ++r) {
        const int s = st * 32 + crow(r, hh); const bool keep = dir == 0 ? (s <= tl) : (s >= tl);
        const float dec = __expf(fminf(cuml - scum[(dir * 64 + s) * 4 + h], 0.f)) * sdt[(dir * 64 + s) * 4 + h];
        cbt[r] = keep ? cbt[r] * dec : 0.f;
      }
      const bf16x8 p0 = pack8(cbt[0], cbt[1], cbt[2], cbt[3], cbt[4], cbt[5], cbt[6], cbt[7]), p1 = pack8(cbt[8], cbt[9], cbt[10], cbt[11], cbt[12], cbt[13], cbt[14], cbt[15]);
#pragma unroll
      for (int s2 = 0; s2 < 2; ++s2)
#pragma unroll
        for (int pt = 0; pt < 2; ++pt) {
          bf16x8 xa;
#pragma unroll
          for (int e = 0; e < 8; ++e) { const int s = st * 32 + 16 * s2 + 8 * (e >> 2) + 4 * hh + (e & 3); xa[e] = (short)sx[s * SXP + h * 64 + pt * 32 + c31]; }
          y[pt][lt] = MFMA32(xa, s2 ? p1 : p0, y[pt][lt]);
        }
    }
  }
  if (dir == 1) {
#pragma unroll
    for (int pt = 0; pt < 2; ++pt)
#pragma unroll
      for (int lt = 0; lt < 2; ++lt)
#pragma unroll
        for (int r = 0; r < 16; ++r) xb[(lt * 32 + c31) * 257 + h * 64 + pt * 32 + crow(r, hh)] = y[pt][lt][r];
  }
  __syncthreads();
  if (dir == 0) {
    const float dsk = P.ssd_d[l * 4 + h];
#pragma unroll
    for (int lt = 0; lt < 2; ++lt) {
      const int tl = lt * 32 + c31;
#pragma unroll
      for (int pt = 0; pt < 2; ++pt)
#pragma unroll
        for (int r = 0; r < 16; ++r) {
          const int p = pt * 32 + crow(r, hh);
          xb[tl * 257 + h * 64 + p] += y[pt][lt][r] + dsk * bf2f(sx[tl * SXP + h * 64 + p]);
        }
    }
  }
  __syncthreads();
  {
    const u16* U = (const u16*)(P.ws + WS_U); u16* Y = (u16*)(P.ws + WS_XN);
#pragma unroll
    for (int q = 0; q < 4; ++q) {
      const int idx = tid + q * NTHREADS, row = idx >> 5, ch0 = (idx & 31) * 8; const size_t m = (size_t)(m0 + row);
      const uint4 zv = *(const uint4*)(U + m * UP + UD_Z + ch0);
      const float zz[8] = {bflo(zv.x), bfhi(zv.x), bflo(zv.y), bfhi(zv.y), bflo(zv.z), bfhi(zv.z), bflo(zv.w), bfhi(zv.w)};
      float v[8]; float ss = 0.f;
#pragma unroll
      for (int e = 0; e < 8; ++e) { v[e] = xb[row * 257 + ch0 + e] * siluf(zz[e]); ss += v[e] * v[e]; }
      ss += shx(ss, 1); ss += shx(ss, 2); ss += shx(ss, 4); ss += shx(ss, 8); ss += shx(ss, 16);
      const float rstd = rsqrtf(ss * (1.f / 256.f) + 1e-6f);
      const float4 n0 = *(const float4*)(P.ssd_norm_w + l * 256 + ch0), n1 = *(const float4*)(P.ssd_norm_w + l * 256 + ch0 + 4);
      uint4 ov;
      ov.x = pk2(v[0] * rstd * n0.x, v[1] * rstd * n0.y); ov.y = pk2(v[2] * rstd * n0.z, v[3] * rstd * n0.w);
      ov.z = pk2(v[4] * rstd * n1.x, v[5] * rstd * n1.y); ov.w = pk2(v[6] * rstd * n1.z, v[7] * rstd * n1.w);
      *(uint4*)(Y + m * 1024 + 768 + ch0) = ov;
    }
  }
  __syncthreads();
}

constexpr int LXP = 264;
DI float neg_expm1f(float x) { return x > -0.01f ? -x * (1.f + x * (0.5f + x * (1.f / 6.f))) : 1.f - __expf(x); }

DI void lru_stage(const Params& P, int l, int b, int cb, char* lds) {
  u16* sxc = (u16*)lds;
  const int tid = tidx();
  const u16* U = (const u16*)(P.ws + WS_U);
  const int tseq0 = cb < 4 ? cb * 64 : (cb - 4) * 64, slen = cb < 4 ? 256 : T, mseq0 = cb < 4 ? MLAT + b * 256 : b * T;
  {
    const int ch0 = (tid & 31) * 8;
    float wt[4][8], bs[8];
    { const float4 b0 = *(const float4*)(P.lru_conv_b + l * 256 + ch0), b1 = *(const float4*)(P.lru_conv_b + l * 256 + ch0 + 4);
      bs[0] = b0.x; bs[1] = b0.y; bs[2] = b0.z; bs[3] = b0.w; bs[4] = b1.x; bs[5] = b1.y; bs[6] = b1.z; bs[7] = b1.w; }
#pragma unroll
    for (int j = 0; j < 4; ++j) {
      const float* wj = gp(P.lru_conv_w + (l * 4 + j) * 256 + ch0); const float4 w0 = *(const float4*)wj, w1 = *(const float4*)(wj + 4);
      wt[j][0] = w0.x; wt[j][1] = w0.y; wt[j][2] = w0.z; wt[j][3] = w0.w; wt[j][4] = w1.x; wt[j][5] = w1.y; wt[j][6] = w1.z; wt[j][7] = w1.w;
    }
#pragma unroll 2
    for (int t = tid >> 5; t < 64; t += 16) {
      float acc[8];
#pragma unroll
      for (int i = 0; i < 8; ++i) acc[i] = bs[i];
#pragma unroll
      for (int j = 0; j < 4; ++j) {
        const int ts = tseq0 + t - 2 + j;
        if (ts >= 0 && ts < slen) {
          const uint4 v = *(const uint4*)(U + (size_t)(mseq0 + ts) * UP + UB_X + ch0);
          acc[0] += bflo(v.x) * wt[j][0]; acc[1] += bfhi(v.x) * wt[j][1]; acc[2] += bflo(v.y) * wt[j][2]; acc[3] += bfhi(v.y) * wt[j][3];
          acc[4] += bflo(v.z) * wt[j][4]; acc[5] += bfhi(v.z) * wt[j][5]; acc[6] += bflo(v.w) * wt[j][6]; acc[7] += bfhi(v.w) * wt[j][7];
        }
      }
      uint4 o; o.x = pk2(acc[0], acc[1]); o.y = pk2(acc[2], acc[3]); o.z = pk2(acc[4], acc[5]); o.w = pk2(acc[6], acc[7]);
      *(uint4*)(sxc + t * LXP + ch0) = o;
    }
  }
  __syncthreads();
}

DI void lru_gates(const Params& P, int l, int dir, int g, int ct, const u16* sxc, f32x16 (&av)[2], f32x16 (&uv)[2]) {
  const int lane = tidx() & 63, c31 = lane & 31, hh = lane >> 5;
#pragma unroll
  for (int a = 0; a < 2; ++a)
#pragma unroll
    for (int r = 0; r < 16; ++r) { av[a][r] = 0.f; uv[a][r] = 0.f; }
  const u16* wfa_p = (const u16*)(P.ws + WS_LRUW) + (size_t)((((l * 2 + dir) * 4 + g) * 2 + 0) * 4096) + (ct * 64 + lane) * 8;
  const u16* wfx_p = wfa_p + 4096;
#pragma unroll
  for (int ks = 0; ks < 4; ++ks) {
    const bf16x8 wfa = *(const bf16x8*)(wfa_p + ks * 1024), wfx = *(const bf16x8*)(wfx_p + ks * 1024);
#pragma unroll
    for (int tt = 0; tt < 2; ++tt) {
      const bf16x8 xa = *(const bf16x8*)(sxc + (tt * 32 + c31) * LXP + g * 64 + ks * 16 + hh * 8);
      av[tt] = MFMA32(xa, wfa, av[tt]); uv[tt] = MFMA32(xa, wfx, uv[tt]);
    }
  }
  const int ch = g * 64 + ct * 32 + c31;
  const float ba = P.lru_ba[(l * 2 + dir) * 256 + ch], bx = P.lru_bx[(l * 2 + dir) * 256 + ch];
  const float sp = softplusf(-P.lru_lam[(l * 2 + dir) * 256 + ch]);
#pragma unroll
  for (int tt = 0; tt < 2; ++tt)
#pragma unroll
    for (int r = 0; r < 16; ++r) {
      const float rg = sigmf(av[tt][r] + ba), ig = sigmf(uv[tt][r] + bx);
      const float la = -8.f * rg * sp;
      const float xv = bf2f(sxc[(tt * 32 + crow(r, hh)) * LXP + ch]);
      av[tt][r] = __expf(la);
      uv[tt][r] = __builtin_amdgcn_sqrtf(neg_expm1f(2.f * la)) * ig * xv;
    }
}

template <int REV>
DI void lru_scan(f32x16 (&av)[2], f32x16 (&uv)[2], float& hc, float& ap) {
  const int hh = (tidx() & 63) >> 5;
  const bool first = (hh == (REV ? 1 : 0));
  ap = 1.f;
#pragma unroll
  for (int tti = 0; tti < 2; ++tti) {
    const int tt = REV ? 1 - tti : tti;
#pragma unroll
    for (int ii = 0; ii < 4; ++ii) {
      const int i = REV ? 3 - ii : ii;
      float GA = 1.f, GU = 0.f;
#pragma unroll
      for (int ee = 0; ee < 4; ++ee) { const int r = 4 * i + (REV ? 3 - ee : ee); GU = av[tt][r] * GU + uv[tt][r]; GA *= av[tt][r]; }
      const float PA = shx(GA, 32), PU = shx(GU, 32);
      float hcur = first ? hc : PA * hc + PU;
#pragma unroll
      for (int ee = 0; ee < 4; ++ee) { const int r = 4 * i + (REV ? 3 - ee : ee); hcur = av[tt][r] * hcur + uv[tt][r]; uv[tt][r] = hcur; }
      const float pairA = GA * PA, pairU = first ? PA * GU + PU : GA * PU + GU;
      hc = pairA * hc + pairU; ap *= pairA;
    }
  }
}

DI void lru_local(const Params& P, int l, int b, int cb, char* lds) {
  lru_stage(P, l, b, cb, lds);
  const int tid = tidx(), w = tid >> 6, lane = tid & 63, c31 = lane & 31, hh = lane >> 5, dir = w >> 2, g = w & 3;
  const int ci = blk_ci(cb, dir);
#pragma unroll 1
  for (int ct = 0; ct < 2; ++ct) {
    f32x16 av[2], uv[2];
    lru_gates(P, l, dir, g, ct, (const u16*)lds, av, uv);
    float hc = 0.f, ap;
    if (dir) lru_scan<1>(av, uv, hc, ap); else lru_scan<0>(av, uv, hc, ap);
    if (hh == 0) {
      const int ch = g * 64 + ct * 32 + c31;
      ((float*)(P.ws + WS_LRUA))[((b * 2 + dir) * NCH + ci) * 256 + ch] = ap;
      ((float*)(P.ws + WS_LRUU))[((b * 2 + dir) * NCH + ci) * 256 + ch] = hc;
    }
  }
  __syncthreads();
}

DI void lru_out(const Params& P, int l, int b, int cb, char* lds) {
  lru_stage(P, l, b, cb, lds);
  const int tid = tidx(), w = tid >> 6, lane = tid & 63, c31 = lane & 31, hh = lane >> 5, dir = w >> 2, g = w & 3;
  const int ci = blk_ci(cb, dir), m0 = blk_m0(b, cb);
  float* xb = (float*)(lds + 34816);
  f32x16 hres[2][2];
#pragma unroll
  for (int ct = 0; ct < 2; ++ct) {
    f32x16 av[2], uv[2];
    lru_gates(P, l, dir, g, ct, (const u16*)lds, av, uv);
    float hc = ((const float*)(P.ws + WS_LRUU))[((b * 2 + dir) * NCH + ci) * 256 + g * 64 + ct * 32 + c31], ap;
    if (dir) lru_scan<1>(av, uv, hc, ap); else lru_scan<0>(av, uv, hc, ap);
    if (dir == 1) {
#pragma unroll
      for (int tt = 0; tt < 2; ++tt)
#pragma unroll
        for (int r = 0; r < 16; ++r) xb[(tt * 32 + crow(r, hh)) * 257 + g * 64 + ct * 32 + c31] = uv[tt][r];
    }
    hres[ct][0] = uv[0]; hres[ct][1] = uv[1];
  }
  __syncthreads();
  if (dir == 0) {
#pragma unroll
    for (int ct = 0; ct < 2; ++ct)
#pragma unroll
      for (int tt = 0; tt < 2; ++tt)
#pragma unroll
        for (int r = 0; r < 16; ++r) xb[(tt * 32 + crow(r, hh)) * 257 + g * 64 + ct * 32 + c31] += hres[ct][tt][r];
  }
  __syncthreads();
  {
    const u16* U = (const u16*)(P.ws + WS_U); u16* Y = (u16*)(P.ws + WS_XN);
#pragma unroll
    for (int q = 0; q < 4; ++q) {
      const int idx = tid + q * NTHREADS, row = idx >> 5, ch0 = (idx & 31) * 8; const size_t m = (size_t)(m0 + row);
      const uint4 gv = *(const uint4*)(U + m * UP + UB_G + ch0);
      const float* xr = xb + row * 257 + ch0;
      uint4 ov;
      ov.x = pk2(xr[0] * siluf(bflo(gv.x)), xr[1] * siluf(bfhi(gv.x))); ov.y = pk2(xr[2] * siluf(bflo(gv.y)), xr[3] * siluf(bfhi(gv.y)));
      ov.z = pk2(xr[4] * siluf(bflo(gv.z)), xr[5] * siluf(bfhi(gv.z))); ov.w = pk2(xr[6] * siluf(bflo(gv.w)), xr[7] * siluf(bfhi(gv.w)));
      *(uint4*)(Y + m * 1024 + 256 + ch0) = ov;
    }
  }
  __syncthreads();
}

template <int PS, int DS>
DI void scan_bf16(u16* p, const float* d) {
  float s = 0.f;
  u16 ua[12], ub[12]; float da[12], db[12];
#pragma unroll
  for (int j = 0; j < 12; ++j) { ua[j] = p[(size_t)j * PS]; da[j] = d[j * DS]; }
#pragma unroll 1
  for (int g = 0; g < 11; g += 2) {
    if (g + 1 < 11) {
#pragma unroll
      for (int j = 0; j < 12; ++j) { ub[j] = p[(size_t)((g + 1) * 12 + j) * PS]; db[j] = d[((g + 1) * 12 + j) * DS]; }
    }
#pragma unroll
    for (int j = 0; j < 12; ++j) { p[(size_t)(g * 12 + j) * PS] = f2bf(s); s = da[j] * s + bf2f(ua[j]); }
    if (g + 2 < 11) {
#pragma unroll
      for (int j = 0; j < 12; ++j) { ua[j] = p[(size_t)((g + 2) * 12 + j) * PS]; da[j] = d[((g + 2) * 12 + j) * DS]; }
    }
    if (g + 1 < 11) {
#pragma unroll
      for (int j = 0; j < 12; ++j) { p[(size_t)((g + 1) * 12 + j) * PS] = f2bf(s); s = db[j] * s + bf2f(ub[j]); }
    }
  }
}

DI void phase_scans(const Params& P) {
  const int tid_ = tidx(); const int w = tid_ >> 6, lane = tid_ & 63;
  for (int unit = blockIdx.x + gridDim.x * w; unit < 1552; unit += gridDim.x * 8) {
    if (unit < 512) {
      const int item = unit * 64 + lane, seq = item >> 11, kv = item & 2047;
      scan_bf16<2048, 32>((u16*)(P.ws + WS_GLA) + (size_t)seq * NCH * 2048 + kv, (const float*)(P.ws + WS_GLAD) + seq * NCH * 32 + (kv >> 6));
    } else if (unit < 1536) {
      const int item = (unit - 512) * 64 + lane, seq = item >> 12, pn = item & 4095;
      scan_bf16<4096, 1>((u16*)(P.ws + WS_SSD) + (size_t)seq * NCH * 4096 + pn, (const float*)(P.ws + WS_SSDD) + seq * NCH);
    } else {
      const int item = (unit - 1536) * 64 + lane, bd = item >> 8, ch = item & 255;
      float* pu = (float*)(P.ws + WS_LRUU) + (size_t)bd * NCH * 256 + ch; const float* pa = (const float*)(P.ws + WS_LRUA) + (size_t)bd * NCH * 256 + ch;
      float s = 0.f;
      for (int c0 = 0; c0 < NCH; c0 += 12) {
        float uu[12], dd[12];
#pragma unroll
        for (int j = 0; j < 12; ++j) { uu[j] = pu[(c0 + j) * 256]; dd[j] = pa[(c0 + j) * 256]; }
#pragma unroll
        for (int j = 0; j < 12; ++j) { pu[(c0 + j) * 256] = s; s = dd[j] * s + uu[j]; }
      }
    }
  }
}

DI void attn_tile(const Params& P, int l, int b, int h, int qpos0, int key0, int ntile, float lam, float lam_init, char* lds) {
  const int tid = tidx(), w = tid >> 6, lane = tid & 63, c31 = lane & 31, hh = lane >> 5;
  const u16* Qg = (const u16*)(P.ws + WS_Q) + (size_t)((b * 4 + h) * 2) * NKEY * 32;
  const u16* Kg = (const u16*)(P.ws + WS_K) + (size_t)((b * 4 + h) * 2) * NKEY * 32;
  const u16* Vg = (const u16*)(P.ws + WS_VT) + (size_t)((b * 4 + h) * 64) * NKEY;
  const int qp = qpos0 + w * 32 + c31;
  bf16x8 qf[2][2]; float bq[2];
#pragma unroll
  for (int c = 0; c < 2; ++c)
#pragma unroll
    for (int ks = 0; ks < 2; ++ks) qf[c][ks] = *(const bf16x8*)(Qg + ((size_t)c * NKEY + qp) * 32 + ks * 16 + hh * 8);
#pragma unroll
  for (int c = 0; c < 2; ++c) {
    float s = 0.f;
#pragma unroll
    for (int ks = 0; ks < 2; ++ks)
#pragma unroll
      for (int e = 0; e < 8; ++e) { const float v = bf2f((u16)qf[c][ks][e]); s += v * v; }
    s += shx(s, 32);
    const float km = ((const float*)(P.ws + WS_MISC))[((l * 2 + b) * 4 + h) * 2 + c];
    bq[c] = sqrtf(s * km) * 1.002f + 1e-3f;
  }
  u16* sK = (u16*)lds; u16* sV = (u16*)(lds + 20480);
  const int kc = tid >> 8, kr = (tid >> 2) & 63, kpart = tid & 3, vdv = tid >> 3, vpart = tid & 7;
  const u16* kp = Kg + ((size_t)kc * NKEY + key0 + kr) * 32 + kpart * 8;
  const u16* vp = Vg + (size_t)vdv * NKEY + key0 + vpart * 8;
  uint4 rk = *(const uint4*)kp, rv = *(const uint4*)vp;
  *(uint4*)(sK + (kc * 64 + kr) * 40 + kpart * 8) = rk; *(uint4*)(sV + vdv * 72 + vpart * 8) = rv;
  __syncthreads();
  f32x16 O[2][2]; float ls[2] = {0.f, 0.f};
#pragma unroll
  for (int a = 0; a < 2; ++a)
#pragma unroll
    for (int bb = 0; bb < 2; ++bb)
#pragma unroll
      for (int r = 0; r < 16; ++r) O[a][bb][r] = 0.f;
  if (__builtin_amdgcn_readfirstlane(tid) >= 256) __builtin_amdgcn_s_setprio(1);
#pragma unroll 1
  for (int kt = 0; kt < ntile; ++kt) {
    const int cur = kt & 1;
    if (kt + 1 < ntile) { rk = *(const uint4*)(kp + (size_t)(kt + 1) * 2048); rv = *(const uint4*)(vp + (kt + 1) * 64); }
    const u16* cK = sK + cur * 5120; const u16* cV = sV + cur * 4608;
#pragma unroll
    for (int kt2 = 0; kt2 < 2; ++kt2) {
      const bf16x8 ka0 = *(const bf16x8*)(cK + (kt2 * 32 + c31) * 40 + hh * 8), ka1 = *(const bf16x8*)(cK + (kt2 * 32 + c31) * 40 + 16 + hh * 8);
      const bf16x8 kb0 = *(const bf16x8*)(cK + (64 + kt2 * 32 + c31) * 40 + hh * 8), kb1 = *(const bf16x8*)(cK + (64 + kt2 * 32 + c31) * 40 + 16 + hh * 8);
      f32x16 Sa, Sb;
#pragma unroll
      for (int r = 0; r < 16; ++r) { Sa[r] = -bq[0]; Sb[r] = -bq[1]; }
      Sa = MFMA32(ka0, qf[0][0], Sa); Sb = MFMA32(kb0, qf[1][0], Sb);
      Sa = MFMA32(ka1, qf[0][1], Sa); Sb = MFMA32(kb1, qf[1][1], Sb);
      const bf16x8 v00 = *(const bf16x8*)(cV + (c31) * 72 + (kt2 * 2) * 16 + hh * 8), v01 = *(const bf16x8*)(cV + (c31) * 72 + (kt2 * 2 + 1) * 16 + hh * 8);
      const bf16x8 v10 = *(const bf16x8*)(cV + (32 + c31) * 72 + (kt2 * 2) * 16 + hh * 8), v11 = *(const bf16x8*)(cV + (32 + c31) * 72 + (kt2 * 2 + 1) * 16 + hh * 8);
      {
        float p[16];
#pragma unroll
        for (int r = 0; r < 16; ++r) { p[r] = __builtin_amdgcn_exp2f(Sa[r]); ls[0] += p[r]; }
        const bf16x8 p0 = pack8(p[0], p[1], p[2], p[3], p[4], p[5], p[6], p[7]), p1 = pack8(p[8], p[9], p[10], p[11], p[12], p[13], p[14], p[15]);
        O[0][0] = MFMA32(v00, p0, O[0][0]); O[0][1] = MFMA32(v10, p0, O[0][1]);
        O[0][0] = MFMA32(v01, p1, O[0][0]); O[0][1] = MFMA32(v11, p1, O[0][1]);
      }
      {
        float p[16];
#pragma unroll
        for (int r = 0; r < 16; ++r) { p[r] = __builtin_amdgcn_exp2f(Sb[r]); ls[1] += p[r]; }
        const bf16x8 p0 = pack8(p[0], p[1], p[2], p[3], p[4], p[5], p[6], p[7]), p1 = pack8(p[8], p[9], p[10], p[11], p[12], p[13], p[14], p[15]);
        O[1][0] = MFMA32(v00, p0, O[1][0]); O[1][1] = MFMA32(v10, p0, O[1][1]);
        O[1][0] = MFMA32(v01, p1, O[1][0]); O[1][1] = MFMA32(v11, p1, O[1][1]);
      }
    }
    if (kt + 1 < ntile) { *(uint4*)(sK + (cur ^ 1) * 5120 + (kc * 64 + kr) * 40 + kpart * 8) = rk; *(uint4*)(sV + (cur ^ 1) * 4608 + vdv * 72 + vpart * 8) = rv; }
    __syncthreads();
  }
  __builtin_amdgcn_s_setprio(0);
  ls[0] += shx(ls[0], 32); ls[1] += shx(ls[1], 32);
  const float i0 = 1.f / ls[0], i1 = lam / ls[1];
  float ss = 0.f;
#pragma unroll
  for (int dt = 0; dt < 2; ++dt)
#pragma unroll
    for (int r = 0; r < 16; ++r) { const float o = O[0][dt][r] * i0 - O[1][dt][r] * i1; O[0][dt][r] = o; ss += o * o; }
  ss += shx(ss, 32);
  const float rstd = rsqrtf(ss * (1.f / 64.f) + 1e-6f) * (1.f - lam_init);
  const size_t m = (qpos0 < 8192) ? (size_t)(b * T + qp) : (size_t)(MLAT + b * 256 + (qp - 8192));
  const u16* U = (const u16*)(P.ws + WS_U); u16* Y = (u16*)(P.ws + WS_XN);
#pragma unroll
  for (int dt = 0; dt < 2; ++dt)
#pragma unroll
    for (int q4 = 0; q4 < 4; ++q4) {
      const int d0 = dt * 32 + 8 * q4 + 4 * hh;
      const uint2 gv = *(const uint2*)(U + m * UP + UC_G + h * 64 + d0);
      const float4 nw = *(const float4*)(P.diff_subln_w + l * 64 + d0);
      const float y0 = O[0][dt][4 * q4 + 0] * rstd * nw.x * siluf(bflo(gv.x)), y1 = O[0][dt][4 * q4 + 1] * rstd * nw.y * siluf(bfhi(gv.x));
      const float y2 = O[0][dt][4 * q4 + 2] * rstd * nw.z * siluf(bflo(gv.y)), y3 = O[0][dt][4 * q4 + 3] * rstd * nw.w * siluf(bfhi(gv.y));
      uint2 ov; ov.x = pk2(y0, y1); ov.y = pk2(y2, y3);
      *(uint2*)(Y + m * 1024 + 512 + h * 64 + d0) = ov;
    }
  __syncthreads();
}

DI void phase_attn(const Params& P, int l, char* lds) {
  const int lane = tidx() & 63;
  const float lam_init = 0.8f - 0.6f * __expf(-0.3f * (float)l);
  float a = 0.f, bsum = 0.f;
  if (lane < 32) { const float* lv = gp(P.diff_lam + l * 128); a = lv[lane] * lv[32 + lane]; bsum = lv[64 + lane] * lv[96 + lane]; }
#pragma unroll
  for (int s = 32; s >= 1; s >>= 1) { a += shx(a, s); bsum += shx(bsum, s); }
  const float lam = __expf(a) - __expf(bsum) + lam_init;
  const int ntask = (l == 0) ? 264 : 256;
  for (int id0 = blockIdx.x; id0 < ntask; id0 += gridDim.x) {
    int tb, th, tq0, tk0, tn;
    if (id0 < 256) {
      const int id = (gridDim.x == 256) ? ((id0 & 7) * 32 + (id0 >> 3)) : id0;
      tb = id >> 7; th = (id >> 5) & 3; tq0 = (id & 31) * 256; tk0 = 0; tn = 132;
    } else {
      const int id = id0 - 256;
      tb = id >> 2; th = id & 3; tq0 = 8192; tk0 = 8192; tn = 4;
    }
    attn_tile(P, l, tb, th, tq0, tk0, tn, lam, lam_init, lds);
  }
}

#define XB_TMO      128
#define XB_XCNT(j)  (256  + 64 * (j))
#define XB_XSUB(j)  (1280 + 64 * (j))
#define XB_XGEN(j)  (2304 + 64 * (j))
#define XB_TOP      3328
#define XB_TOPGEN   3392
#define XCD_BAR_WORDS 3456
#define XB_SPIN_CAP (1u << 18)
#define LAS __attribute__((address_space(3)))
DI unsigned xb_ld(unsigned* p) { return __hip_atomic_load(p, __ATOMIC_RELAXED, __HIP_MEMORY_SCOPE_AGENT); }
DI unsigned xb_add(unsigned* p, unsigned v) { return __hip_atomic_fetch_add(p, v, __ATOMIC_RELAXED, __HIP_MEMORY_SCOPE_AGENT); }
DI unsigned xb_xcc_id() { return (unsigned)__builtin_amdgcn_s_getreg((3 << 11) | 20) & 0xFu; }
#define XB_SPIN(cond, bar) do { unsigned _sp = 0; while (cond) { __builtin_amdgcn_s_sleep(1); \
    if ((++_sp & 255u) == 0u) { if (xb_ld(&(bar)[XB_TMO])) break; if (_sp > XB_SPIN_CAP) { atomicAdd(&(bar)[XB_TMO], 1u); break; } } } } while (0)
struct XcdBarrier { unsigned* bar; unsigned x; volatile LAS unsigned* st; };
DI XcdBarrier xcd_barrier_post(unsigned* bar, volatile LAS unsigned* st) {
  XcdBarrier b; b.bar = bar; b.x = xb_xcc_id(); b.st = st;
  if (threadIdx.x == 0) (void)xb_add(&bar[XB_XCNT(b.x)], 1u);
  return b;
}
DI void xcd_barrier_complete(unsigned* bar, unsigned x, unsigned& nloc, unsigned& nx) {
  const unsigned G = gridDim.x * gridDim.y * gridDim.z;
  unsigned sum, cnt, mine, sp = 0u;
  for (;;) {
    sum = 0u; cnt = 0u; mine = 0u;
#pragma unroll
    for (unsigned j = 0; j < 16; ++j) { const unsigned c = xb_ld(&bar[XB_XCNT(j)]); sum += c; cnt += (c > 0u) ? 1u : 0u; mine = (j == x) ? c : mine; }
    if (sum == G) break;
    __builtin_amdgcn_s_sleep(1);
    if ((++sp & 255u) == 0u) { if (xb_ld(&bar[XB_TMO])) break; if (sp > XB_SPIN_CAP) { atomicAdd(&bar[XB_TMO], 1u); break; } }
  }
  nloc = mine > 0u ? mine : 1u; nx = cnt > 0u ? cnt : 1u;
}
DI void xcd_barrier(const XcdBarrier& b) {
  asm volatile("s_waitcnt vmcnt(0)" ::: "memory");
  __syncthreads();
  if (threadIdx.x == 0) {
    unsigned* bar = b.bar;
    __builtin_amdgcn_s_waitcnt(0);
    unsigned nloc = b.st[0], nx = b.st[1];
    if (nloc == 0u) { xcd_barrier_complete(bar, b.x, nloc, nx); b.st[0] = nloc; b.st[1] = nx; }
    const unsigned old = xb_add(&bar[XB_XSUB(b.x)], 1u);
    const unsigned gen = old / nloc;
    if (old + 1u == (gen + 1u) * nloc) {
      __builtin_amdgcn_fence(__ATOMIC_RELEASE, "agent");
      asm volatile("s_waitcnt vmcnt(0)" ::: "memory");
      const unsigned og = xb_add(&bar[XB_TOP], 1u);
      const unsigned tg = og / nx;
      if (og + 1u == (tg + 1u) * nx) xb_add(&bar[XB_TOPGEN], 1u);
      else XB_SPIN(xb_ld(&bar[XB_TOPGEN]) == tg, bar);
      __builtin_amdgcn_fence(__ATOMIC_ACQUIRE, "agent");
      xb_add(&bar[XB_XGEN(b.x)], 1u);
      asm volatile("s_waitcnt vmcnt(0)" ::: "memory");
    } else {
      XB_SPIN(xb_ld(&bar[XB_XGEN(b.x)]) == gen, bar);
      __builtin_amdgcn_fence(__ATOMIC_ACQUIRE, "agent");
      asm volatile("s_waitcnt vmcnt(0)" ::: "memory");
    }
  }
  __syncthreads();
}

__global__ void __launch_bounds__(NTHREADS) fwd_megakernel(Params Parg) {
  extern __shared__ __attribute__((aligned(16))) char lds[];
  __shared__ Params sP;
  __shared__ uint4 xb_words;
  if (threadIdx.x == 0) { sP = Parg; xb_words = make_uint4(0u, 0u, 0u, 0u); }
  __syncthreads();
  const Params& P = sP;
  cg::grid_group grid = cg::this_grid();
  if (blockDim.x == 12345u) grid.sync();
  (void)xcd_barrier_post((unsigned*)(Parg.ws + WS_BAR), (volatile LAS unsigned*)&xb_words);
#define GRID_BAR() do { XcdBarrier xb_; xb_.bar = (unsigned*)(P.ws + WS_BAR); xb_.x = xb_xcc_id(); xb_.st = (volatile LAS unsigned*)&xb_words; xcd_barrier(xb_); } while (0)
  MARK(0); phase_p0(P, lds);
  GRID_BAR();
#pragma unroll 1
  for (int l = 0; l < 2; ++l) {
    MARK(1); phase_norm(P, l);
    GRID_BAR(); MARK(2);
    gemm_phase<0>(P, l, (const u16*)(P.ws + WS_XN), (const u16*)(P.ws + WS_WINT) + (size_t)l * UP * 1024, 66, 25, lds);
    GRID_BAR();
    MARK(3);
    for (int t = blockIdx.x; t < 1056; t += gridDim.x) {
      const int ty = t / 264, idx = t % 264, b = idx / 132, cb = idx % 132;
      if (ty == 0) ssd_local(P, l, b, cb, lds);
      else if (ty == 1) lru_local(P, l, b, cb, lds);
      else if (ty == 2) gla_local(P, l, b, cb, lds);
      else attn_prep(P, l, idx, lds);
    }
    GRID_BAR();
    MARK(4); phase_scans(P);
    MARK(5); phase_attn(P, l, lds); MARK(6);
    GRID_BAR();
    {
      const int per = (l == 0) ? 264 : 256;
      for (int t = blockIdx.x; t < 3 * per; t += gridDim.x) {
        const int ty = t / per, idx = t % per;
        const int b = (l == 0) ? idx / 132 : (idx >> 7), cb = (l == 0) ? idx % 132 : 4 + (idx & 127);
        if (ty == 0) ssd_out(P, l, b, cb, lds);
        else if (ty == 1) lru_out(P, l, b, cb, lds);
        else gla_out(P, l, b, cb, lds);
      }
    }
    GRID_BAR();
    MARK(7); gemm_phase<1>(P, l, (const u16*)(P.ws + WS_XN), (const u16*)(P.ws + WS_WOUT) + (size_t)l * 1024 * 1024, l == 0 ? 66 : 64, 8, lds);
    GRID_BAR();
  }
  MARK(8); phase_final_norm(P);
}

extern "C" void kernel_launch(void* const* d_in, const int* in_sizes, int n_in, void* d_out, int out_size, void* d_ws, size_t ws_size, hipStream_t stream) {
  static int grid_blocks = 0;
  if (!grid_blocks) {
    int dev = 0, cus = 0, per_cu = 0;
    hipGetDevice(&dev);
    hipDeviceGetAttribute(&cus, hipDeviceAttributeMultiprocessorCount, dev);
    hipFuncSetAttribute((const void*)fwd_megakernel, hipFuncAttributeMaxDynamicSharedMemorySize, LDS_BYTES);
    hipOccupancyMaxActiveBlocksPerMultiprocessor(&per_cu, (const void*)fwd_megakernel, NTHREADS, LDS_BYTES);
    if (per_cu < 1) { fprintf(stderr, "occupancy query returned %d\n", per_cu); per_cu = 1; }
    if (per_cu > 1) per_cu = 1;
    grid_blocks = cus * per_cu;
  }
  Params p{};
  const float** pf = (const float**)&p;
  for (int i = 0; i < 28; ++i) pf[i] = (const float*)d_in[i];
  pf[28] = (const float*)d_out; pf[29] = (const float*)d_ws;
  hipMemsetAsync((char*)d_ws + WS_BAR, 0, XCD_BAR_WORDS * 4, stream);
  void* args[] = {&p};
  hipError_t e = hipLaunchCooperativeKernel((const void*)fwd_megakernel, dim3(grid_blocks), dim3(NTHREADS), args, LDS_BYTES, stream);
  if (e != hipSuccess) fprintf(stderr, "cooperative launch failed: %s (grid %d)\n", hipGetErrorString(e), grid_blocks);
}
```

```cpp
#include <hip/hip_runtime.h>
#include <hip/hip_cooperative_groups.h>
#include <cstdio>
namespace cg = cooperative_groups;

#define DI __device__ __forceinline__
typedef unsigned short u16;
typedef __attribute__((ext_vector_type(8))) short bf16x8;
typedef __attribute__((ext_vector_type(16))) float f32x16;
typedef __attribute__((ext_vector_type(4))) unsigned u32x4;
typedef __bf16 bf2_t __attribute__((ext_vector_type(2)));
typedef float fl2_t __attribute__((ext_vector_type(2)));

#define MARK(n) asm volatile("; MARK " #n)
#define MFMA32(a, b, c) __builtin_amdgcn_mfma_f32_32x32x16_bf16((a), (b), (c), 0, 0, 0)

constexpr int T = 8192, D = 1024, UP = 3200, MLAT = 16384, MTOT = 16896, NKEY = 8448, NCH = 132;
constexpr int UA_Q = 0, UA_K = 128, UA_V = 256, UA_LRF = 512, UA_G = 544;
constexpr int UB_X = 800, UB_G = 1056;
constexpr int UC_Q = 1312, UC_K = 1568, UC_V = 1824, UC_G = 2080;
constexpr int UD_XBC = 2336, UD_DTF = 2848, UD_Z = 2856;
constexpr int NTHREADS = 512;
constexpr int LDS_BYTES = 147456;

constexpr size_t WS_WINT = 0;
constexpr size_t WS_WOUT = WS_WINT + (size_t)2 * UP * 1024 * 2;
constexpr size_t WS_MOD = WS_WOUT + (size_t)2 * 1024 * 1024 * 2;
constexpr size_t WS_ROPE = WS_MOD + (size_t)2 * 3 * 3072 * 4;
constexpr size_t WS_MISC = WS_ROPE + 8192;
constexpr size_t WS_XN = WS_MISC + 4096;
constexpr size_t WS_U = WS_XN + (size_t)MTOT * 1024 * 2;
constexpr size_t WS_HCTX = WS_U + (size_t)MTOT * UP * 2;
constexpr size_t WS_Q = WS_HCTX + (size_t)512 * 1024 * 4;
constexpr size_t WS_K = WS_Q + (size_t)16 * NKEY * 32 * 2;
constexpr size_t WS_VT = WS_K + (size_t)16 * NKEY * 32 * 2;
constexpr size_t WS_GLA = WS_VT + (size_t)8 * 64 * NKEY * 2;
constexpr size_t WS_GLAD = WS_GLA + (size_t)16 * NCH * 2048 * 4;
constexpr size_t WS_SSD = WS_GLAD + (size_t)16 * NCH * 32 * 4;
constexpr size_t WS_SSDD = WS_SSD + (size_t)16 * NCH * 4096 * 4;
constexpr size_t WS_LRUA = WS_SSDD + 16384;
constexpr size_t WS_LRUU = WS_LRUA + (size_t)4 * NCH * 256 * 4;
constexpr size_t WS_BAR = WS_LRUU + (size_t)4 * NCH * 256 * 4;
constexpr size_t WS_LRUW = WS_BAR + 16384;
constexpr size_t WS_END = WS_LRUW + (size_t)64 * 4096 * 2;
static_assert(WS_END <= (size_t)256 * 1024 * 1024, "workspace");

#define GAS __attribute__((address_space(1)))
struct Params {
  const GAS float *x, *c, *ctx, *c_ctx, *w_mod, *b_mod, *norm_w, *w_in, *w_out, *gla_w2, *gla_b2, *gla_norm_w, *lru_conv_w, *lru_conv_b,
      *lru_wa, *lru_ba, *lru_wx, *lru_bx, *lru_lam, *diff_lam, *diff_subln_w, *ssd_conv_w, *ssd_conv_b, *ssd_dt_bias, *ssd_a_log, *ssd_d,
      *ssd_norm_w, *final_norm_w;
  GAS float* out;
  GAS unsigned char* ws;
};

DI unsigned pk2(float a, float b) { fl2_t v = {a, b}; return __builtin_bit_cast(unsigned, __builtin_convertvector(v, bf2_t)); }
DI u16 f2bf(float a) { return (u16)(pk2(a, 0.f) & 0xffffu); }
DI float bf2f(u16 x) { return __uint_as_float(((unsigned)x) << 16); }
DI float bflo(unsigned x) { return __uint_as_float(x << 16); }
DI float bfhi(unsigned x) { return __uint_as_float(x & 0xffff0000u); }
DI bf16x8 mk8(unsigned a, unsigned b, unsigned c, unsigned d) { u32x4 v = {a, b, c, d}; return __builtin_bit_cast(bf16x8, v); }
DI bf16x8 pack8(float a0, float a1, float a2, float a3, float a4, float a5, float a6, float a7) { return mk8(pk2(a0, a1), pk2(a2, a3), pk2(a4, a5), pk2(a6, a7)); }
template <class T> DI T* gp(GAS T* p) { return (T*)p; }
typedef __attribute__((ext_vector_type(4))) float f32x4_t;
DI float4 ld_nt(const float4* p) { const f32x4_t v = __builtin_nontemporal_load((const f32x4_t*)p); return make_float4(v.x, v.y, v.z, v.w); }
typedef __attribute__((ext_vector_type(4))) unsigned u32x4_nt;
DI uint4 ld_nt(const uint4* p) { const u32x4_nt v = __builtin_nontemporal_load((const u32x4_nt*)p); return make_uint4(v.x, v.y, v.z, v.w); }
DI int tidx() { int t = threadIdx.x; asm volatile("" : "+v"(t)); return t; }
DI int crow(int r, int hh) { return (r & 3) + 8 * (r >> 2) + 4 * hh; }
DI float siluf(float x) { return x * __builtin_amdgcn_rcpf(1.f + __expf(-x)); }
DI float sigmf(float x) { return __builtin_amdgcn_rcpf(1.f + __expf(-x)); }
DI float softplusf(float x) { return fmaxf(x, 0.f) + __logf(1.f + __expf(-fabsf(x))); }
DI float shx(float v, int m) { return __shfl_xor(v, m, 64); }
DI int blk_m0(int b, int cb) { return cb < 4 ? MLAT + b * 256 + cb * 64 : b * T + (cb - 4) * 64; }
DI int blk_ci(int cb, int dir) { return dir == 0 ? cb : (cb < 4 ? 3 - cb : 135 - cb); }

DI void p0_transpose(const float* src, int N, u16* dst, int k0, int n0, float* lds) {
  const int tid = tidx();
  float v[8];
#pragma unroll
  for (int i = 0; i < 8; ++i) { const int e = tid + i * NTHREADS, kk = e >> 6, n = n0 + (e & 63); v[i] = (n < N) ? src[(size_t)(k0 + kk) * N + n] : 0.f; }
#pragma unroll
  for (int i = 0; i < 8; ++i) { const int e = tid + i * NTHREADS; lds[(e >> 6) * 65 + (e & 63)] = v[i]; }
  __syncthreads();
#pragma unroll
  for (int e = tid; e < 2048; e += NTHREADS) { int nn = e >> 5, kp = (e & 31) * 2; *(unsigned*)(dst + (size_t)(n0 + nn) * 1024 + k0 + kp) = pk2(lds[kp * 65 + nn], lds[(kp + 1) * 65 + nn]); }
  __syncthreads();
}

DI void p0_mod(const Params& P, int l, int n0, float* lds) {
  const int tid = tidx(), col = tid & 63, kg = tid >> 6;
  for (int e = tid; e < 1024; e += NTHREADS) { lds[e] = siluf(P.c[e]); lds[1024 + e] = siluf(P.c[1024 + e]); lds[2048 + e] = siluf(P.c_ctx[e]); }
  __syncthreads();
  float a0 = 0.f, a1 = 0.f, a2 = 0.f;
  const float* wm = gp(P.w_mod + (size_t)l * 1024 * 3072 + n0 + col);
  for (int k0 = kg * 128; k0 < kg * 128 + 128; k0 += 16) {
    float w[16];
#pragma unroll
    for (int j = 0; j < 16; ++j) w[j] = wm[(size_t)(k0 + j) * 3072];
#pragma unroll
    for (int j = 0; j < 16; ++j) { a0 += lds[k0 + j] * w[j]; a1 += lds[1024 + k0 + j] * w[j]; a2 += lds[2048 + k0 + j] * w[j]; }
  }
  float* red = lds + 3072;
  red[(kg * 3 + 0) * 64 + col] = a0; red[(kg * 3 + 1) * 64 + col] = a1; red[(kg * 3 + 2) * 64 + col] = a2;
  __syncthreads();
  if (tid < 192) {
    int j = tid >> 6; float sacc = P.b_mod[l * 3072 + n0 + col];
    for (int g = 0; g < 8; ++g) sacc += red[(g * 3 + j) * 64 + col];
    ((float*)(P.ws + WS_MOD))[(l * 3 + j) * 3072 + n0 + col] = sacc;
  }
  __syncthreads();
}

DI void phase_p0(const Params& P, char* lds) {
  float* fl = (float*)lds;
  for (int t0 = blockIdx.x; t0 < 2273; t0 += gridDim.x) {
    if (t0 >= 2209) {
      const int mid = t0 - 2209, gate = mid & 1, ldg = mid >> 1, tid = tidx();
      const float* wsrc = gp((gate ? P.lru_wx : P.lru_wa) + (size_t)ldg * 4096);
      const int lane = tid & 63, ct = (tid >> 6) & 1, ks = tid >> 7, c31 = lane & 31, hh = lane >> 5;
      float v[8];
#pragma unroll
      for (int e = 0; e < 8; ++e) v[e] = wsrc[(ks * 16 + hh * 8 + e) * 64 + ct * 32 + c31];
      uint4 o; o.x = pk2(v[0], v[1]); o.y = pk2(v[2], v[3]); o.z = pk2(v[4], v[5]); o.w = pk2(v[6], v[7]);
      *(uint4*)((u16*)(P.ws + WS_LRUW) + (size_t)mid * 4096 + tid * 8) = o;
      continue;
    }
    const int t = t0 < 96 ? 2112 + t0 : (t0 < 2208 ? t0 - 96 : t0);
    if (t < 1600) { int l = t / 800, rem = t % 800; p0_transpose(gp(P.w_in + (size_t)l * 1024 * 3112), 3112, (u16*)(P.ws + WS_WINT) + (size_t)l * UP * 1024, (rem & 15) * 64, (rem >> 4) * 64, fl); }
    else if (t < 2112) { int t2 = t - 1600; int l = t2 >> 8, rem = t2 & 255; p0_transpose(gp(P.w_out + (size_t)l * 1024 * 1024), 1024, (u16*)(P.ws + WS_WOUT) + (size_t)l * 1024 * 1024, (rem & 15) * 64, (rem >> 4) * 64, fl); }
    else if (t < 2208) { int t2 = t - 2112; p0_mod(P, t2 / 48, (t2 % 48) * 64, fl); }
    else {
      float* rope = (float*)(P.ws + WS_ROPE);
      const int tid = tidx();
      for (int e = tid; e < 1024; e += NTHREADS) { int pos = e >> 3, f = e & 7; float inv = exp2f(-(float)f * (13.287712379549449f / 8.f)); float ang = (float)pos * inv; rope[e] = __cosf(ang); rope[1024 + e] = __sinf(ang); }
      if (tid < 64) ((unsigned*)(P.ws + WS_MISC))[tid] = 0u;
    }
  }
}

DI const float* h_row(const Params& P, int l, int m) {
  if (l == 0) return gp(m < MLAT ? P.x + (size_t)m * 1024 : P.ctx + (size_t)(m - MLAT) * 1024);
  return m < MLAT ? (const float*)(P.out + (size_t)m * 1024) : (const float*)(P.ws + WS_HCTX) + (size_t)(m - MLAT) * 1024;
}

DI void phase_norm(const Params& P, int l) {
  const int tid_ = tidx(); const int w = tid_ >> 6, lane = tid_ & 63;
  u16* xn = (u16*)(P.ws + WS_XN);
  for (int row = blockIdx.x * 8 + w; row < MTOT; row += gridDim.x * 8) {
    const float4* src = (const float4*)h_row(P, l, row);
    const int j = row < MLAT ? (row >> 13) : 2;
    const float* mod = (const float*)(P.ws + WS_MOD) + (l * 3 + j) * 3072;
    float4 v[4]; float ss = 0.f;
#pragma unroll
    for (int i = 0; i < 4; ++i) { v[i] = ld_nt(src + i * 64 + lane); ss += v[i].x * v[i].x + v[i].y * v[i].y + v[i].z * v[i].z + v[i].w * v[i].w; }
#pragma unroll
    for (int s = 32; s >= 1; s >>= 1) ss += shx(ss, s);
    const float rstd = rsqrtf(ss * (1.f / 1024.f) + 1e-6f);
#pragma unroll
    for (int i = 0; i < 4; ++i) {
      const int k = (i * 64 + lane) * 4;
      float4 nw = *(const float4*)(P.norm_w + l * 1024 + k), sc = *(const float4*)(mod + 1024 + k), sh = *(const float4*)(mod + k);
      float y0 = v[i].x * rstd * nw.x * (1.f + sc.x) + sh.x, y1 = v[i].y * rstd * nw.y * (1.f + sc.y) + sh.y;
      float y2 = v[i].z * rstd * nw.z * (1.f + sc.z) + sh.z, y3 = v[i].w * rstd * nw.w * (1.f + sc.w) + sh.w;
      uint2 o; o.x = pk2(y0, y1); o.y = pk2(y2, y3);
      *(uint2*)(xn + (size_t)row * 1024 + k) = o;
    }
  }
}

DI void phase_final_norm(const Params& P) {
  const int tid_ = tidx(); const int w = tid_ >> 6, lane = tid_ & 63;
  for (int row = blockIdx.x * 8 + w; row < MLAT; row += gridDim.x * 8) {
    float4* src = (float4*)(P.out + (size_t)row * 1024);
    float4 v[4]; float ss = 0.f;
#pragma unroll
    for (int i = 0; i < 4; ++i) { v[i] = ld_nt(src + i * 64 + lane); ss += v[i].x * v[i].x + v[i].y * v[i].y + v[i].z * v[i].z + v[i].w * v[i].w; }
#pragma unroll
    for (int s = 32; s >= 1; s >>= 1) ss += shx(ss, s);
    const float rstd = rsqrtf(ss * (1.f / 1024.f) + 1e-6f);
#pragma unroll
    for (int i = 0; i < 4; ++i) {
      float4 nw = *(const float4*)(P.final_norm_w + (i * 64 + lane) * 4);
      float4 o; o.x = v[i].x * rstd * nw.x; o.y = v[i].y * rstd * nw.y; o.z = v[i].z * rstd * nw.z; o.w = v[i].w * rstd * nw.w;
      src[i * 64 + lane] = o;
    }
  }
}

constexpr int GS = 72;
template <int EPI>
DI void gemm_phase(const Params& P, int l, const u16* A, const u16* Bt, int mtiles, int ntiles, char* lds) {
  const int tid = tidx(), w = tid >> 6, lane = tid & 63, c31 = lane & 31, hh = lane >> 5, wm = w >> 1, wn = w & 1;
  const int lrow = tid >> 3, lcol = (tid & 7) * 8;
  const int ntot = mtiles * ntiles;
  const bool swz = (gridDim.x == 256);
  const int xcd = blockIdx.x & 7, jloc = blockIdx.x >> 3;
  const int per = (ntot + 7) >> 3, qbeg = xcd * per, qend = min(ntot, qbeg + per);
  for (int it = 0;; ++it) {
    int tm, tn;
    if (swz) {
      const int q = qbeg + jloc + 32 * it;
      if (q >= qend) break;
      const int band = q / (4 * ntiles), within = q - band * 4 * ntiles;
      const int rows = min(4, mtiles - band * 4);
      tn = within / rows; tm = band * 4 + (within - tn * rows);
    } else {
      const int tile = blockIdx.x + it * gridDim.x;
      if (tile >= ntot) break;
      tm = tile / ntiles; tn = tile % ntiles;
    }
    const int m0 = tm * 256, n0 = tn * 128;
    f32x16 acc[2][2];
#pragma unroll
    for (int i = 0; i < 2; ++i)
#pragma unroll
      for (int j = 0; j < 2; ++j)
#pragma unroll
        for (int r = 0; r < 16; ++r) acc[i][j][r] = 0.f;
    const u16* ga = A + (size_t)(m0 + lrow) * 1024 + lcol;
    const u16* gb = Bt + (size_t)(n0 + lrow) * 1024 + lcol;
    uint4 ra0, ra1, ra2, ra3, rb0, rb1, rc0, rc1, rc2, rc3, rd0, rd1;
#define G_LOAD(A0, A1, A2, A3, B0, B1, ko) { A0 = *(const uint4*)(ga + (ko)); A1 = *(const uint4*)(ga + (size_t)64 * 1024 + (ko)); A2 = *(const uint4*)(ga + (size_t)128 * 1024 + (ko)); A3 = *(const uint4*)(ga + (size_t)192 * 1024 + (ko)); \
      B0 = *(const uint4*)(gb + (ko)); B1 = *(const uint4*)(gb + (size_t)64 * 1024 + (ko)); }
#define G_STORE(A0, A1, A2, A3, B0, B1, buf) { u16* nA = (u16*)(lds + (buf) * 55296); u16* nB = (u16*)(lds + (buf) * 55296 + 36864); \
      *(uint4*)(nA + (lrow) * GS + lcol) = A0; *(uint4*)(nA + (lrow + 64) * GS + lcol) = A1; *(uint4*)(nA + (lrow + 128) * GS + lcol) = A2; *(uint4*)(nA + (lrow + 192) * GS + lcol) = A3; \
      *(uint4*)(nB + (lrow) * GS + lcol) = B0; *(uint4*)(nB + (lrow + 64) * GS + lcol) = B1; }
#define G_READ(buf) { const u16* sA = (const u16*)(lds + (buf) * 55296); const u16* sB = (const u16*)(lds + (buf) * 55296 + 36864); \
      _Pragma("unroll") for (int ks = 0; ks < 4; ++ks) { \
        af[ks][0] = *(const bf16x8*)(sA + (wm * 64 + c31) * GS + ks * 16 + hh * 8); af[ks][1] = *(const bf16x8*)(sA + (wm * 64 + 32 + c31) * GS + ks * 16 + hh * 8); \
        bfr[ks][0] = *(const bf16x8*)(sB + (wn * 64 + c31) * GS + ks * 16 + hh * 8); bfr[ks][1] = *(const bf16x8*)(sB + (wn * 64 + 32 + c31) * GS + ks * 16 + hh * 8); } \
      __builtin_amdgcn_sched_barrier(0); }
#define G_MMA() { __builtin_amdgcn_sched_barrier(0); \
      _Pragma("unroll") for (int ks = 0; ks < 4; ++ks) { \
        acc[0][0] = MFMA32(af[ks][0], bfr[ks][0], acc[0][0]); acc[0][1] = MFMA32(af[ks][0], bfr[ks][1], acc[0][1]); \
        acc[1][0] = MFMA32(af[ks][1], bfr[ks][0], acc[1][0]); acc[1][1] = MFMA32(af[ks][1], bfr[ks][1], acc[1][1]); } \
      __builtin_amdgcn_sched_barrier(0); }
    bf16x8 af[4][2], bfr[4][2];
#define S0 ra0, ra1, ra2, ra3, rb0, rb1
#define S1 rc0, rc1, rc2, rc3, rd0, rd1
#define GX(M, ...) M(__VA_ARGS__)
#define TK(t) (min((t), 15) * 64)
    if (w < 4) {
      GX(G_LOAD, S0, 0); GX(G_LOAD, S1, 64);
      GX(G_STORE, S0, 0); GX(G_STORE, S1, 1);
      GX(G_LOAD, S0, 128); GX(G_LOAD, S1, 192);
      __syncthreads();
      G_READ(0);
#pragma unroll 1
      for (int kt = 0; kt < 16; kt += 2) {
        G_MMA();
        __syncthreads();
        G_READ(1);
        if (kt + 2 < 16) GX(G_STORE, S0, 0);
        GX(G_LOAD, S0, TK(kt + 4));
        __syncthreads();
        G_MMA();
        __syncthreads();
        if (kt + 2 < 16) { G_READ(0); }
        if (kt + 3 < 16) GX(G_STORE, S1, 1);
        GX(G_LOAD, S1, TK(kt + 5));
        __syncthreads();
      }
    } else {
      GX(G_LOAD, S0, 0);
      GX(G_STORE, S0, 0);
      GX(G_LOAD, S1, 64); GX(G_LOAD, S0, 128);
      __syncthreads();
#pragma unroll 1
      for (int kt = 0; kt < 16; kt += 2) {
        G_READ(0);
        GX(G_STORE, S1, 1);
        GX(G_LOAD, S1, TK(kt + 3));
        __syncthreads();
        G_MMA();
        __syncthreads();
        G_READ(1);
        if (kt + 2 < 16) GX(G_STORE, S0, 0);
        GX(G_LOAD, S0, TK(kt + 4));
        __syncthreads();
        G_MMA();
        __syncthreads();
      }
    }
#undef GX
#undef S0
#undef S1
#undef TK
#undef G_READ
#undef G_MMA
#undef G_LOAD
#undef G_STORE
#undef G_COMPUTE
    if (EPI == 0) {
      u16* st = (u16*)(lds + 55296 + w * 9216);
#pragma unroll
      for (int i = 0; i < 2; ++i)
#pragma unroll
        for (int j = 0; j < 2; ++j)
#pragma unroll
          for (int r = 0; r < 16; ++r) st[(i * 32 + crow(r, hh)) * 72 + j * 32 + c31] = f2bf(acc[i][j][r]);
      u16* U = (u16*)(P.ws + WS_U) + (size_t)(m0 + wm * 64) * UP + n0 + wn * 64;
#pragma unroll
      for (int q = 0; q < 8; ++q) {
        const int idx = q * 64 + lane, row = idx >> 3, part = idx & 7;
        *(uint4*)(U + (size_t)row * UP + part * 8) = *(const uint4*)(st + row * 72 + part * 8);
      }
      __syncthreads();
    } else {
      float* st = (float*)(lds + w * 17408);
#pragma unroll
      for (int i = 0; i < 2; ++i)
#pragma unroll
        for (int j = 0; j < 2; ++j)
#pragma unroll
          for (int r = 0; r < 16; ++r) st[(i * 32 + crow(r, hh)) * 68 + j * 32 + c31] = acc[i][j][r];
      const int mrow0 = m0 + wm * 64, ncol = n0 + wn * 64 + (lane & 15) * 4;
      const int jm = mrow0 < MLAT ? (mrow0 >> 13) : 2;
      const float4 gate = *(const float4*)((const float*)(P.ws + WS_MOD) + (l * 3 + jm) * 3072 + 2048 + ncol);
#pragma unroll
      for (int half = 0; half < 2; ++half) {
        float4 hv[8];
#pragma unroll
        for (int q = 0; q < 8; ++q) { const int row = (half * 8 + q) * 4 + (lane >> 4); hv[q] = ld_nt((const float4*)(h_row(P, l, mrow0 + row) + ncol)); }
#pragma unroll
        for (int q = 0; q < 8; ++q) {
          const int row = (half * 8 + q) * 4 + (lane >> 4), m = mrow0 + row;
          const float4 a = *(const float4*)(st + row * 68 + (lane & 15) * 4);
          float4 o; o.x = hv[q].x + gate.x * a.x; o.y = hv[q].y + gate.y * a.y; o.z = hv[q].z + gate.z * a.z; o.w = hv[q].w + gate.w * a.w;
          float* dst = m < MLAT ? (float*)(P.out + (size_t)m * 1024 + ncol) : (float*)(P.ws + WS_HCTX) + (size_t)(m - MLAT) * 1024 + ncol;
          *(float4*)dst = o;
        }
      }
      __syncthreads();
    }
  }
}

DI void attn_prep(const Params& P, int l, int unit, char* lds) {
  const int tid = tidx(); const int gid = unit * NTHREADS + tid;
  const int m = gid >> 3, h = (gid >> 1) & 3, c = gid & 1;
  const u16* urow = (const u16*)(P.ws + WS_U) + (size_t)m * UP;
  float q[32], k[32];
  {
    const uint4* qs = (const uint4*)(urow + UC_Q + h * 64 + c * 32); const uint4* ks = (const uint4*)(urow + UC_K + h * 64 + c * 32);
#pragma unroll
    for (int i = 0; i < 4; ++i) {
      uint4 a = qs[i], b = ks[i];
      q[i * 8 + 0] = bflo(a.x); q[i * 8 + 1] = bfhi(a.x); q[i * 8 + 2] = bflo(a.y); q[i * 8 + 3] = bfhi(a.y); q[i * 8 + 4] = bflo(a.z); q[i * 8 + 5] = bfhi(a.z); q[i * 8 + 6] = bflo(a.w); q[i * 8 + 7] = bfhi(a.w);
      k[i * 8 + 0] = bflo(b.x); k[i * 8 + 1] = bfhi(b.x); k[i * 8 + 2] = bflo(b.y); k[i * 8 + 3] = bfhi(b.y); k[i * 8 + 4] = bflo(b.z); k[i * 8 + 5] = bfhi(b.z); k[i * 8 + 6] = bflo(b.w); k[i * 8 + 7] = bfhi(b.w);
    }
  }
  const bool lat = m < MLAT;
  const int b = lat ? (m >> 13) : ((m - MLAT) >> 8), t = lat ? (m & 8191) : ((m - MLAT) & 255);
  if (lat) {
    const float* rc = (const float*)(P.ws + WS_ROPE); const float* rs = rc + 1024;
#pragma unroll
    for (int a = 0; a < 2; ++a) {
      const int pos = a ? (t & 63) : (t >> 6);
#pragma unroll
      for (int f = 0; f < 8; ++f) {
        const float cs = rc[pos * 8 + f], sn = rs[pos * 8 + f];
        float x0 = q[a * 16 + f], x1 = q[a * 16 + 8 + f]; q[a * 16 + f] = x0 * cs - x1 * sn; q[a * 16 + 8 + f] = x1 * cs + x0 * sn;
        x0 = k[a * 16 + f]; x1 = k[a * 16 + 8 + f]; k[a * 16 + f] = x0 * cs - x1 * sn; k[a * 16 + 8 + f] = x1 * cs + x0 * sn;
      }
    }
  }
  const int pos = lat ? t : 8192 + t;
  const float QS = 0.17677669529663687f * 1.4426950408889634f;
  float k2 = 0.f;
  u16* qd = (u16*)(P.ws + WS_Q) + ((size_t)((b * 4 + h) * 2 + c) * NKEY + pos) * 32;
  u16* kd = (u16*)(P.ws + WS_K) + ((size_t)((b * 4 + h) * 2 + c) * NKEY + pos) * 32;
#pragma unroll
  for (int i = 0; i < 4; ++i) {
    uint4 a, bb;
    a.x = pk2(q[i * 8 + 0] * QS, q[i * 8 + 1] * QS); a.y = pk2(q[i * 8 + 2] * QS, q[i * 8 + 3] * QS); a.z = pk2(q[i * 8 + 4] * QS, q[i * 8 + 5] * QS); a.w = pk2(q[i * 8 + 6] * QS, q[i * 8 + 7] * QS);
    bb.x = pk2(k[i * 8 + 0], k[i * 8 + 1]); bb.y = pk2(k[i * 8 + 2], k[i * 8 + 3]); bb.z = pk2(k[i * 8 + 4], k[i * 8 + 5]); bb.w = pk2(k[i * 8 + 6], k[i * 8 + 7]);
    ((uint4*)qd)[i] = a; ((uint4*)kd)[i] = bb;
  }
#pragma unroll
  for (int i = 0; i < 32; ++i) k2 += k[i] * k[i];
  k2 = fmaxf(k2, shx(k2, 8)); k2 = fmaxf(k2, shx(k2, 16)); k2 = fmaxf(k2, shx(k2, 32));
  float* kred = (float*)(lds + 40960);
  if ((tid & 63) < 8) kred[(tid >> 6) * 8 + (tid & 7)] = k2;
  {
    u16* vt = (u16*)lds;
    const uint4* vs = (const uint4*)(urow + UC_V + h * 64 + c * 32);
    const int p64 = pos & 63, within = p64 & 15, hh = (within >> 2) & 1, jj = ((within >> 3) << 2) | (within & 3);
    const int col = (p64 & ~15) + 8 * hh + jj;
    u16* vd = vt + (h * 64 + c * 32) * 72 + col;
#pragma unroll
    for (int i = 0; i < 4; ++i) {
      uint4 a = vs[i];
      vd[(i * 8 + 0) * 72] = (u16)(a.x & 0xffff); vd[(i * 8 + 1) * 72] = (u16)(a.x >> 16);
      vd[(i * 8 + 2) * 72] = (u16)(a.y & 0xffff); vd[(i * 8 + 3) * 72] = (u16)(a.y >> 16);
      vd[(i * 8 + 4) * 72] = (u16)(a.z & 0xffff); vd[(i * 8 + 5) * 72] = (u16)(a.z >> 16);
      vd[(i * 8 + 6) * 72] = (u16)(a.w & 0xffff); vd[(i * 8 + 7) * 72] = (u16)(a.w >> 16);
    }
    __syncthreads();
    const int m0u = unit * 64;
    const int bu = m0u < MLAT ? (m0u >> 13) : ((m0u - MLAT) >> 8), pos0 = m0u < MLAT ? (m0u & 8191) : 8192 + ((m0u - MLAT) & 255);
    u16* Vg = (u16*)(P.ws + WS_VT) + (size_t)(bu * 4) * 64 * NKEY + pos0;
#pragma unroll
    for (int q = 0; q < 4; ++q) {
      const int idx = tid + q * NTHREADS, row = idx >> 3, part = idx & 7;
      *(uint4*)(Vg + (size_t)row * NKEY + part * 8) = *(const uint4*)(vt + row * 72 + part * 8);
    }
    if (tid < 8) {
      float mx = 0.f;
#pragma unroll
      for (int w8 = 0; w8 < 8; ++w8) mx = fmaxf(mx, kred[w8 * 8 + tid]);
      atomicMax((unsigned*)(P.ws + WS_MISC) + ((l * 2 + bu) * 4 + (tid >> 1)) * 2 + (tid & 1), __float_as_uint(mx));
    }
    __syncthreads();
  }
}

constexpr int QP = 136, GP = 129, GLA_SG = 2 * 64 * QP * 2 + 64 * 256 * 2, GLA_SLR = GLA_SG + 2 * 64 * GP * 4;
DI void gla_stage(const Params& P, int l, int b, int cb, char* lds) {
  u16* sq = (u16*)lds; u16* sk = sq + 64 * QP; u16* sv = sk + 64 * QP; float* sg = (float*)(lds + GLA_SG); float* slr = (float*)(lds + GLA_SLR);
  const int tid = tidx(), m0 = blk_m0(b, cb);
  const u16* U = (const u16*)(P.ws + WS_U);
#pragma unroll
  for (int e = tid; e < 1024; e += NTHREADS) {
    int t = e >> 4, part = e & 15; const u16* row = U + (size_t)(m0 + t) * UP;
    *(uint4*)(sq + t * QP + part * 8) = *(const uint4*)(row + UA_Q + part * 8);
    *(uint4*)(sk + t * QP + part * 8) = *(const uint4*)(row + UA_K + part * 8);
  }
#pragma unroll
  for (int e = tid; e < 2048; e += NTHREADS) { int t = e >> 5, part = e & 31; *(uint4*)(sv + t * 256 + part * 8) = *(const uint4*)(U + (size_t)(m0 + t) * UP + UA_V + part * 8); }
  {
    int t = tid >> 3, part = tid & 7;
    uint2 v = *(const uint2*)(U + (size_t)(m0 + t) * UP + UA_LRF + part * 4);
    int dir = part >> 2, r0 = (part & 3) * 4; float* d = slr + (dir * 64 + t) * 16 + r0;
    d[0] = bflo(v.x); d[1] = bfhi(v.x); d[2] = bflo(v.y); d[3] = bfhi(v.y);
  }
  __syncthreads();
  {
    const int hk = tid & 127, tq = tid >> 7;
#pragma unroll
    for (int dir = 0; dir < 2; ++dir) {
      float wv[16];
#pragma unroll
      for (int r = 0; r < 16; ++r) wv[r] = P.gla_w2[((l * 2 + dir) * 16 + r) * 128 + hk];
      const float bb = P.gla_b2[(l * 2 + dir) * 128 + hk];
      for (int t = tq; t < 64; t += 4) {
        const float* lr = slr + (dir * 64 + t) * 16; float z = bb;
#pragma unroll
        for (int r = 0; r < 16; ++r) z += lr[r] * wv[r];
        const float ls = fminf(z, 0.f) - __logf(1.f + __expf(-fabsf(z)));
        sg[(dir * 64 + t) * GP + hk] = ls * (1.f / 16.f);
      }
    }
  }
  __syncthreads();
  if (tid < 256) {
    const int dir = tid >> 7, hk = tid & 127; float s = 0.f;
    float* col = sg + dir * 64 * GP + hk; float v[64];
#pragma unroll
    for (int t = 0; t < 64; ++t) v[t] = col[t * GP];
    if (dir == 0) {
#pragma unroll
      for (int t = 0; t < 64; ++t) { s += v[t]; col[t * GP] = s; }
    } else {
#pragma unroll
      for (int t = 63; t >= 0; --t) { s += v[t]; col[t * GP] = s; }
    }
  }
  __syncthreads();
}

DI void gla_local(const Params& P, int l, int b, int cb, char* lds) {
  gla_stage(P, l, b, cb, lds);
  const u16* sk = (const u16*)lds + 64 * QP; const u16* sv = sk + 64 * QP; const float* sg = (const float*)(lds + GLA_SG);
  const int tid = tidx(), w = tid >> 6, lane = tid & 63, c31 = lane & 31, hh = lane >> 5, dir = w >> 2, h = w & 3;
  const float* g = sg + dir * 64 * GP;
  const float glast = g[(dir ? 0 : 63) * GP + h * 32 + c31];
  f32x16 acc[2];
#pragma unroll
  for (int r = 0; r < 16; ++r) { acc[0][r] = 0.f; acc[1][r] = 0.f; }
#pragma unroll
  for (int ks = 0; ks < 4; ++ks) {
    float av[8];
#pragma unroll
    for (int e = 0; e < 8; ++e) { const int j = ks * 16 + hh * 8 + e; av[e] = bf2f(sk[j * QP + h * 32 + c31]) * __expf(glast - g[j * GP + h * 32 + c31]); }
    const bf16x8 a = pack8(av[0], av[1], av[2], av[3], av[4], av[5], av[6], av[7]);
#pragma unroll
    for (int vt = 0; vt < 2; ++vt) {
      bf16x8 bv;
#pragma unroll
      for (int e = 0; e < 8; ++e) bv[e] = (short)sv[(ks * 16 + hh * 8 + e) * 256 + h * 64 + vt * 32 + c31];
      acc[vt] = MFMA32(a, bv, acc[vt]);
    }
  }
  const int seq = (b * 2 + dir) * 4 + h, ci = blk_ci(cb, dir);
  u16* dst = (u16*)(P.ws + WS_GLA) + (size_t)(seq * NCH + ci) * 2048;
#pragma unroll
  for (int vt = 0; vt < 2; ++vt)
#pragma unroll
    for (int r = 0; r < 16; ++r) dst[crow(r, hh) * 64 + vt * 32 + c31] = f2bf(acc[vt][r]);
  if (hh == 0) ((float*)(P.ws + WS_GLAD))[(seq * NCH + ci) * 32 + c31] = __expf(glast);
  __syncthreads();
}

DI void gla_out(const Params& P, int l, int b, int cb, char* lds) {
  gla_stage(P, l, b, cb, lds);
  const u16* sq = (const u16*)lds; const u16* sk = sq + 64 * QP; const u16* sv = sk + 64 * QP; const float* sg = (const float*)(lds + GLA_SG);
  const int tid = tidx(), w = tid >> 6, lane = tid & 63, c31 = lane & 31, hh = lane >> 5, dir = w >> 2, h = w & 3;
  const float* g = sg + dir * 64 * GP;
  const int seq = (b * 2 + dir) * 4 + h, ci = blk_ci(cb, dir), m0 = blk_m0(b, cb);
  const u16* Sin = (const u16*)(P.ws + WS_GLA) + (size_t)(seq * NCH + ci) * 2048;
  f32x16 o[2][2];
#pragma unroll
  for (int a = 0; a < 2; ++a)
#pragma unroll
    for (int bb = 0; bb < 2; ++bb)
#pragma unroll
      for (int r = 0; r < 16; ++r) o[a][bb][r] = 0.f;
  bf16x8 qg[2][2];
#pragma unroll
  for (int it = 0; it < 2; ++it)
#pragma unroll
    for (int ks = 0; ks < 2; ++ks) {
      float v[8]; const int i = it * 32 + c31;
#pragma unroll
      for (int e = 0; e < 8; ++e) { const int kk = h * 32 + ks * 16 + hh * 8 + e; v[e] = bf2f(sq[i * QP + kk]) * __expf(g[i * GP + kk]) * 0.17677669529663687f; }
      qg[it][ks] = pack8(v[0], v[1], v[2], v[3], v[4], v[5], v[6], v[7]);
    }
#pragma unroll
  for (int ks = 0; ks < 2; ++ks)
#pragma unroll
    for (int vt = 0; vt < 2; ++vt) {
      bf16x8 sa;
#pragma unroll
      for (int e = 0; e < 8; ++e) sa[e] = (short)Sin[(ks * 16 + hh * 8 + e) * 64 + vt * 32 + c31];
#pragma unroll
      for (int it = 0; it < 2; ++it) o[vt][it] = MFMA32(sa, qg[it][ks], o[vt][it]);
    }
#pragma unroll
  for (int jt = 0; jt < 2; ++jt) {
    bf16x8 kg[2];
#pragma unroll
    for (int ks = 0; ks < 2; ++ks) {
      float v[8]; const int j = jt * 32 + c31;
#pragma unroll
      for (int e = 0; e < 8; ++e) { const int kk = h * 32 + ks * 16 + hh * 8 + e; v[e] = bf2f(sk[j * QP + kk]) * __expf(-g[j * GP + kk]); }
      kg[ks] = pack8(v[0], v[1], v[2], v[3], v[4], v[5], v[6], v[7]);
    }
#pragma unroll
    for (int it = 0; it < 2; ++it) {
      const bool skip = dir == 0 ? (jt > it) : (jt < it);
      if (skip) continue;
      f32x16 s;
#pragma unroll
      for (int r = 0; r < 16; ++r) s[r] = 0.f;
      s = MFMA32(kg[0], qg[it][0], s); s = MFMA32(kg[1], qg[it][1], s);
      const int i = it * 32 + c31;
#pragma unroll
      for (int r = 0; r < 16; ++r) { const int j = jt * 32 + crow(r, hh); const bool keep = dir == 0 ? (j <= i) : (j >= i); s[r] = keep ? s[r] : 0.f; }
      const bf16x8 p0 = pack8(s[0], s[1], s[2], s[3], s[4], s[5], s[6], s[7]), p1 = pack8(s[8], s[9], s[10], s[11], s[12], s[13], s[14], s[15]);
#pragma unroll
      for (int s2 = 0; s2 < 2; ++s2)
#pragma unroll
        for (int vt = 0; vt < 2; ++vt) {
          bf16x8 va;
#pragma unroll
          for (int e = 0; e < 8; ++e) { const int j = jt * 32 + 16 * s2 + 8 * (e >> 2) + 4 * hh + (e & 3); va[e] = (short)sv[j * 256 + h * 64 + vt * 32 + c31]; }
          o[vt][it] = MFMA32(va, s2 ? p1 : p0, o[vt][it]);
        }
    }
  }
  __syncthreads();
  float* xb = (float*)(lds + GLA_SG);
  if (dir == 1) {
#pragma unroll
    for (int vt = 0; vt < 2; ++vt)
#pragma unroll
      for (int it = 0; it < 2; ++it)
#pragma unroll
        for (int r = 0; r < 16; ++r) xb[(it * 32 + c31) * 257 + h * 64 + vt * 32 + crow(r, hh)] = o[vt][it][r];
  }
  __syncthreads();
  if (dir == 0) {
#pragma unroll
    for (int vt = 0; vt < 2; ++vt)
#pragma unroll
      for (int it = 0; it < 2; ++it)
#pragma unroll
        for (int r = 0; r < 16; ++r) xb[(it * 32 + c31) * 257 + h * 64 + vt * 32 + crow(r, hh)] += o[vt][it][r];
  }
  __syncthreads();
  {
    const u16* U = (const u16*)(P.ws + WS_U); u16* Y = (u16*)(P.ws + WS_XN);
#pragma unroll
    for (int q = 0; q < 4; ++q) {
      const int idx = tid + q * NTHREADS, row = idx >> 5, ch0 = (idx & 31) * 8; const size_t m = (size_t)(m0 + row);
      const uint4 gv = ld_nt((const uint4*)(U + m * UP + UA_G + ch0));
      float v[8]; float ss = 0.f;
#pragma unroll
      for (int e = 0; e < 8; ++e) { v[e] = xb[row * 257 + ch0 + e]; ss += v[e] * v[e]; }
      ss += shx(ss, 1); ss += shx(ss, 2); ss += shx(ss, 4);
      const float rstd = rsqrtf(ss * (1.f / 64.f) + 1e-6f);
      const float4 n0 = *(const float4*)(P.gla_norm_w + l * 64 + (ch0 & 63)), n1 = *(const float4*)(P.gla_norm_w + l * 64 + (ch0 & 63) + 4);
      uint4 ov;
      ov.x = pk2(v[0] * rstd * n0.x * siluf(bflo(gv.x)), v[1] * rstd * n0.y * siluf(bfhi(gv.x)));
      ov.y = pk2(v[2] * rstd * n0.z * siluf(bflo(gv.y)), v[3] * rstd * n0.w * siluf(bfhi(gv.y)));
      ov.z = pk2(v[4] * rstd * n1.x * siluf(bflo(gv.z)), v[5] * rstd * n1.y * siluf(bfhi(gv.z)));
      ov.w = pk2(v[6] * rstd * n1.z * siluf(bflo(gv.w)), v[7] * rstd * n1.w * siluf(bfhi(gv.w)));
      *(uint4*)(Y + m * 1024 + ch0) = ov;
    }
  }
  __syncthreads();
}

constexpr int SXP = 520;
DI void ssd_stage(const Params& P, int l, int b, int cb, char* lds) {
  u16* sx = (u16*)lds; float* scum = (float*)(lds + 132352); float* sdt = scum + 512;
  const int tid = tidx(), m0 = blk_m0(b, cb);
  const u16* U = (const u16*)(P.ws + WS_U);
  const int tseq0 = cb < 4 ? cb * 64 : (cb - 4) * 64, slen = cb < 4 ? 256 : T, mseq0 = cb < 4 ? MLAT + b * 256 : b * T;
  {
    const int ch0 = (tid & 63) * 8;
    float wt[4][8], bs[8];
    { const float4 b0 = *(const float4*)(P.ssd_conv_b + l * 512 + ch0), b1 = *(const float4*)(P.ssd_conv_b + l * 512 + ch0 + 4);
      bs[0] = b0.x; bs[1] = b0.y; bs[2] = b0.z; bs[3] = b0.w; bs[4] = b1.x; bs[5] = b1.y; bs[6] = b1.z; bs[7] = b1.w; }
#pragma unroll
    for (int j = 0; j < 4; ++j) {
      const float* wj = gp(P.ssd_conv_w + (l * 4 + j) * 512 + ch0); const float4 w0 = *(const float4*)wj, w1 = *(const float4*)(wj + 4);
      wt[j][0] = w0.x; wt[j][1] = w0.y; wt[j][2] = w0.z; wt[j][3] = w0.w; wt[j][4] = w1.x; wt[j][5] = w1.y; wt[j][6] = w1.z; wt[j][7] = w1.w;
    }
#pragma unroll 2
    for (int t = tid >> 6; t < 64; t += 8) {
      float acc[8];
#pragma unroll
      for (int i = 0; i < 8; ++i) acc[i] = bs[i];
#pragma unroll
      for (int j = 0; j < 4; ++j) {
        const int ts = tseq0 + t - 2 + j;
        if (ts >= 0 && ts < slen) {
          const uint4 v = *(const uint4*)(U + (size_t)(mseq0 + ts) * UP + UD_XBC + ch0);
          acc[0] += bflo(v.x) * wt[j][0]; acc[1] += bfhi(v.x) * wt[j][1]; acc[2] += bflo(v.y) * wt[j][2]; acc[3] += bfhi(v.y) * wt[j][3];
          acc[4] += bflo(v.z) * wt[j][4]; acc[5] += bfhi(v.z) * wt[j][5]; acc[6] += bflo(v.w) * wt[j][6]; acc[7] += bfhi(v.w) * wt[j][7];
        }
      }
      uint4 o; o.x = pk2(siluf(acc[0]), siluf(acc[1])); o.y = pk2(siluf(acc[2]), siluf(acc[3])); o.z = pk2(siluf(acc[4]), siluf(acc[5])); o.w = pk2(siluf(acc[6]), siluf(acc[7]));
      *(uint4*)(sx + t * SXP + ch0) = o;
    }
  }
  {
    const int dir = tid >> 8, t = (tid >> 2) & 63, hd = tid & 3;
    const float raw = bf2f(U[(size_t)(m0 + t) * UP + UD_DTF + dir * 4 + hd]);
    const float dt = softplusf(raw + P.ssd_dt_bias[(l * 2 + dir) * 4 + hd]);
    const float a = -__expf(P.ssd_a_log[(l * 2 + dir) * 4 + hd]);
    sdt[(dir * 64 + t) * 4 + hd] = dt; scum[(dir * 64 + t) * 4 + hd] = dt * a;
  }
  __syncthreads();
  if (tid < 8) {
    const int dir = tid >> 2, hd = tid & 3; float s = 0.f;
    float* col = scum + dir * 256 + hd; float v[64];
#pragma unroll
    for (int t = 0; t < 64; ++t) v[t] = col[t * 4];
    if (dir == 0) {
#pragma unroll
      for (int t = 0; t < 64; ++t) { s += v[t]; col[t * 4] = s; }
    } else {
#pragma unroll
      for (int t = 63; t >= 0; --t) { s += v[t]; col[t * 4] = s; }
    }
  }
  __syncthreads();
}

DI void ssd_local(const Params& P, int l, int b, int cb, char* lds) {
  ssd_stage(P, l, b, cb, lds);
  const u16* sx = (const u16*)lds; const float* scum = (const float*)(lds + 132352); const float* sdt = scum + 512;
  const int tid = tidx(), w = tid >> 6, lane = tid & 63, c31 = lane & 31, hh = lane >> 5, dir = w >> 2, h = w & 3, grp = h >> 1;
  const float cl = scum[(dir * 64 + (dir ? 0 : 63)) * 4 + h];
  f32x16 acc[2][2];
#pragma unroll
  for (int a = 0; a < 2; ++a)
#pragma unroll
    for (int bb = 0; bb < 2; ++bb)
#pragma unroll
      for (int r = 0; r < 16; ++r) acc[a][bb][r] = 0.f;
#pragma unroll
  for (int ks = 0; ks < 4; ++ks) {
    float wgt[8];
#pragma unroll
    for (int e = 0; e < 8; ++e) { const int s = ks * 16 + hh * 8 + e; wgt[e] = __expf(cl - scum[(dir * 64 + s) * 4 + h]) * sdt[(dir * 64 + s) * 4 + h]; }
    bf16x8 bn[2];
#pragma unroll
    for (int nt = 0; nt < 2; ++nt)
#pragma unroll
      for (int e = 0; e < 8; ++e) bn[nt][e] = (short)sx[(ks * 16 + hh * 8 + e) * SXP + 256 + grp * 64 + nt * 32 + c31];
#pragma unroll
    for (int pt = 0; pt < 2; ++pt) {
      float v[8];
#pragma unroll
      for (int e = 0; e < 8; ++e) v[e] = bf2f(sx[(ks * 16 + hh * 8 + e) * SXP + h * 64 + pt * 32 + c31]) * wgt[e];
      const bf16x8 a = pack8(v[0], v[1], v[2], v[3], v[4], v[5], v[6], v[7]);
#pragma unroll
      for (int nt = 0; nt < 2; ++nt) acc[pt][nt] = MFMA32(a, bn[nt], acc[pt][nt]);
    }
  }
  const int seq = (b * 2 + dir) * 4 + h, ci = blk_ci(cb, dir);
  u16* dst = (u16*)(P.ws + WS_SSD) + (size_t)(seq * NCH + ci) * 4096;
#pragma unroll
  for (int pt = 0; pt < 2; ++pt)
#pragma unroll
    for (int nt = 0; nt < 2; ++nt)
#pragma unroll
      for (int r = 0; r < 16; ++r) dst[(pt * 32 + crow(r, hh)) * 64 + nt * 32 + c31] = f2bf(acc[pt][nt][r]);
  if (lane == 0) ((float*)(P.ws + WS_SSDD))[seq * NCH + ci] = __expf(cl);
  __syncthreads();
}

DI void ssd_out(const Params& P, int l, int b, int cb, char* lds) {
  ssd_stage(P, l, b, cb, lds);
  const u16* sx = (const u16*)lds; float* xb = (float*)(lds + 66560); const float* scum = (const float*)(lds + 132352); const float* sdt = scum + 512; float* ssq = (float*)(lds + 136448);
  const int tid = tidx(), w = tid >> 6, lane = tid & 63, c31 = lane & 31, hh = lane >> 5, dir = w >> 2, h = w & 3, grp = h >> 1;
  const int seq = (b * 2 + dir) * 4 + h, ci = blk_ci(cb, dir), m0 = blk_m0(b, cb);
  const u16* Sin = (const u16*)(P.ws + WS_SSD) + (size_t)(seq * NCH + ci) * 4096;
  f32x16 y[2][2];
#pragma unroll
  for (int a = 0; a < 2; ++a)
#pragma unroll
    for (int bb = 0; bb < 2; ++bb)
#pragma unroll
      for (int r = 0; r < 16; ++r) y[a][bb][r] = 0.f;
#pragma unroll
  for (int lt = 0; lt < 2; ++lt) {
    const int tl = lt * 32 + c31;
    const float cuml = scum[(dir * 64 + tl) * 4 + h];
    const float ecl = __expf(cuml);
#pragma unroll
    for (int ks = 0; ks < 4; ++ks) {
      const uint4 cv = *(const uint4*)(sx + tl * SXP + 384 + grp * 64 + ks * 16 + hh * 8);
      const bf16x8 cmf = pack8(bflo(cv.x) * ecl, bfhi(cv.x) * ecl, bflo(cv.y) * ecl, bfhi(cv.y) * ecl, bflo(cv.z) * ecl, bfhi(cv.z) * ecl, bflo(cv.w) * ecl, bfhi(cv.w) * ecl);
#pragma unroll
      for (int pt = 0; pt < 2; ++pt) {
        const uint4 sraw = ld_nt((const uint4*)(Sin + (pt * 32 + c31) * 64 + ks * 16 + hh * 8)); const bf16x8 sa = mk8(sraw.x, sraw.y, sraw.z, sraw.w);
        y[pt][lt] = MFMA32(sa, cmf, y[pt][lt]);
      }
    }
#pragma unroll
    for (int st = 0; st < 2; ++st) {
      const bool skip = dir == 0 ? (st > lt) : (st < lt);
      if (skip) continue;
      f32x16 cbt;
#pragma unroll
      for (int r = 0; r < 16; ++r) cbt[r] = 0.f;
#pragma unroll
      for (int ks = 0; ks < 4; ++ks) {
        const bf16x8 bmf = *(const bf16x8*)(sx + (st * 32 + c31) * SXP + 256 + grp * 64 + ks * 16 + hh * 8);
        const bf16x8 cmf = *(const bf16x8*)(sx + tl * SXP + 384 + grp * 64 + ks * 16 + hh * 8);
        cbt = MFMA32(bmf, cmf, cbt);
      }
#pragma unroll
      for (int r = 0; r < 16; ++r) {
        const int s = st * 32 + crow(r, hh); const bool keep = dir == 0 ? (s <= tl) : (s >= tl);
        const float dec = __expf(fminf(cuml - scum[(dir * 64 + s) * 4 + h], 0.f)) * sdt[(dir * 64 + s) * 4 + h];
        cbt[r] = keep ? cbt[r] * dec : 0.f;
      }
      const bf16x8 p0 = pack8(cbt[0], cbt[1], cbt[2], cbt[3], cbt[4], cbt[5], cbt[6], cbt[7]), p1 = pack8(cbt[8], cbt[9], cbt[10], cbt[11], cbt[12], cbt[13], cbt[14], cbt[15]);
#pragma unroll
      for (int s2 = 0; s2 < 2; ++s2)
#pragma unroll
        for (int pt = 0; pt < 2; ++pt) {
          bf16x8 xa;
#pragma unroll
          for (int e = 0; e < 8; ++e) { const int s = st * 32 + 16 * s2 + 8 * (e >> 2) + 4 * hh + (e & 3); xa[e] = (short)sx[s * SXP + h * 64 + pt * 32 + c31]; }
          y[pt][lt] = MFMA32(xa, s2 ? p1 : p0, y[pt][lt]);
        }
    }
  }
  if (dir == 1) {
#pragma unroll
    for (int pt = 0; pt < 2; ++pt)
#pragma unroll
      for (int lt = 0; lt < 2; ++lt)
#pragma unroll
        for (int r = 0; r < 16; ++r) xb[(lt * 32 + c31) * 257 + h * 64 + pt * 32 + crow(r, hh)] = y[pt][lt][r];
  }
  __syncthreads();
  if (dir == 0) {
    const float dsk = P.ssd_d[l * 4 + h];
#pragma unroll
    for (int lt = 0; lt < 2; ++lt) {
      const int tl = lt * 32 + c31;
#pragma unroll
      for (int pt = 0; pt < 2; ++pt)
#pragma unroll
        for (int r = 0; r < 16; ++r) {
          const int p = pt * 32 + crow(r, hh);
          xb[tl * 257 + h * 64 + p] += y[pt][lt][r] + dsk * bf2f(sx[tl * SXP + h * 64 + p]);
        }
    }
  }
  __syncthreads();
  {
    const u16* U = (const u16*)(P.ws + WS_U); u16* Y = (u16*)(P.ws + WS_XN);
#pragma unroll
    for (int q = 0; q < 4; ++q) {
      const int idx = tid + q * NTHREADS, row = idx >> 5, ch0 = (idx & 31) * 8; const size_t m = (size_t)(m0 + row);
      const uint4 zv = ld_nt((const uint4*)(U + m * UP + UD_Z + ch0));
      const float zz[8] = {bflo(zv.x), bfhi(zv.x), bflo(zv.y), bfhi(zv.y), bflo(zv.z), bfhi(zv.z), bflo(zv.w), bfhi(zv.w)};
      float v[8]; float ss = 0.f;
#pragma unroll
      for (int e = 0; e < 8; ++e) { v[e] = xb[row * 257 + ch0 + e] * siluf(zz[e]); ss += v[e] * v[e]; }
      ss += shx(ss, 1); ss += shx(ss, 2); ss += shx(ss, 4); ss += shx(ss, 8); ss += shx(ss, 16);
      const float rstd = rsqrtf(ss * (1.f / 256.f) + 1e-6f);
      const float4 n0 = *(const float4*)(P.ssd_norm_w + l * 256 + ch0), n1 = *(const float4*)(P.ssd_norm_w + l * 256 + ch0 + 4);
      uint4 ov;
      ov.x = pk2(v[0] * rstd * n0.x, v[1] * rstd * n0.y); ov.y = pk2(v[2] * rstd * n0.z, v[3] * rstd * n0.w);
      ov.z = pk2(v[4] * rstd * n1.x, v[5] * rstd * n1.y); ov.w = pk2(v[6] * rstd * n1.z, v[7] * rstd * n1.w);
      *(uint4*)(Y + m * 1024 + 768 + ch0) = ov;
    }
  }
  __syncthreads();
}

constexpr int LXP = 264;
DI float neg_expm1f(float x) { return x > -0.01f ? -x * (1.f + x * (0.5f + x * (1.f / 6.f))) : 1.f - __expf(x); }

DI void lru_stage(const Params& P, int l, int b, int cb, char* lds) {
  u16* sxc = (u16*)lds;
  const int tid = tidx();
  const u16* U = (const u16*)(P.ws + WS_U);
  const int tseq0 = cb < 4 ? cb * 64 : (cb - 4) * 64, slen = cb < 4 ? 256 : T, mseq0 = cb < 4 ? MLAT + b * 256 : b * T;
  {
    const int ch0 = (tid & 31) * 8;
    float wt[4][8], bs[8];
    { const float4 b0 = *(const float4*)(P.lru_conv_b + l * 256 + ch0), b1 = *(const float4*)(P.lru_conv_b + l * 256 + ch0 + 4);
      bs[0] = b0.x; bs[1] = b0.y; bs[2] = b0.z; bs[3] = b0.w; bs[4] = b1.x; bs[5] = b1.y; bs[6] = b1.z; bs[7] = b1.w; }
#pragma unroll
    for (int j = 0; j < 4; ++j) {
      const float* wj = gp(P.lru_conv_w + (l * 4 + j) * 256 + ch0); const float4 w0 = *(const float4*)wj, w1 = *(const float4*)(wj + 4);
      wt[j][0] = w0.x; wt[j][1] = w0.y; wt[j][2] = w0.z; wt[j][3] = w0.w; wt[j][4] = w1.x; wt[j][5] = w1.y; wt[j][6] = w1.z; wt[j][7] = w1.w;
    }
#pragma unroll 2
    for (int t = tid >> 5; t < 64; t += 16) {
      float acc[8];
#pragma unroll
      for (int i = 0; i < 8; ++i) acc[i] = bs[i];
#pragma unroll
      for (int j = 0; j < 4; ++j) {
        const int ts = tseq0 + t - 2 + j;
        if (ts >= 0 && ts < slen) {
          const uint4 v = *(const uint4*)(U + (size_t)(mseq0 + ts) * UP + UB_X + ch0);
          acc[0] += bflo(v.x) * wt[j][0]; acc[1] += bfhi(v.x) * wt[j][1]; acc[2] += bflo(v.y) * wt[j][2]; acc[3] += bfhi(v.y) * wt[j][3];
          acc[4] += bflo(v.z) * wt[j][4]; acc[5] += bfhi(v.z) * wt[j][5]; acc[6] += bflo(v.w) * wt[j][6]; acc[7] += bfhi(v.w) * wt[j][7];
        }
      }
      uint4 o; o.x = pk2(acc[0], acc[1]); o.y = pk2(acc[2], acc[3]); o.z = pk2(acc[4], acc[5]); o.w = pk2(acc[6], acc[7]);
      *(uint4*)(sxc + t * LXP + ch0) = o;
    }
  }
  __syncthreads();
}

DI void lru_gates(const Params& P, int l, int dir, int g, int ct, const u16* sxc, f32x16 (&av)[2], f32x16 (&uv)[2]) {
  const int lane = tidx() & 63, c31 = lane & 31, hh = lane >> 5;
#pragma unroll
  for (int a = 0; a < 2; ++a)
#pragma unroll
    for (int r = 0; r < 16; ++r) { av[a][r] = 0.f; uv[a][r] = 0.f; }
  const u16* wfa_p = (const u16*)(P.ws + WS_LRUW) + (size_t)((((l * 2 + dir) * 4 + g) * 2 + 0) * 4096) + (ct * 64 + lane) * 8;
  const u16* wfx_p = wfa_p + 4096;
#pragma unroll
  for (int ks = 0; ks < 4; ++ks) {
    const bf16x8 wfa = *(const bf16x8*)(wfa_p + ks * 1024), wfx = *(const bf16x8*)(wfx_p + ks * 1024);
#pragma unroll
    for (int tt = 0; tt < 2; ++tt) {
      const bf16x8 xa = *(const bf16x8*)(sxc + (tt * 32 + c31) * LXP + g * 64 + ks * 16 + hh * 8);
      av[tt] = MFMA32(xa, wfa, av[tt]); uv[tt] = MFMA32(xa, wfx, uv[tt]);
    }
  }
  const int ch = g * 64 + ct * 32 + c31;
  const float ba = P.lru_ba[(l * 2 + dir) * 256 + ch], bx = P.lru_bx[(l * 2 + dir) * 256 + ch];
  const float sp = softplusf(-P.lru_lam[(l * 2 + dir) * 256 + ch]);
#pragma unroll
  for (int tt = 0; tt < 2; ++tt)
#pragma unroll
    for (int r = 0; r < 16; ++r) {
      const float rg = sigmf(av[tt][r] + ba), ig = sigmf(uv[tt][r] + bx);
      const float la = -8.f * rg * sp;
      const float xv = bf2f(sxc[(tt * 32 + crow(r, hh)) * LXP + ch]);
      av[tt][r] = __expf(la);
      uv[tt][r] = __builtin_amdgcn_sqrtf(neg_expm1f(2.f * la)) * ig * xv;
    }
}

template <int REV>
DI void lru_scan(f32x16 (&av)[2], f32x16 (&uv)[2], float& hc, float& ap) {
  const int hh = (tidx() & 63) >> 5;
  const bool first = (hh == (REV ? 1 : 0));
  ap = 1.f;
#pragma unroll
  for (int tti = 0; tti < 2; ++tti) {
    const int tt = REV ? 1 - tti : tti;
#pragma unroll
    for (int ii = 0; ii < 4; ++ii) {
      const int i = REV ? 3 - ii : ii;
      float GA = 1.f, GU = 0.f;
#pragma unroll
      for (int ee = 0; ee < 4; ++ee) { const int r = 4 * i + (REV ? 3 - ee : ee); GU = av[tt][r] * GU + uv[tt][r]; GA *= av[tt][r]; }
      const float PA = shx(GA, 32), PU = shx(GU, 32);
      float hcur = first ? hc : PA * hc + PU;
#pragma unroll
      for (int ee = 0; ee < 4; ++ee) { const int r = 4 * i + (REV ? 3 - ee : ee); hcur = av[tt][r] * hcur + uv[tt][r]; uv[tt][r] = hcur; }
      const float pairA = GA * PA, pairU = first ? PA * GU + PU : GA * PU + GU;
      hc = pairA * hc + pairU; ap *= pairA;
    }
  }
}

DI void lru_local(const Params& P, int l, int b, int cb, char* lds) {
  lru_stage(P, l, b, cb, lds);
  const int tid = tidx(), w = tid >> 6, lane = tid & 63, c31 = lane & 31, hh = lane >> 5, dir = w >> 2, g = w & 3;
  const int ci = blk_ci(cb, dir);
#pragma unroll 1
  for (int ct = 0; ct < 2; ++ct) {
    f32x16 av[2], uv[2];
    lru_gates(P, l, dir, g, ct, (const u16*)lds, av, uv);
    float hc = 0.f, ap;
    if (dir) lru_scan<1>(av, uv, hc, ap); else lru_scan<0>(av, uv, hc, ap);
    if (hh == 0) {
      const int ch = g * 64 + ct * 32 + c31;
      ((float*)(P.ws + WS_LRUA))[((b * 2 + dir) * NCH + ci) * 256 + ch] = ap;
      ((float*)(P.ws + WS_LRUU))[((b * 2 + dir) * NCH + ci) * 256 + ch] = hc;
    }
  }
  __syncthreads();
}

DI void lru_out(const Params& P, int l, int b, int cb, char* lds) {
  lru_stage(P, l, b, cb, lds);
  const int tid = tidx(), w = tid >> 6, lane = tid & 63, c31 = lane & 31, hh = lane >> 5, dir = w >> 2, g = w & 3;
  const int ci = blk_ci(cb, dir), m0 = blk_m0(b, cb);
  float* xb = (float*)(lds + 34816);
  f32x16 hres[2][2];
#pragma unroll
  for (int ct = 0; ct < 2; ++ct) {
    f32x16 av[2], uv[2];
    lru_gates(P, l, dir, g, ct, (const u16*)lds, av, uv);
    float hc = ((const float*)(P.ws + WS_LRUU))[((b * 2 + dir) * NCH + ci) * 256 + g * 64 + ct * 32 + c31], ap;
    if (dir) lru_scan<1>(av, uv, hc, ap); else lru_scan<0>(av, uv, hc, ap);
    if (dir == 1) {
#pragma unroll
      for (int tt = 0; tt < 2; ++tt)
#pragma unroll
        for (int r = 0; r < 16; ++r) xb[(tt * 32 + crow(r, hh)) * 257 + g * 64 + ct * 32 + c31] = uv[tt][r];
    }
    hres[ct][0] = uv[0]; hres[ct][1] = uv[1];
  }
  __syncthreads();
  if (dir == 0) {
#pragma unroll
    for (int ct = 0; ct < 2; ++ct)
#pragma unroll
      for (int tt = 0; tt < 2; ++tt)
#pragma unroll
        for (int r = 0; r < 16; ++r) xb[(tt * 32 + crow(r, hh)) * 257 + g * 64 + ct * 32 + c31] += hres[ct][tt][r];
  }
  __syncthreads();
  {
    const u16* U = (const u16*)(P.ws + WS_U); u16* Y = (u16*)(P.ws + WS_XN);
#pragma unroll
    for (int q = 0; q < 4; ++q) {
      const int idx = tid + q * NTHREADS, row = idx >> 5, ch0 = (idx & 31) * 8; const size_t m = (size_t)(m0 + row);
      const uint4 gv = ld_nt((const uint4*)(U + m * UP + UB_G + ch0));
      const float* xr = xb + row * 257 + ch0;
      uint4 ov;
      ov.x = pk2(xr[0] * siluf(bflo(gv.x)), xr[1] * siluf(bfhi(gv.x))); ov.y = pk2(xr[2] * siluf(bflo(gv.y)), xr[3] * siluf(bfhi(gv.y)));
      ov.z = pk2(xr[4] * siluf(bflo(gv.z)), xr[5] * siluf(bfhi(gv.z))); ov.w = pk2(xr[6] * siluf(bflo(gv.w)), xr[7] * siluf(bfhi(gv.w)));
      *(uint4*)(Y + m * 1024 + 256 + ch0) = ov;
    }
  }
  __syncthreads();
}

template <int PS, int DS>
DI void scan_bf16(u16* p, const float* d) {
  float s = 0.f;
  u16 ua[12], ub[12]; float da[12], db[12];
#pragma unroll
  for (int j = 0; j < 12; ++j) { ua[j] = p[(size_t)j * PS]; da[j] = d[j * DS]; }
#pragma unroll 1
  for (int g = 0; g < 11; g += 2) {
    if (g + 1 < 11) {
#pragma unroll
      for (int j = 0; j < 12; ++j) { ub[j] = p[(size_t)((g + 1) * 12 + j) * PS]; db[j] = d[((g + 1) * 12 + j) * DS]; }
    }
#pragma unroll
    for (int j = 0; j < 12; ++j) { p[(size_t)(g * 12 + j) * PS] = f2bf(s); s = da[j] * s + bf2f(ua[j]); }
    if (g + 2 < 11) {
#pragma unroll
      for (int j = 0; j < 12; ++j) { ua[j] = p[(size_t)((g + 2) * 12 + j) * PS]; da[j] = d[((g + 2) * 12 + j) * DS]; }
    }
    if (g + 1 < 11) {
#pragma unroll
      for (int j = 0; j < 12; ++j) { p[(size_t)((g + 1) * 12 + j) * PS] = f2bf(s); s = db[j] * s + bf2f(ub[j]); }
    }
  }
}

DI void phase_scans(const Params& P) {
  const int tid_ = tidx(); const int w = tid_ >> 6, lane = tid_ & 63;
  for (int unit = blockIdx.x + gridDim.x * w; unit < 1552; unit += gridDim.x * 8) {
    if (unit < 512) {
      const int item = unit * 64 + lane, seq = item >> 11, kv = item & 2047;
      scan_bf16<2048, 32>((u16*)(P.ws + WS_GLA) + (size_t)seq * NCH * 2048 + kv, (const float*)(P.ws + WS_GLAD) + seq * NCH * 32 + (kv >> 6));
    } else if (unit < 1536) {
      const int item = (unit - 512) * 64 + lane, seq = item >> 12, pn = item & 4095;
      scan_bf16<4096, 1>((u16*)(P.ws + WS_SSD) + (size_t)seq * NCH * 4096 + pn, (const float*)(P.ws + WS_SSDD) + seq * NCH);
    } else {
      const int item = (unit - 1536) * 64 + lane, bd = item >> 8, ch = item & 255;
      float* pu = (float*)(P.ws + WS_LRUU) + (size_t)bd * NCH * 256 + ch; const float* pa = (const float*)(P.ws + WS_LRUA) + (size_t)bd * NCH * 256 + ch;
      float s = 0.f;
      for (int c0 = 0; c0 < NCH; c0 += 12) {
        float uu[12], dd[12];
#pragma unroll
        for (int j = 0; j < 12; ++j) { uu[j] = pu[(c0 + j) * 256]; dd[j] = pa[(c0 + j) * 256]; }
#pragma unroll
        for (int j = 0; j < 12; ++j) { pu[(c0 + j) * 256] = s; s = dd[j] * s + uu[j]; }
      }
    }
  }
}

DI void attn_tile(const Params& P, int l, int b, int h, int qpos0, int key0, int ntile, float lam, float lam_init, char* lds) {
  const int tid = tidx(), w = tid >> 6, lane = tid & 63, c31 = lane & 31, hh = lane >> 5;
  const u16* Qg = (const u16*)(P.ws + WS_Q) + (size_t)((b * 4 + h) * 2) * NKEY * 32;
  const u16* Kg = (const u16*)(P.ws + WS_K) + (size_t)((b * 4 + h) * 2) * NKEY * 32;
  const u16* Vg = (const u16*)(P.ws + WS_VT) + (size_t)((b * 4 + h) * 64) * NKEY;
  const int qp = qpos0 + w * 32 + c31;
  bf16x8 qf[2][2]; float bq[2];
#pragma unroll
  for (int c = 0; c < 2; ++c)
#pragma unroll
    for (int ks = 0; ks < 2; ++ks) qf[c][ks] = *(const bf16x8*)(Qg + ((size_t)c * NKEY + qp) * 32 + ks * 16 + hh * 8);
#pragma unroll
  for (int c = 0; c < 2; ++c) {
    float s = 0.f;
#pragma unroll
    for (int ks = 0; ks < 2; ++ks)
#pragma unroll
      for (int e = 0; e < 8; ++e) { const float v = bf2f((u16)qf[c][ks][e]); s += v * v; }
    s += shx(s, 32);
    const float km = ((const float*)(P.ws + WS_MISC))[((l * 2 + b) * 4 + h) * 2 + c];
    bq[c] = sqrtf(s * km) * 1.002f + 1e-3f;
  }
  u16* sK = (u16*)lds; u16* sV = (u16*)(lds + 20480);
  const int kc = tid >> 8, kr = (tid >> 2) & 63, kpart = tid & 3, vdv = tid >> 3, vpart = tid & 7;
  const u16* kp = Kg + ((size_t)kc * NKEY + key0 + kr) * 32 + kpart * 8;
  const u16* vp = Vg + (size_t)vdv * NKEY + key0 + vpart * 8;
  uint4 rk = *(const uint4*)kp, rv = *(const uint4*)vp;
  *(uint4*)(sK + (kc * 64 + kr) * 40 + kpart * 8) = rk; *(uint4*)(sV + vdv * 72 + vpart * 8) = rv;
  __syncthreads();
  f32x16 O[2][2]; float ls[2] = {0.f, 0.f};
#pragma unroll
  for (int a = 0; a < 2; ++a)
#pragma unroll
    for (int bb = 0; bb < 2; ++bb)
#pragma unroll
      for (int r = 0; r < 16; ++r) O[a][bb][r] = 0.f;
  if (__builtin_amdgcn_readfirstlane(tid) >= 256) __builtin_amdgcn_s_setprio(1);
#pragma unroll 1
  for (int kt = 0; kt < ntile; ++kt) {
    const int cur = kt & 1;
    if (kt + 1 < ntile) { rk = *(const uint4*)(kp + (size_t)(kt + 1) * 2048); rv = *(const uint4*)(vp + (kt + 1) * 64); }
    const u16* cK = sK + cur * 5120; const u16* cV = sV + cur * 4608;
#pragma unroll
    for (int kt2 = 0; kt2 < 2; ++kt2) {
      const bf16x8 ka0 = *(const bf16x8*)(cK + (kt2 * 32 + c31) * 40 + hh * 8), ka1 = *(const bf16x8*)(cK + (kt2 * 32 + c31) * 40 + 16 + hh * 8);
      const bf16x8 kb0 = *(const bf16x8*)(cK + (64 + kt2 * 32 + c31) * 40 + hh * 8), kb1 = *(const bf16x8*)(cK + (64 + kt2 * 32 + c31) * 40 + 16 + hh * 8);
      f32x16 Sa, Sb;
#pragma unroll
      for (int r = 0; r < 16; ++r) { Sa[r] = -bq[0]; Sb[r] = -bq[1]; }
      Sa = MFMA32(ka0, qf[0][0], Sa); Sb = MFMA32(kb0, qf[1][0], Sb);
      Sa = MFMA32(ka1, qf[0][1], Sa); Sb = MFMA32(kb1, qf[1][1], Sb);
      const bf16x8 v00 = *(const bf16x8*)(cV + (c31) * 72 + (kt2 * 2) * 16 + hh * 8), v01 = *(const bf16x8*)(cV + (c31) * 72 + (kt2 * 2 + 1) * 16 + hh * 8);
      const bf16x8 v10 = *(const bf16x8*)(cV + (32 + c31) * 72 + (kt2 * 2) * 16 + hh * 8), v11 = *(const bf16x8*)(cV + (32 + c31) * 72 + (kt2 * 2 + 1) * 16 + hh * 8);
      {
        float p[16];
#pragma unroll
        for (int r = 0; r < 16; ++r) { p[r] = __builtin_amdgcn_exp2f(Sa[r]); ls[0] += p[r]; }
        const bf16x8 p0 = pack8(p[0], p[1], p[2], p[3], p[4], p[5], p[6], p[7]), p1 = pack8(p[8], p[9], p[10], p[11], p[12], p[13], p[14], p[15]);
        O[0][0] = MFMA32(v00, p0, O[0][0]); O[0][1] = MFMA32(v10, p0, O[0][1]);
        O[0][0] = MFMA32(v01, p1, O[0][0]); O[0][1] = MFMA32(v11, p1, O[0][1]);
      }
      {
        float p[16];
#pragma unroll
        for (int r = 0; r < 16; ++r) { p[r] = __builtin_amdgcn_exp2f(Sb[r]); ls[1] += p[r]; }
        const bf16x8 p0 = pack8(p[0], p[1], p[2], p[3], p[4], p[5], p[6], p[7]), p1 = pack8(p[8], p[9], p[10], p[11], p[12], p[13], p[14], p[15]);
        O[1][0] = MFMA32(v00, p0, O[1][0]); O[1][1] = MFMA32(v10, p0, O[1][1]);
        O[1][0] = MFMA32(v01, p1, O[1][0]); O[1][1] = MFMA32(v11, p1, O[1][1]);
      }
    }
    if (kt + 1 < ntile) { *(uint4*)(sK + (cur ^ 1) * 5120 + (kc * 64 + kr) * 40 + kpart * 8) = rk; *(uint4*)(sV + (cur ^ 1) * 4608 + vdv * 72 + vpart * 8) = rv; }
    __syncthreads();
  }
  __builtin_amdgcn_s_setprio(0);
  ls[0] += shx(ls[0], 32); ls[1] += shx(ls[1], 32);
  const float i0 = 1.f / ls[0], i1 = lam / ls[1];
  float ss = 0.f;
#pragma unroll
  for (int dt = 0; dt < 2; ++dt)
#pragma unroll
    for (int r = 0; r < 16; ++r) { const float o = O[0][dt][r] * i0 - O[1][dt][r] * i1; O[0][dt][r] = o; ss += o * o; }
  ss += shx(ss, 32);
  const float rstd = rsqrtf(ss * (1.f / 64.f) + 1e-6f) * (1.f - lam_init);
  const size_t m = (qpos0 < 8192) ? (size_t)(b * T + qp) : (size_t)(MLAT + b * 256 + (qp - 8192));
  const u16* U = (const u16*)(P.ws + WS_U); u16* Y = (u16*)(P.ws + WS_XN);
#pragma unroll
  for (int dt = 0; dt < 2; ++dt)
#pragma unroll
    for (int q4 = 0; q4 < 4; ++q4) {
      const int d0 = dt * 32 + 8 * q4 + 4 * hh;
      const uint2 gv = *(const uint2*)(U + m * UP + UC_G + h * 64 + d0);
      const float4 nw = *(const float4*)(P.diff_subln_w + l * 64 + d0);
      const float y0 = O[0][dt][4 * q4 + 0] * rstd * nw.x * siluf(bflo(gv.x)), y1 = O[0][dt][4 * q4 + 1] * rstd * nw.y * siluf(bfhi(gv.x));
      const float y2 = O[0][dt][4 * q4 + 2] * rstd * nw.z * siluf(bflo(gv.y)), y3 = O[0][dt][4 * q4 + 3] * rstd * nw.w * siluf(bfhi(gv.y));
      uint2 ov; ov.x = pk2(y0, y1); ov.y = pk2(y2, y3);
      *(uint2*)(Y + m * 1024 + 512 + h * 64 + d0) = ov;
    }
  __syncthreads();
}

DI void phase_attn(const Params& P, int l, char* lds) {
  const int lane = tidx() & 63;
  const float lam_init = 0.8f - 0.6f * __expf(-0.3f * (float)l);
  float a = 0.f, bsum = 0.f;
  if (lane < 32) { const float* lv = gp(P.diff_lam + l * 128); a = lv[lane] * lv[32 + lane]; bsum = lv[64 + lane] * lv[96 + lane]; }
#pragma unroll
  for (int s = 32; s >= 1; s >>= 1) { a += shx(a, s); bsum += shx(bsum, s); }
  const float lam = __expf(a) - __expf(bsum) + lam_init;
  const int ntask = (l == 0) ? 264 : 256;
  for (int id0 = blockIdx.x; id0 < ntask; id0 += gridDim.x) {
    int tb, th, tq0, tk0, tn;
    if (id0 < 256) {
      const int id = (gridDim.x == 256) ? ((id0 & 7) * 32 + (id0 >> 3)) : id0;
      tb = id >> 7; th = (id >> 5) & 3; tq0 = (id & 31) * 256; tk0 = 0; tn = 132;
    } else {
      const int id = id0 - 256;
      tb = id >> 2; th = id & 3; tq0 = 8192; tk0 = 8192; tn = 4;
    }
    attn_tile(P, l, tb, th, tq0, tk0, tn, lam, lam_init, lds);
  }
}

#define XB_TMO      128
#define XB_XCNT(j)  (256  + 64 * (j))
#define XB_XSUB(j)  (1280 + 64 * (j))
#define XB_XGEN(j)  (2304 + 64 * (j))
#define XB_TOP      3328
#define XB_TOPGEN   3392
#define XCD_BAR_WORDS 3456
#define XB_SPIN_CAP (1u << 18)
#define LAS __attribute__((address_space(3)))
DI unsigned xb_ld(unsigned* p) { return __hip_atomic_load(p, __ATOMIC_RELAXED, __HIP_MEMORY_SCOPE_AGENT); }
DI unsigned xb_add(unsigned* p, unsigned v) { return __hip_atomic_fetch_add(p, v, __ATOMIC_RELAXED, __HIP_MEMORY_SCOPE_AGENT); }
DI unsigned xb_xcc_id() { return (unsigned)__builtin_amdgcn_s_getreg((3 << 11) | 20) & 0xFu; }
#define XB_SPIN(cond, bar) do { unsigned _sp = 0; while (cond) { __builtin_amdgcn_s_sleep(1); \
    if ((++_sp & 255u) == 0u) { if (xb_ld(&(bar)[XB_TMO])) break; if (_sp > XB_SPIN_CAP) { atomicAdd(&(bar)[XB_TMO], 1u); break; } } } } while (0)
struct XcdBarrier { unsigned* bar; unsigned x; volatile LAS unsigned* st; };
DI XcdBarrier xcd_barrier_post(unsigned* bar, volatile LAS unsigned* st) {
  XcdBarrier b; b.bar = bar; b.x = xb_xcc_id(); b.st = st;
  if (threadIdx.x == 0) (void)xb_add(&bar[XB_XCNT(b.x)], 1u);
  return b;
}
DI void xcd_barrier_complete(unsigned* bar, unsigned x, unsigned& nloc, unsigned& nx) {
  const unsigned G = gridDim.x * gridDim.y * gridDim.z;
  unsigned sum, cnt, mine, sp = 0u;
  for (;;) {
    sum = 0u; cnt = 0u; mine = 0u;
#pragma unroll
    for (unsigned j = 0; j < 16; ++j) { const unsigned c = xb_ld(&bar[XB_XCNT(j)]); sum += c; cnt += (c > 0u) ? 1u : 0u; mine = (j == x) ? c : mine; }
    if (sum == G) break;
    __builtin_amdgcn_s_sleep(1);
    if ((++sp & 255u) == 0u) { if (xb_ld(&bar[XB_TMO])) break; if (sp > XB_SPIN_CAP) { atomicAdd(&bar[XB_TMO], 1u); break; } }
  }
  nloc = mine > 0u ? mine : 1u; nx = cnt > 0u ? cnt : 1u;
}
DI void xcd_barrier(const XcdBarrier& b) {
  asm volatile("s_waitcnt vmcnt(0)" ::: "memory");
  __syncthreads();
  if (threadIdx.x == 0) {
    unsigned* bar = b.bar;
    __builtin_amdgcn_s_waitcnt(0);
    unsigned nloc = b.st[0], nx = b.st[1];
    if (nloc == 0u) { xcd_barrier_complete(bar, b.x, nloc, nx); b.st[0] = nloc; b.st[1] = nx; }
    const unsigned old = xb_add(&bar[XB_XSUB(b.x)], 1u);
    const unsigned gen = old / nloc;
    if (old + 1u == (gen + 1u) * nloc) {
      __builtin_amdgcn_fence(__ATOMIC_RELEASE, "agent");
      asm volatile("s_waitcnt vmcnt(0)" ::: "memory");
      const unsigned og = xb_add(&bar[XB_TOP], 1u);
      const unsigned tg = og / nx;
      if (og + 1u == (tg + 1u) * nx) xb_add(&bar[XB_TOPGEN], 1u);
      else XB_SPIN(xb_ld(&bar[XB_TOPGEN]) == tg, bar);
      __builtin_amdgcn_fence(__ATOMIC_ACQUIRE, "agent");
      xb_add(&bar[XB_XGEN(b.x)], 1u);
      asm volatile("s_waitcnt vmcnt(0)" ::: "memory");
    } else {
      XB_SPIN(xb_ld(&bar[XB_XGEN(b.x)]) == gen, bar);
      __builtin_amdgcn_fence(__ATOMIC_ACQUIRE, "agent");
      asm volatile("s_waitcnt vmcnt(0)" ::: "memory");
    }
  }
  __syncthreads();
}

__global__ void __launch_bounds__(NTHREADS) fwd_megakernel(Params Parg) {
  extern __shared__ __attribute__((aligned(16))) char lds[];
  __shared__ Params sP;
  __shared__ uint4 xb_words;
  if (threadIdx.x == 0) { sP = Parg; xb_words = make_uint4(0u, 0u, 0u, 0u); }
  __syncthreads();
  const Params& P = sP;
  cg::grid_group grid = cg::this_grid();
  if (blockDim.x == 12345u) grid.sync();
  (void)xcd_barrier_post((unsigned*)(Parg.ws + WS_BAR), (volatile LAS unsigned*)&xb_words);
#define GRID_BAR() do { XcdBarrier xb_; xb_.bar = (unsigned*)(P.ws + WS_BAR); xb_.x = xb_xcc_id(); xb_.st = (volatile LAS unsigned*)&xb_words; xcd_barrier(xb_); } while (0)
  MARK(0); phase_p0(P, lds);
  GRID_BAR();
#pragma unroll 1
  for (int l = 0; l < 2; ++l) {
    MARK(1); phase_norm(P, l);
    GRID_BAR(); MARK(2);
    gemm_phase<0>(P, l, (const u16*)(P.ws + WS_XN), (const u16*)(P.ws + WS_WINT) + (size_t)l * UP * 1024, 66, 25, lds);
    GRID_BAR();
    MARK(3);
    for (int t = blockIdx.x; t < 1056; t += gridDim.x) {
      const int ty = t / 264, idx = t % 264, b = idx / 132, cb = idx % 132;
      if (ty == 0) ssd_local(P, l, b, cb, lds);
      else if (ty == 1) lru_local(P, l, b, cb, lds);
      else if (ty == 2) gla_local(P, l, b, cb, lds);
      else attn_prep(P, l, idx, lds);
    }
    GRID_BAR();
    MARK(4); phase_scans(P);
    MARK(5); phase_attn(P, l, lds); MARK(6);
    GRID_BAR();
    {
      const int per = (l == 0) ? 264 : 256;
      for (int t = blockIdx.x; t < 3 * per; t += gridDim.x) {
        const int ty = t / per, idx = t % per;
        const int b = (l == 0) ? idx / 132 : (idx >> 7), cb = (l == 0) ? idx % 132 : 4 + (idx & 127);
        if (ty == 0) ssd_out(P, l, b, cb, lds);
        else if (ty == 1) lru_out(P, l, b, cb, lds);
        else gla_out(P, l, b, cb, lds);
      }
    }
    GRID_BAR();
    MARK(7); gemm_phase<1>(P, l, (const u16*)(P.ws + WS_XN), (const u16*)(P.ws + WS_WOUT) + (size_t)l * 1024 * 1024, l == 0 ? 66 : 64, 8, lds);
    GRID_BAR();
  }
  MARK(8); phase_final_norm(P);
}

extern "C" void kernel_launch(void* const* d_in, const int* in_sizes, int n_in, void* d_out, int out_size, void* d_ws, size_t ws_size, hipStream_t stream) {
  static int grid_blocks = 0;
  if (!grid_blocks) {
    int dev = 0, cus = 0, per_cu = 0;
    hipGetDevice(&dev);
    hipDeviceGetAttribute(&cus, hipDeviceAttributeMultiprocessorCount, dev);
    hipFuncSetAttribute((const void*)fwd_megakernel, hipFuncAttributeMaxDynamicSharedMemorySize, LDS_BYTES);
    hipOccupancyMaxActiveBlocksPerMultiprocessor(&per_cu, (const void*)fwd_megakernel, NTHREADS, LDS_BYTES);
    if (per_cu < 1) { fprintf(stderr, "occupancy query returned %d\n", per_cu); per_cu = 1; }
    if (per_cu > 1) per_cu = 1;
    grid_blocks = cus * per_cu;
  }
  Params p{};
  const float** pf = (const float**)&p;
  for (int i = 0; i < 28; ++i) pf[i] = (const float*)d_in[i];
  pf[28] = (const float*)d_out; pf[29] = (const float*)d_ws;
  hipMemsetAsync((char*)d_ws + WS_BAR, 0, XCD_BAR_WORDS * 4, stream);
  void* args[] = {&p};
  hipError_t e = hipLaunchCooperativeKernel((const void*)fwd_megakernel, dim3(grid_blocks), dim3(NTHREADS), args, LDS_BYTES, stream);
  if (e != hipSuccess) fprintf(stderr, "cooperative launch failed: %s (grid %d)\n", hipGetErrorString(e), grid_blocks);
}
```

```cpp
#include <hip/hip_runtime.h>
#include <hip/hip_cooperative_groups.h>
#include <cstdio>
namespace cg = cooperative_groups;

#define DI __device__ __forceinline__
typedef unsigned short u16;
typedef __attribute__((ext_vector_type(8))) short bf16x8;
typedef __attribute__((ext_vector_type(16))) float f32x16;
typedef __attribute__((ext_vector_type(4))) unsigned u32x4;
typedef __bf16 bf2_t __attribute__((ext_vector_type(2)));
typedef float fl2_t __attribute__((ext_vector_type(2)));

#define MARK(n) asm volatile("; MARK " #n)
#define MFMA32(a, b, c) __builtin_amdgcn_mfma_f32_32x32x16_bf16((a), (b), (c), 0, 0, 0)

constexpr int T = 8192, D = 1024, UP = 3200, MLAT = 16384, MTOT = 16896, NKEY = 8448, NCH = 132;
constexpr int UA_Q = 0, UA_K = 128, UA_V = 256, UA_LRF = 512, UA_G = 544;
constexpr int UB_X = 800, UB_G = 1056;
constexpr int UC_Q = 1312, UC_K = 1568, UC_V = 1824, UC_G = 2080;
constexpr int UD_XBC = 2336, UD_DTF = 2848, UD_Z = 2856;
constexpr int NTHREADS = 512;
constexpr int LDS_BYTES = 147456;

constexpr size_t WS_WINT = 0;
constexpr size_t WS_WOUT = WS_WINT + (size_t)2 * UP * 1024 * 2;
constexpr size_t WS_MOD = WS_WOUT + (size_t)2 * 1024 * 1024 * 2;
constexpr size_t WS_ROPE = WS_MOD + (size_t)2 * 3 * 3072 * 4;
constexpr size_t WS_MISC = WS_ROPE + 8192;
constexpr size_t WS_XN = WS_MISC + 4096;
constexpr size_t WS_U = WS_XN + (size_t)MTOT * 1024 * 2;
constexpr size_t WS_HCTX = WS_U + (size_t)MTOT * UP * 2;
constexpr size_t WS_Q = WS_HCTX + (size_t)512 * 1024 * 4;
constexpr size_t WS_K = WS_Q + (size_t)16 * NKEY * 32 * 2;
constexpr size_t WS_VT = WS_K + (size_t)16 * NKEY * 32 * 2;
constexpr size_t WS_GLA = WS_VT + (size_t)8 * 64 * NKEY * 2;
constexpr size_t WS_GLAD = WS_GLA + (size_t)16 * NCH * 2048 * 4;
constexpr size_t WS_SSD = WS_GLAD + (size_t)16 * NCH * 32 * 4;
constexpr size_t WS_SSDD = WS_SSD + (size_t)16 * NCH * 4096 * 4;
constexpr size_t WS_LRUA = WS_SSDD + 16384;
constexpr size_t WS_LRUU = WS_LRUA + (size_t)4 * NCH * 256 * 4;
constexpr size_t WS_BAR = WS_LRUU + (size_t)4 * NCH * 256 * 4;
constexpr size_t WS_LRUW = WS_BAR + 16384;
constexpr size_t WS_END = WS_LRUW + (size_t)64 * 4096 * 2;
static_assert(WS_END <= (size_t)256 * 1024 * 1024, "workspace");

#define GAS __attribute__((address_space(1)))
struct Params {
  const GAS float *x, *c, *ctx, *c_ctx, *w_mod, *b_mod, *norm_w, *w_in, *w_out, *gla_w2, *gla_b2, *gla_norm_w, *lru_conv_w, *lru_conv_b,
      *lru_wa, *lru_ba, *lru_wx, *lru_bx, *lru_lam, *diff_lam, *diff_subln_w, *ssd_conv_w, *ssd_conv_b, *ssd_dt_bias, *ssd_a_log, *ssd_d,
      *ssd_norm_w, *final_norm_w;
  GAS float* out;
  GAS unsigned char* ws;
};

DI unsigned pk2(float a, float b) { fl2_t v = {a, b}; return __builtin_bit_cast(unsigned, __builtin_convertvector(v, bf2_t)); }
DI u16 f2bf(float a) { return (u16)(pk2(a, 0.f) & 0xffffu); }
DI float bf2f(u16 x) { return __uint_as_float(((unsigned)x) << 16); }
DI float bflo(unsigned x) { return __uint_as_float(x << 16); }
DI float bfhi(unsigned x) { return __uint_as_float(x & 0xffff0000u); }
DI bf16x8 mk8(unsigned a, unsigned b, unsigned c, unsigned d) { u32x4 v = {a, b, c, d}; return __builtin_bit_cast(bf16x8, v); }
DI bf16x8 pack8(float a0, float a1, float a2, float a3, float a4, float a5, float a6, float a7) { return mk8(pk2(a0, a1), pk2(a2, a3), pk2(a4, a5), pk2(a6, a7)); }
template <class T> DI T* gp(GAS T* p) { return (T*)p; }
typedef __attribute__((ext_vector_type(4))) float f32x4_t;
DI float4 ld_nt(const float4* p) { const f32x4_t v = __builtin_nontemporal_load((const f32x4_t*)p); return make_float4(v.x, v.y, v.z, v.w); }
typedef __attribute__((ext_vector_type(4))) unsigned u32x4_nt;
DI uint4 ld_nt(const uint4* p) { const u32x4_nt v = __builtin_nontemporal_load((const u32x4_nt*)p); return make_uint4(v.x, v.y, v.z, v.w); }
DI int tidx() { int t = threadIdx.x; asm volatile("" : "+v"(t)); return t; }
DI int crow(int r, int hh) { return (r & 3) + 8 * (r >> 2) + 4 * hh; }
DI float siluf(float x) { return x * __builtin_amdgcn_rcpf(1.f + __expf(-x)); }
DI float sigmf(float x) { return __builtin_amdgcn_rcpf(1.f + __expf(-x)); }
DI float softplusf(float x) { return fmaxf(x, 0.f) + __logf(1.f + __expf(-fabsf(x))); }
DI float shx(float v, int m) { return __shfl_xor(v, m, 64); }
DI int blk_m0(int b, int cb) { return cb < 4 ? MLAT + b * 256 + cb * 64 : b * T + (cb - 4) * 64; }
DI int blk_ci(int cb, int dir) { return dir == 0 ? cb : (cb < 4 ? 3 - cb : 135 - cb); }

DI void p0_transpose(const float* src, int N, u16* dst, int k0, int n0, float* lds) {
  const int tid = tidx();
  float v[8];
#pragma unroll
  for (int i = 0; i < 8; ++i) { const int e = tid + i * NTHREADS, kk = e >> 6, n = n0 + (e & 63); v[i] = (n < N) ? src[(size_t)(k0 + kk) * N + n] : 0.f; }
#pragma unroll
  for (int i = 0; i < 8; ++i) { const int e = tid + i * NTHREADS; lds[(e >> 6) * 65 + (e & 63)] = v[i]; }
  __syncthreads();
#pragma unroll
  for (int e = tid; e < 2048; e += NTHREADS) { int nn = e >> 5, kp = (e & 31) * 2; *(unsigned*)(dst + (size_t)(n0 + nn) * 1024 + k0 + kp) = pk2(lds[kp * 65 + nn], lds[(kp + 1) * 65 + nn]); }
  __syncthreads();
}

DI void p0_mod(const Params& P, int l, int n0, float* lds) {
  const int tid = tidx(), col = tid & 63, kg = tid >> 6;
  for (int e = tid; e < 1024; e += NTHREADS) { lds[e] = siluf(P.c[e]); lds[1024 + e] = siluf(P.c[1024 + e]); lds[2048 + e] = siluf(P.c_ctx[e]); }
  __syncthreads();
  float a0 = 0.f, a1 = 0.f, a2 = 0.f;
  const float* wm = gp(P.w_mod + (size_t)l * 1024 * 3072 + n0 + col);
  for (int k0 = kg * 128; k0 < kg * 128 + 128; k0 += 16) {
    float w[16];
#pragma unroll
    for (int j = 0; j < 16; ++j) w[j] = wm[(size_t)(k0 + j) * 3072];
#pragma unroll
    for (int j = 0; j < 16; ++j) { a0 += lds[k0 + j] * w[j]; a1 += lds[1024 + k0 + j] * w[j]; a2 += lds[2048 + k0 + j] * w[j]; }
  }
  float* red = lds + 3072;
  red[(kg * 3 + 0) * 64 + col] = a0; red[(kg * 3 + 1) * 64 + col] = a1; red[(kg * 3 + 2) * 64 + col] = a2;
  __syncthreads();
  if (tid < 192) {
    int j = tid >> 6; float sacc = P.b_mod[l * 3072 + n0 + col];
    for (int g = 0; g < 8; ++g) sacc += red[(g * 3 + j) * 64 + col];
    ((float*)(P.ws + WS_MOD))[(l * 3 + j) * 3072 + n0 + col] = sacc;
  }
  __syncthreads();
}

DI void phase_p0(const Params& P, char* lds) {
  float* fl = (float*)lds;
  for (int t0 = blockIdx.x; t0 < 2273; t0 += gridDim.x) {
    if (t0 >= 2209) {
      const int mid = t0 - 2209, gate = mid & 1, ldg = mid >> 1, tid = tidx();
      const float* wsrc = gp((gate ? P.lru_wx : P.lru_wa) + (size_t)ldg * 4096);
      const int lane = tid & 63, ct = (tid >> 6) & 1, ks = tid >> 7, c31 = lane & 31, hh = lane >> 5;
      float v[8];
#pragma unroll
      for (int e = 0; e < 8; ++e) v[e] = wsrc[(ks * 16 + hh * 8 + e) * 64 + ct * 32 + c31];
      uint4 o; o.x = pk2(v[0], v[1]); o.y = pk2(v[2], v[3]); o.z = pk2(v[4], v[5]); o.w = pk2(v[6], v[7]);
      *(uint4*)((u16*)(P.ws + WS_LRUW) + (size_t)mid * 4096 + tid * 8) = o;
      continue;
    }
    const int t = t0 < 96 ? 2112 + t0 : (t0 < 2208 ? t0 - 96 : t0);
    if (t < 1600) { int l = t / 800, rem = t % 800; p0_transpose(gp(P.w_in + (size_t)l * 1024 * 3112), 3112, (u16*)(P.ws + WS_WINT) + (size_t)l * UP * 1024, (rem & 15) * 64, (rem >> 4) * 64, fl); }
    else if (t < 2112) { int t2 = t - 1600; int l = t2 >> 8, rem = t2 & 255; p0_transpose(gp(P.w_out + (size_t)l * 1024 * 1024), 1024, (u16*)(P.ws + WS_WOUT) + (size_t)l * 1024 * 1024, (rem & 15) * 64, (rem >> 4) * 64, fl); }
    else if (t < 2208) { int t2 = t - 2112; p0_mod(P, t2 / 48, (t2 % 48) * 64, fl); }
    else {
      float* rope = (float*)(P.ws + WS_ROPE);
      const int tid = tidx();
      for (int e = tid; e < 1024; e += NTHREADS) { int pos = e >> 3, f = e & 7; float inv = exp2f(-(float)f * (13.287712379549449f / 8.f)); float ang = (float)pos * inv; rope[e] = __cosf(ang); rope[1024 + e] = __sinf(ang); }
      if (tid < 64) ((unsigned*)(P.ws + WS_MISC))[tid] = 0u;
    }
  }
}

DI const float* h_row(const Params& P, int l, int m) {
  if (l == 0) return gp(m < MLAT ? P.x + (size_t)m * 1024 : P.ctx + (size_t)(m - MLAT) * 1024);
  return m < MLAT ? (const float*)(P.out + (size_t)m * 1024) : (const float*)(P.ws + WS_HCTX) + (size_t)(m - MLAT) * 1024;
}

DI void phase_norm(const Params& P, int l) {
  const int tid_ = tidx(); const int w = tid_ >> 6, lane = tid_ & 63;
  u16* xn = (u16*)(P.ws + WS_XN);
  for (int row = blockIdx.x * 8 + w; row < MTOT; row += gridDim.x * 8) {
    const float4* src = (const float4*)h_row(P, l, row);
    const int j = row < MLAT ? (row >> 13) : 2;
    const float* mod = (const float*)(P.ws + WS_MOD) + (l * 3 + j) * 3072;
    float4 v[4]; float ss = 0.f;
#pragma unroll
    for (int i = 0; i < 4; ++i) { v[i] = ld_nt(src + i * 64 + lane); ss += v[i].x * v[i].x + v[i].y * v[i].y + v[i].z * v[i].z + v[i].w * v[i].w; }
#pragma unroll
    for (int s = 32; s >= 1; s >>= 1) ss += shx(ss, s);
    const float rstd = rsqrtf(ss * (1.f / 1024.f) + 1e-6f);
#pragma unroll
    for (int i = 0; i < 4; ++i) {
      const int k = (i * 64 + lane) * 4;
      float4 nw = *(const float4*)(P.norm_w + l * 1024 + k), sc = *(const float4*)(mod + 1024 + k), sh = *(const float4*)(mod + k);
      float y0 = v[i].x * rstd * nw.x * (1.f + sc.x) + sh.x, y1 = v[i].y * rstd * nw.y * (1.f + sc.y) + sh.y;
      float y2 = v[i].z * rstd * nw.z * (1.f + sc.z) + sh.z, y3 = v[i].w * rstd * nw.w * (1.f + sc.w) + sh.w;
      uint2 o; o.x = pk2(y0, y1); o.y = pk2(y2, y3);
      *(uint2*)(xn + (size_t)row * 1024 + k) = o;
    }
  }
}

DI void phase_final_norm(const Params& P) {
  const int tid_ = tidx(); const int w = tid_ >> 6, lane = tid_ & 63;
  for (int row = blockIdx.x * 8 + w; row < MLAT; row += gridDim.x * 8) {
    float4* src = (float4*)(P.out + (size_t)row * 1024);
    float4 v[4]; float ss = 0.f;
#pragma unroll
    for (int i = 0; i < 4; ++i) { v[i] = ld_nt(src + i * 64 + lane); ss += v[i].x * v[i].x + v[i].y * v[i].y + v[i].z * v[i].z + v[i].w * v[i].w; }
#pragma unroll
    for (int s = 32; s >= 1; s >>= 1) ss += shx(ss, s);
    const float rstd = rsqrtf(ss * (1.f / 1024.f) + 1e-6f);
#pragma unroll
    for (int i = 0; i < 4; ++i) {
      float4 nw = *(const float4*)(P.final_norm_w + (i * 64 + lane) * 4);
      float4 o; o.x = v[i].x * rstd * nw.x; o.y = v[i].y * rstd * nw.y; o.z = v[i].z * rstd * nw.z; o.w = v[i].w * rstd * nw.w;
      { const f32x4_t ov = {o.x, o.y, o.z, o.w}; __builtin_nontemporal_store(ov, (f32x4_t*)(src + i * 64 + lane)); }
    }
  }
}

constexpr int GS = 72;
template <int EPI>
DI void gemm_phase(const Params& P, int l, const u16* A, const u16* Bt, int mtiles, int ntiles, char* lds) {
  const int tid = tidx(), w = tid >> 6, lane = tid & 63, c31 = lane & 31, hh = lane >> 5, wm = w >> 1, wn = w & 1;
  const int lrow = tid >> 3, lcol = (tid & 7) * 8;
  const int ntot = mtiles * ntiles;
  const bool swz = (gridDim.x == 256);
  const int xcd = blockIdx.x & 7, jloc = blockIdx.x >> 3;
  const int per = (ntot + 7) >> 3, qbeg = xcd * per, qend = min(ntot, qbeg + per);
  for (int it = 0;; ++it) {
    int tm, tn;
    if (swz) {
      const int q = qbeg + jloc + 32 * it;
      if (q >= qend) break;
      const int band = q / (4 * ntiles), within = q - band * 4 * ntiles;
      const int rows = min(4, mtiles - band * 4);
      tn = within / rows; tm = band * 4 + (within - tn * rows);
    } else {
      const int tile = blockIdx.x + it * gridDim.x;
      if (tile >= ntot) break;
      tm = tile / ntiles; tn = tile % ntiles;
    }
    const int m0 = tm * 256, n0 = tn * 128;
    f32x16 acc[2][2];
#pragma unroll
    for (int i = 0; i < 2; ++i)
#pragma unroll
      for (int j = 0; j < 2; ++j)
#pragma unroll
        for (int r = 0; r < 16; ++r) acc[i][j][r] = 0.f;
    const u16* ga = A + (size_t)(m0 + lrow) * 1024 + lcol;
    const u16* gb = Bt + (size_t)(n0 + lrow) * 1024 + lcol;
    uint4 ra0, ra1, ra2, ra3, rb0, rb1, rc0, rc1, rc2, rc3, rd0, rd1;
#define G_LOAD(A0, A1, A2, A3, B0, B1, ko) { A0 = *(const uint4*)(ga + (ko)); A1 = *(const uint4*)(ga + (size_t)64 * 1024 + (ko)); A2 = *(const uint4*)(ga + (size_t)128 * 1024 + (ko)); A3 = *(const uint4*)(ga + (size_t)192 * 1024 + (ko)); \
      B0 = *(const uint4*)(gb + (ko)); B1 = *(const uint4*)(gb + (size_t)64 * 1024 + (ko)); }
#define G_STORE(A0, A1, A2, A3, B0, B1, buf) { u16* nA = (u16*)(lds + (buf) * 55296); u16* nB = (u16*)(lds + (buf) * 55296 + 36864); \
      *(uint4*)(nA + (lrow) * GS + lcol) = A0; *(uint4*)(nA + (lrow + 64) * GS + lcol) = A1; *(uint4*)(nA + (lrow + 128) * GS + lcol) = A2; *(uint4*)(nA + (lrow + 192) * GS + lcol) = A3; \
      *(uint4*)(nB + (lrow) * GS + lcol) = B0; *(uint4*)(nB + (lrow + 64) * GS + lcol) = B1; }
#define G_READ(buf) { const u16* sA = (const u16*)(lds + (buf) * 55296); const u16* sB = (const u16*)(lds + (buf) * 55296 + 36864); \
      _Pragma("unroll") for (int ks = 0; ks < 4; ++ks) { \
        af[ks][0] = *(const bf16x8*)(sA + (wm * 64 + c31) * GS + ks * 16 + hh * 8); af[ks][1] = *(const bf16x8*)(sA + (wm * 64 + 32 + c31) * GS + ks * 16 + hh * 8); \
        bfr[ks][0] = *(const bf16x8*)(sB + (wn * 64 + c31) * GS + ks * 16 + hh * 8); bfr[ks][1] = *(const bf16x8*)(sB + (wn * 64 + 32 + c31) * GS + ks * 16 + hh * 8); } \
      __builtin_amdgcn_sched_barrier(0); }
#define G_MMA() { __builtin_amdgcn_sched_barrier(0); \
      _Pragma("unroll") for (int ks = 0; ks < 4; ++ks) { \
        acc[0][0] = MFMA32(af[ks][0], bfr[ks][0], acc[0][0]); acc[0][1] = MFMA32(af[ks][0], bfr[ks][1], acc[0][1]); \
        acc[1][0] = MFMA32(af[ks][1], bfr[ks][0], acc[1][0]); acc[1][1] = MFMA32(af[ks][1], bfr[ks][1], acc[1][1]); } \
      __builtin_amdgcn_sched_barrier(0); }
    bf16x8 af[4][2], bfr[4][2];
#define S0 ra0, ra1, ra2, ra3, rb0, rb1
#define S1 rc0, rc1, rc2, rc3, rd0, rd1
#define GX(M, ...) M(__VA_ARGS__)
#define TK(t) (min((t), 15) * 64)
    if (w < 4) {
      GX(G_LOAD, S0, 0); GX(G_LOAD, S1, 64);
      GX(G_STORE, S0, 0); GX(G_STORE, S1, 1);
      GX(G_LOAD, S0, 128); GX(G_LOAD, S1, 192);
      __syncthreads();
      G_READ(0);
#pragma unroll 1
      for (int kt = 0; kt < 16; kt += 2) {
        G_MMA();
        __syncthreads();
        G_READ(1);
        if (kt + 2 < 16) GX(G_STORE, S0, 0);
        GX(G_LOAD, S0, TK(kt + 4));
        __syncthreads();
        G_MMA();
        __syncthreads();
        if (kt + 2 < 16) { G_READ(0); }
        if (kt + 3 < 16) GX(G_STORE, S1, 1);
        GX(G_LOAD, S1, TK(kt + 5));
        __syncthreads();
      }
    } else {
      GX(G_LOAD, S0, 0);
      GX(G_STORE, S0, 0);
      GX(G_LOAD, S1, 64); GX(G_LOAD, S0, 128);
      __syncthreads();
#pragma unroll 1
      for (int kt = 0; kt < 16; kt += 2) {
        G_READ(0);
        GX(G_STORE, S1, 1);
        GX(G_LOAD, S1, TK(kt + 3));
        __syncthreads();
        G_MMA();
        __syncthreads();
        G_READ(1);
        if (kt + 2 < 16) GX(G_STORE, S0, 0);
        GX(G_LOAD, S0, TK(kt + 4));
        __syncthreads();
        G_MMA();
        __syncthreads();
      }
    }
#undef GX
#undef S0
#undef S1
#undef TK
#undef G_READ
#undef G_MMA
#undef G_LOAD
#undef G_STORE
#undef G_COMPUTE
    if (EPI == 0) {
      u16* st = (u16*)(lds + 55296 + w * 9216);
#pragma unroll
      for (int i = 0; i < 2; ++i)
#pragma unroll
        for (int j = 0; j < 2; ++j)
#pragma unroll
          for (int r = 0; r < 16; ++r) st[(i * 32 + crow(r, hh)) * 72 + j * 32 + c31] = f2bf(acc[i][j][r]);
      u16* U = (u16*)(P.ws + WS_U) + (size_t)(m0 + wm * 64) * UP + n0 + wn * 64;
#pragma unroll
      for (int q = 0; q < 8; ++q) {
        const int idx = q * 64 + lane, row = idx >> 3, part = idx & 7;
        *(uint4*)(U + (size_t)row * UP + part * 8) = *(const uint4*)(st + row * 72 + part * 8);
      }
      __syncthreads();
    } else {
      float* st = (float*)(lds + w * 17408);
#pragma unroll
      for (int i = 0; i < 2; ++i)
#pragma unroll
        for (int j = 0; j < 2; ++j)
#pragma unroll
          for (int r = 0; r < 16; ++r) st[(i * 32 + crow(r, hh)) * 68 + j * 32 + c31] = acc[i][j][r];
      const int mrow0 = m0 + wm * 64, ncol = n0 + wn * 64 + (lane & 15) * 4;
      const int jm = mrow0 < MLAT ? (mrow0 >> 13) : 2;
      const float4 gate = *(const float4*)((const float*)(P.ws + WS_MOD) + (l * 3 + jm) * 3072 + 2048 + ncol);
#pragma unroll
      for (int half = 0; half < 2; ++half) {
        float4 hv[8];
#pragma unroll
        for (int q = 0; q < 8; ++q) { const int row = (half * 8 + q) * 4 + (lane >> 4); hv[q] = ld_nt((const float4*)(h_row(P, l, mrow0 + row) + ncol)); }
#pragma unroll
        for (int q = 0; q < 8; ++q) {
          const int row = (half * 8 + q) * 4 + (lane >> 4), m = mrow0 + row;
          const float4 a = *(const float4*)(st + row * 68 + (lane & 15) * 4);
          float4 o; o.x = hv[q].x + gate.x * a.x; o.y = hv[q].y + gate.y * a.y; o.z = hv[q].z + gate.z * a.z; o.w = hv[q].w + gate.w * a.w;
          float* dst = m < MLAT ? (float*)(P.out + (size_t)m * 1024 + ncol) : (float*)(P.ws + WS_HCTX) + (size_t)(m - MLAT) * 1024 + ncol;
          *(float4*)dst = o;
        }
      }
      __syncthreads();
    }
  }
}

DI void attn_prep(const Params& P, int l, int unit, char* lds) {
  const int tid = tidx(); const int gid = unit * NTHREADS + tid;
  const int m = gid >> 3, h = (gid >> 1) & 3, c = gid & 1;
  const u16* urow = (const u16*)(P.ws + WS_U) + (size_t)m * UP;
  float q[32], k[32];
  {
    const uint4* qs = (const uint4*)(urow + UC_Q + h * 64 + c * 32); const uint4* ks = (const uint4*)(urow + UC_K + h * 64 + c * 32);
#pragma unroll
    for (int i = 0; i < 4; ++i) {
      uint4 a = qs[i], b = ks[i];
      q[i * 8 + 0] = bflo(a.x); q[i * 8 + 1] = bfhi(a.x); q[i * 8 + 2] = bflo(a.y); q[i * 8 + 3] = bfhi(a.y); q[i * 8 + 4] = bflo(a.z); q[i * 8 + 5] = bfhi(a.z); q[i * 8 + 6] = bflo(a.w); q[i * 8 + 7] = bfhi(a.w);
      k[i * 8 + 0] = bflo(b.x); k[i * 8 + 1] = bfhi(b.x); k[i * 8 + 2] = bflo(b.y); k[i * 8 + 3] = bfhi(b.y); k[i * 8 + 4] = bflo(b.z); k[i * 8 + 5] = bfhi(b.z); k[i * 8 + 6] = bflo(b.w); k[i * 8 + 7] = bfhi(b.w);
    }
  }
  const bool lat = m < MLAT;
  const int b = lat ? (m >> 13) : ((m - MLAT) >> 8), t = lat ? (m & 8191) : ((m - MLAT) & 255);
  if (lat) {
    const float* rc = (const float*)(P.ws + WS_ROPE); const float* rs = rc + 1024;
#pragma unroll
    for (int a = 0; a < 2; ++a) {
      const int pos = a ? (t & 63) : (t >> 6);
#pragma unroll
      for (int f = 0; f < 8; ++f) {
        const float cs = rc[pos * 8 + f], sn = rs[pos * 8 + f];
        float x0 = q[a * 16 + f], x1 = q[a * 16 + 8 + f]; q[a * 16 + f] = x0 * cs - x1 * sn; q[a * 16 + 8 + f] = x1 * cs + x0 * sn;
        x0 = k[a * 16 + f]; x1 = k[a * 16 + 8 + f]; k[a * 16 + f] = x0 * cs - x1 * sn; k[a * 16 + 8 + f] = x1 * cs + x0 * sn;
      }
    }
  }
  const int pos = lat ? t : 8192 + t;
  const float QS = 0.17677669529663687f * 1.4426950408889634f;
  float k2 = 0.f;
  u16* qd = (u16*)(P.ws + WS_Q) + ((size_t)((b * 4 + h) * 2 + c) * NKEY + pos) * 32;
  u16* kd = (u16*)(P.ws + WS_K) + ((size_t)((b * 4 + h) * 2 + c) * NKEY + pos) * 32;
#pragma unroll
  for (int i = 0; i < 4; ++i) {
    uint4 a, bb;
    a.x = pk2(q[i * 8 + 0] * QS, q[i * 8 + 1] * QS); a.y = pk2(q[i * 8 + 2] * QS, q[i * 8 + 3] * QS); a.z = pk2(q[i * 8 + 4] * QS, q[i * 8 + 5] * QS); a.w = pk2(q[i * 8 + 6] * QS, q[i * 8 + 7] * QS);
    bb.x = pk2(k[i * 8 + 0], k[i * 8 + 1]); bb.y = pk2(k[i * 8 + 2], k[i * 8 + 3]); bb.z = pk2(k[i * 8 + 4], k[i * 8 + 5]); bb.w = pk2(k[i * 8 + 6], k[i * 8 + 7]);
    ((uint4*)qd)[i] = a; ((uint4*)kd)[i] = bb;
  }
#pragma unroll
  for (int i = 0; i < 32; ++i) k2 += k[i] * k[i];
  k2 = fmaxf(k2, shx(k2, 8)); k2 = fmaxf(k2, shx(k2, 16)); k2 = fmaxf(k2, shx(k2, 32));
  float* kred = (float*)(lds + 40960);
  if ((tid & 63) < 8) kred[(tid >> 6) * 8 + (tid & 7)] = k2;
  {
    u16* vt = (u16*)lds;
    const uint4* vs = (const uint4*)(urow + UC_V + h * 64 + c * 32);
    const int p64 = pos & 63, within = p64 & 15, hh = (within >> 2) & 1, jj = ((within >> 3) << 2) | (within & 3);
    const int col = (p64 & ~15) + 8 * hh + jj;
    u16* vd = vt + (h * 64 + c * 32) * 72 + col;
#pragma unroll
    for (int i = 0; i < 4; ++i) {
      uint4 a = vs[i];
      vd[(i * 8 + 0) * 72] = (u16)(a.x & 0xffff); vd[(i * 8 + 1) * 72] = (u16)(a.x >> 16);
      vd[(i * 8 + 2) * 72] = (u16)(a.y & 0xffff); vd[(i * 8 + 3) * 72] = (u16)(a.y >> 16);
      vd[(i * 8 + 4) * 72] = (u16)(a.z & 0xffff); vd[(i * 8 + 5) * 72] = (u16)(a.z >> 16);
      vd[(i * 8 + 6) * 72] = (u16)(a.w & 0xffff); vd[(i * 8 + 7) * 72] = (u16)(a.w >> 16);
    }
    __syncthreads();
    const int m0u = unit * 64;
    const int bu = m0u < MLAT ? (m0u >> 13) : ((m0u - MLAT) >> 8), pos0 = m0u < MLAT ? (m0u & 8191) : 8192 + ((m0u - MLAT) & 255);
    u16* Vg = (u16*)(P.ws + WS_VT) + (size_t)(bu * 4) * 64 * NKEY + pos0;
#pragma unroll
    for (int q = 0; q < 4; ++q) {
      const int idx = tid + q * NTHREADS, row = idx >> 3, part = idx & 7;
      *(uint4*)(Vg + (size_t)row * NKEY + part * 8) = *(const uint4*)(vt + row * 72 + part * 8);
    }
    if (tid < 8) {
      float mx = 0.f;
#pragma unroll
      for (int w8 = 0; w8 < 8; ++w8) mx = fmaxf(mx, kred[w8 * 8 + tid]);
      atomicMax((unsigned*)(P.ws + WS_MISC) + ((l * 2 + bu) * 4 + (tid >> 1)) * 2 + (tid & 1), __float_as_uint(mx));
    }
    __syncthreads();
  }
}

constexpr int QP = 136, GP = 129, GLA_SG = 2 * 64 * QP * 2 + 64 * 256 * 2, GLA_SLR = GLA_SG + 2 * 64 * GP * 4;
DI void gla_stage(const Params& P, int l, int b, int cb, char* lds) {
  u16* sq = (u16*)lds; u16* sk = sq + 64 * QP; u16* sv = sk + 64 * QP; float* sg = (float*)(lds + GLA_SG); float* slr = (float*)(lds + GLA_SLR);
  const int tid = tidx(), m0 = blk_m0(b, cb);
  const u16* U = (const u16*)(P.ws + WS_U);
#pragma unroll
  for (int e = tid; e < 1024; e += NTHREADS) {
    int t = e >> 4, part = e & 15; const u16* row = U + (size_t)(m0 + t) * UP;
    *(uint4*)(sq + t * QP + part * 8) = *(const uint4*)(row + UA_Q + part * 8);
    *(uint4*)(sk + t * QP + part * 8) = *(const uint4*)(row + UA_K + part * 8);
  }
#pragma unroll
  for (int e = tid; e < 2048; e += NTHREADS) { int t = e >> 5, part = e & 31; *(uint4*)(sv + t * 256 + part * 8) = *(const uint4*)(U + (size_t)(m0 + t) * UP + UA_V + part * 8); }
  {
    int t = tid >> 3, part = tid & 7;
    uint2 v = *(const uint2*)(U + (size_t)(m0 + t) * UP + UA_LRF + part * 4);
    int dir = part >> 2, r0 = (part & 3) * 4; float* d = slr + (dir * 64 + t) * 16 + r0;
    d[0] = bflo(v.x); d[1] = bfhi(v.x); d[2] = bflo(v.y); d[3] = bfhi(v.y);
  }
  __syncthreads();
  {
    const int hk = tid & 127, tq = tid >> 7;
#pragma unroll
    for (int dir = 0; dir < 2; ++dir) {
      float wv[16];
#pragma unroll
      for (int r = 0; r < 16; ++r) wv[r] = P.gla_w2[((l * 2 + dir) * 16 + r) * 128 + hk];
      const float bb = P.gla_b2[(l * 2 + dir) * 128 + hk];
      for (int t = tq; t < 64; t += 4) {
        const float* lr = slr + (dir * 64 + t) * 16; float z = bb;
#pragma unroll
        for (int r = 0; r < 16; ++r) z += lr[r] * wv[r];
        const float ls = fminf(z, 0.f) - __logf(1.f + __expf(-fabsf(z)));
        sg[(dir * 64 + t) * GP + hk] = ls * (1.f / 16.f);
      }
    }
  }
  __syncthreads();
  if (tid < 256) {
    const int dir = tid >> 7, hk = tid & 127; float s = 0.f;
    float* col = sg + dir * 64 * GP + hk; float v[64];
#pragma unroll
    for (int t = 0; t < 64; ++t) v[t] = col[t * GP];
    if (dir == 0) {
#pragma unroll
      for (int t = 0; t < 64; ++t) { s += v[t]; col[t * GP] = s; }
    } else {
#pragma unroll
      for (int t = 63; t >= 0; --t) { s += v[t]; col[t * GP] = s; }
    }
  }
  __syncthreads();
}

DI void gla_local(const Params& P, int l, int b, int cb, char* lds) {
  gla_stage(P, l, b, cb, lds);
  const u16* sk = (const u16*)lds + 64 * QP; const u16* sv = sk + 64 * QP; const float* sg = (const float*)(lds + GLA_SG);
  const int tid = tidx(), w = tid >> 6, lane = tid & 63, c31 = lane & 31, hh = lane >> 5, dir = w >> 2, h = w & 3;
  const float* g = sg + dir * 64 * GP;
  const float glast = g[(dir ? 0 : 63) * GP + h * 32 + c31];
  f32x16 acc[2];
#pragma unroll
  for (int r = 0; r < 16; ++r) { acc[0][r] = 0.f; acc[1][r] = 0.f; }
#pragma unroll
  for (int ks = 0; ks < 4; ++ks) {
    float av[8];
#pragma unroll
    for (int e = 0; e < 8; ++e) { const int j = ks * 16 + hh * 8 + e; av[e] = bf2f(sk[j * QP + h * 32 + c31]) * __expf(glast - g[j * GP + h * 32 + c31]); }
    const bf16x8 a = pack8(av[0], av[1], av[2], av[3], av[4], av[5], av[6], av[7]);
#pragma unroll
    for (int vt = 0; vt < 2; ++vt) {
      bf16x8 bv;
#pragma unroll
      for (int e = 0; e < 8; ++e) bv[e] = (short)sv[(ks * 16 + hh * 8 + e) * 256 + h * 64 + vt * 32 + c31];
      acc[vt] = MFMA32(a, bv, acc[vt]);
    }
  }
  const int seq = (b * 2 + dir) * 4 + h, ci = blk_ci(cb, dir);
  u16* dst = (u16*)(P.ws + WS_GLA) + (size_t)(seq * NCH + ci) * 2048;
#pragma unroll
  for (int vt = 0; vt < 2; ++vt)
#pragma unroll
    for (int r = 0; r < 16; ++r) dst[crow(r, hh) * 64 + vt * 32 + c31] = f2bf(acc[vt][r]);
  if (hh == 0) ((float*)(P.ws + WS_GLAD))[(seq * NCH + ci) * 32 + c31] = __expf(glast);
  __syncthreads();
}

DI void gla_out(const Params& P, int l, int b, int cb, char* lds) {
  gla_stage(P, l, b, cb, lds);
  const u16* sq = (const u16*)lds; const u16* sk = sq + 64 * QP; const u16* sv = sk + 64 * QP; const float* sg = (const float*)(lds + GLA_SG);
  const int tid = tidx(), w = tid >> 6, lane = tid & 63, c31 = lane & 31, hh = lane >> 5, dir = w >> 2, h = w & 3;
  const float* g = sg + dir * 64 * GP;
  const int seq = (b * 2 + dir) * 4 + h, ci = blk_ci(cb, dir), m0 = blk_m0(b, cb);
  const u16* Sin = (const u16*)(P.ws + WS_GLA) + (size_t)(seq * NCH + ci) * 2048;
  f32x16 o[2][2];
#pragma unroll
  for (int a = 0; a < 2; ++a)
#pragma unroll
    for (int bb = 0; bb < 2; ++bb)
#pragma unroll
      for (int r = 0; r < 16; ++r) o[a][bb][r] = 0.f;
  bf16x8 qg[2][2];
#pragma unroll
  for (int it = 0; it < 2; ++it)
#pragma unroll
    for (int ks = 0; ks < 2; ++ks) {
      float v[8]; const int i = it * 32 + c31;
#pragma unroll
      for (int e = 0; e < 8; ++e) { const int kk = h * 32 + ks * 16 + hh * 8 + e; v[e] = bf2f(sq[i * QP + kk]) * __expf(g[i * GP + kk]) * 0.17677669529663687f; }
      qg[it][ks] = pack8(v[0], v[1], v[2], v[3], v[4], v[5], v[6], v[7]);
    }
#pragma unroll
  for (int ks = 0; ks < 2; ++ks)
#pragma unroll
    for (int vt = 0; vt < 2; ++vt) {
      bf16x8 sa;
#pragma unroll
      for (int e = 0; e < 8; ++e) sa[e] = (short)Sin[(ks * 16 + hh * 8 + e) * 64 + vt * 32 + c31];
#pragma unroll
      for (int it = 0; it < 2; ++it) o[vt][it] = MFMA32(sa, qg[it][ks], o[vt][it]);
    }
#pragma unroll
  for (int jt = 0; jt < 2; ++jt) {
    bf16x8 kg[2];
#pragma unroll
    for (int ks = 0; ks < 2; ++ks) {
      float v[8]; const int j = jt * 32 + c31;
#pragma unroll
      for (int e = 0; e < 8; ++e) { const int kk = h * 32 + ks * 16 + hh * 8 + e; v[e] = bf2f(sk[j * QP + kk]) * __expf(-g[j * GP + kk]); }
      kg[ks] = pack8(v[0], v[1], v[2], v[3], v[4], v[5], v[6], v[7]);
    }
#pragma unroll
    for (int it = 0; it < 2; ++it) {
      const bool skip = dir == 0 ? (jt > it) : (jt < it);
      if (skip) continue;
      f32x16 s;
#pragma unroll
      for (int r = 0; r < 16; ++r) s[r] = 0.f;
      s = MFMA32(kg[0], qg[it][0], s); s = MFMA32(kg[1], qg[it][1], s);
      const int i = it * 32 + c31;
#pragma unroll
      for (int r = 0; r < 16; ++r) { const int j = jt * 32 + crow(r, hh); const bool keep = dir == 0 ? (j <= i) : (j >= i); s[r] = keep ? s[r] : 0.f; }
      const bf16x8 p0 = pack8(s[0], s[1], s[2], s[3], s[4], s[5], s[6], s[7]), p1 = pack8(s[8], s[9], s[10], s[11], s[12], s[13], s[14], s[15]);
#pragma unroll
      for (int s2 = 0; s2 < 2; ++s2)
#pragma unroll
        for (int vt = 0; vt < 2; ++vt) {
          bf16x8 va;
#pragma unroll
          for (int e = 0; e < 8; ++e) { const int j = jt * 32 + 16 * s2 + 8 * (e >> 2) + 4 * hh + (e & 3); va[e] = (short)sv[j * 256 + h * 64 + vt * 32 + c31]; }
          o[vt][it] = MFMA32(va, s2 ? p1 : p0, o[vt][it]);
        }
    }
  }
  __syncthreads();
  float* xb = (float*)(lds + GLA_SG);
  if (dir == 1) {
#pragma unroll
    for (int vt = 0; vt < 2; ++vt)
#pragma unroll
      for (int it = 0; it < 2; ++it)
#pragma unroll
        for (int r = 0; r < 16; ++r) xb[(it * 32 + c31) * 257 + h * 64 + vt * 32 + crow(r, hh)] = o[vt][it][r];
  }
  __syncthreads();
  if (dir == 0) {
#pragma unroll
    for (int vt = 0; vt < 2; ++vt)
#pragma unroll
      for (int it = 0; it < 2; ++it)
#pragma unroll
        for (int r = 0; r < 16; ++r) xb[(it * 32 + c31) * 257 + h * 64 + vt * 32 + crow(r, hh)] += o[vt][it][r];
  }
  __syncthreads();
  {
    const u16* U = (const u16*)(P.ws + WS_U); u16* Y = (u16*)(P.ws + WS_XN);
#pragma unroll
    for (int q = 0; q < 4; ++q) {
      const int idx = tid + q * NTHREADS, row = idx >> 5, ch0 = (idx & 31) * 8; const size_t m = (size_t)(m0 + row);
      const uint4 gv = ld_nt((const uint4*)(U + m * UP + UA_G + ch0));
      float v[8]; float ss = 0.f;
#pragma unroll
      for (int e = 0; e < 8; ++e) { v[e] = xb[row * 257 + ch0 + e]; ss += v[e] * v[e]; }
      ss += shx(ss, 1); ss += shx(ss, 2); ss += shx(ss, 4);
      const float rstd = rsqrtf(ss * (1.f / 64.f) + 1e-6f);
      const float4 n0 = *(const float4*)(P.gla_norm_w + l * 64 + (ch0 & 63)), n1 = *(const float4*)(P.gla_norm_w + l * 64 + (ch0 & 63) + 4);
      uint4 ov;
      ov.x = pk2(v[0] * rstd * n0.x * siluf(bflo(gv.x)), v[1] * rstd * n0.y * siluf(bfhi(gv.x)));
      ov.y = pk2(v[2] * rstd * n0.z * siluf(bflo(gv.y)), v[3] * rstd * n0.w * siluf(bfhi(gv.y)));
      ov.z = pk2(v[4] * rstd * n1.x * siluf(bflo(gv.z)), v[5] * rstd * n1.y * siluf(bfhi(gv.z)));
      ov.w = pk2(v[6] * rstd * n1.z * siluf(bflo(gv.w)), v[7] * rstd * n1.w * siluf(bfhi(gv.w)));
      *(uint4*)(Y + m * 1024 + ch0) = ov;
    }
  }
  __syncthreads();
}

constexpr int SXP = 520;
DI void ssd_stage(const Params& P, int l, int b, int cb, char* lds) {
  u16* sx = (u16*)lds; float* scum = (float*)(lds + 132352); float* sdt = scum + 512;
  const int tid = tidx(), m0 = blk_m0(b, cb);
  const u16* U = (const u16*)(P.ws + WS_U);
  const int tseq0 = cb < 4 ? cb * 64 : (cb - 4) * 64, slen = cb < 4 ? 256 : T, mseq0 = cb < 4 ? MLAT + b * 256 : b * T;
  {
    const int ch0 = (tid & 63) * 8;
    float wt[4][8], bs[8];
    { const float4 b0 = *(const float4*)(P.ssd_conv_b + l * 512 + ch0), b1 = *(const float4*)(P.ssd_conv_b + l * 512 + ch0 + 4);
      bs[0] = b0.x; bs[1] = b0.y; bs[2] = b0.z; bs[3] = b0.w; bs[4] = b1.x; bs[5] = b1.y; bs[6] = b1.z; bs[7] = b1.w; }
#pragma unroll
    for (int j = 0; j < 4; ++j) {
      const float* wj = gp(P.ssd_conv_w + (l * 4 + j) * 512 + ch0); const float4 w0 = *(const float4*)wj, w1 = *(const float4*)(wj + 4);
      wt[j][0] = w0.x; wt[j][1] = w0.y; wt[j][2] = w0.z; wt[j][3] = w0.w; wt[j][4] = w1.x; wt[j][5] = w1.y; wt[j][6] = w1.z; wt[j][7] = w1.w;
    }
#pragma unroll 2
    for (int t = tid >> 6; t < 64; t += 8) {
      float acc[8];
#pragma unroll
      for (int i = 0; i < 8; ++i) acc[i] = bs[i];
#pragma unroll
      for (int j = 0; j < 4; ++j) {
        const int ts = tseq0 + t - 2 + j;
        if (ts >= 0 && ts < slen) {
          const uint4 v = *(const uint4*)(U + (size_t)(mseq0 + ts) * UP + UD_XBC + ch0);
          acc[0] += bflo(v.x) * wt[j][0]; acc[1] += bfhi(v.x) * wt[j][1]; acc[2] += bflo(v.y) * wt[j][2]; acc[3] += bfhi(v.y) * wt[j][3];
          acc[4] += bflo(v.z) * wt[j][4]; acc[5] += bfhi(v.z) * wt[j][5]; acc[6] += bflo(v.w) * wt[j][6]; acc[7] += bfhi(v.w) * wt[j][7];
        }
      }
      uint4 o; o.x = pk2(siluf(acc[0]), siluf(acc[1])); o.y = pk2(siluf(acc[2]), siluf(acc[3])); o.z = pk2(siluf(acc[4]), siluf(acc[5])); o.w = pk2(siluf(acc[6]), siluf(acc[7]));
      *(uint4*)(sx + t * SXP + ch0) = o;
    }
  }
  {
    const int dir = tid >> 8, t = (tid >> 2) & 63, hd = tid & 3;
    const float raw = bf2f(U[(size_t)(m0 + t) * UP + UD_DTF + dir * 4 + hd]);
    const float dt = softplusf(raw + P.ssd_dt_bias[(l * 2 + dir) * 4 + hd]);
    const float a = -__expf(P.ssd_a_log[(l * 2 + dir) * 4 + hd]);
    sdt[(dir * 64 + t) * 4 + hd] = dt; scum[(dir * 64 + t) * 4 + hd] = dt * a;
  }
  __syncthreads();
  if (tid < 8) {
    const int dir = tid >> 2, hd = tid & 3; float s = 0.f;
    float* col = scum + dir * 256 + hd; float v[64];
#pragma unroll
    for (int t = 0; t < 64; ++t) v[t] = col[t * 4];
    if (dir == 0) {
#pragma unroll
      for (int t = 0; t < 64; ++t) { s += v[t]; col[t * 4] = s; }
    } else {
#pragma unroll
      for (int t = 63; t >= 0; --t) { s += v[t]; col[t * 4] = s; }
    }
  }
  __syncthreads();
}

DI void ssd_local(const Params& P, int l, int b, int cb, char* lds) {
  ssd_stage(P, l, b, cb, lds);
  const u16* sx = (const u16*)lds; const float* scum = (const float*)(lds + 132352); const float* sdt = scum + 512;
  const int tid = tidx(), w = tid >> 6, lane = tid & 63, c31 = lane & 31, hh = lane >> 5, dir = w >> 2, h = w & 3, grp = h >> 1;
  const float cl = scum[(dir * 64 + (dir ? 0 : 63)) * 4 + h];
  f32x16 acc[2][2];
#pragma unroll
  for (int a = 0; a < 2; ++a)
#pragma unroll
    for (int bb = 0; bb < 2; ++bb)
#pragma unroll
      for (int r = 0; r < 16; ++r) acc[a][bb][r] = 0.f;
#pragma unroll
  for (int ks = 0; ks < 4; ++ks) {
    float wgt[8];
#pragma unroll
    for (int e = 0; e < 8; ++e) { const int s = ks * 16 + hh * 8 + e; wgt[e] = __expf(cl - scum[(dir * 64 + s) * 4 + h]) * sdt[(dir * 64 + s) * 4 + h]; }
    bf16x8 bn[2];
#pragma unroll
    for (int nt = 0; nt < 2; ++nt)
#pragma unroll
      for (int e = 0; e < 8; ++e) bn[nt][e] = (short)sx[(ks * 16 + hh * 8 + e) * SXP + 256 + grp * 64 + nt * 32 + c31];
#pragma unroll
    for (int pt = 0; pt < 2; ++pt) {
      float v[8];
#pragma unroll
      for (int e = 0; e < 8; ++e) v[e] = bf2f(sx[(ks * 16 + hh * 8 + e) * SXP + h * 64 + pt * 32 + c31]) * wgt[e];
      const bf16x8 a = pack8(v[0], v[1], v[2], v[3], v[4], v[5], v[6], v[7]);
#pragma unroll
      for (int nt = 0; nt < 2; ++nt) acc[pt][nt] = MFMA32(a, bn[nt], acc[pt][nt]);
    }
  }
  const int seq = (b * 2 + dir) * 4 + h, ci = blk_ci(cb, dir);
  u16* dst = (u16*)(P.ws + WS_SSD) + (size_t)(seq * NCH + ci) * 4096;
#pragma unroll
  for (int pt = 0; pt < 2; ++pt)
#pragma unroll
    for (int nt = 0; nt < 2; ++nt)
#pragma unroll
      for (int r = 0; r < 16; ++r) dst[(pt * 32 + crow(r, hh)) * 64 + nt * 32 + c31] = f2bf(acc[pt][nt][r]);
  if (lane == 0) ((float*)(P.ws + WS_SSDD))[seq * NCH + ci] = __expf(cl);
  __syncthreads();
}

DI void ssd_out(const Params& P, int l, int b, int cb, char* lds) {
  ssd_stage(P, l, b, cb, lds);
  const u16* sx = (const u16*)lds; float* xb = (float*)(lds + 66560); const float* scum = (const float*)(lds + 132352); const float* sdt = scum + 512; float* ssq = (float*)(lds + 136448);
  const int tid = tidx(), w = tid >> 6, lane = tid & 63, c31 = lane & 31, hh = lane >> 5, dir = w >> 2, h = w & 3, grp = h >> 1;
  const int seq = (b * 2 + dir) * 4 + h, ci = blk_ci(cb, dir), m0 = blk_m0(b, cb);
  const u16* Sin = (const u16*)(P.ws + WS_SSD) + (size_t)(seq * NCH + ci) * 4096;
  f32x16 y[2][2];
#pragma unroll
  for (int a = 0; a < 2; ++a)
#pragma unroll
    for (int bb = 0; bb < 2; ++bb)
#pragma unroll
      for (int r = 0; r < 16; ++r) y[a][bb][r] = 0.f;
#pragma unroll
  for (int lt = 0; lt < 2; ++lt) {
    const int tl = lt * 32 + c31;
    const float cuml = scum[(dir * 64 + tl) * 4 + h];
    const float ecl = __expf(cuml);
#pragma unroll
    for (int ks = 0; ks < 4; ++ks) {
      const uint4 cv = *(const uint4*)(sx + tl * SXP + 384 + grp * 64 + ks * 16 + hh * 8);
      const bf16x8 cmf = pack8(bflo(cv.x) * ecl, bfhi(cv.x) * ecl, bflo(cv.y) * ecl, bfhi(cv.y) * ecl, bflo(cv.z) * ecl, bfhi(cv.z) * ecl, bflo(cv.w) * ecl, bfhi(cv.w) * ecl);
#pragma unroll
      for (int pt = 0; pt < 2; ++pt) {
        const uint4 sraw = ld_nt((const uint4*)(Sin + (pt * 32 + c31) * 64 + ks * 16 + hh * 8)); const bf16x8 sa = mk8(sraw.x, sraw.y, sraw.z, sraw.w);
        y[pt][lt] = MFMA32(sa, cmf, y[pt][lt]);
      }
    }
#pragma unroll
    for (int st = 0; st < 2; ++st) {
      const bool skip = dir == 0 ? (st > lt) : (st < lt);
      if (skip) continue;
      f32x16 cbt;
#pragma unroll
      for (int r = 0; r < 16; ++r) cbt[r] = 0.f;
#pragma unroll
      for (int ks = 0; ks < 4; ++ks) {
        const bf16x8 bmf = *(const bf16x8*)(sx + (st * 32 + c31) * SXP + 256 + grp * 64 + ks * 16 + hh * 8);
        const bf16x8 cmf = *(const bf16x8*)(sx + tl * SXP + 384 + grp * 64 + ks * 16 + hh * 8);
        cbt = MFMA32(bmf, cmf, cbt);
      }
#pragma unroll
      for (int r = 0; r < 16; ++r) {
        const int s = st * 32 + crow(r, hh); const bool keep = dir == 0 ? (s <= tl) : (s >= tl);
        const float dec = __expf(fminf(cuml - scum[(dir * 64 + s) * 4 + h], 0.f)) * sdt[(dir * 64 + s) * 4 + h];
        cbt[r] = keep ? cbt[r] * dec : 0.f;
      }
      const bf16x8 p0 = pack8(cbt[0], cbt[1], cbt[2], cbt[3], cbt[4], cbt[5], cbt[6], cbt[7]), p1 = pack8(cbt[8], cbt[9], cbt[10], cbt[11], cbt[12], cbt[13], cbt[14], cbt[15]);
#pragma unroll
      for (int s2 = 0; s2 < 2; ++s2)
#pragma unroll
        for (int pt = 0; pt < 2; ++pt) {
          bf16x8 xa;
#pragma unroll
          for (int e = 0; e < 8; ++e) { const int s = st * 32 + 16 * s2 + 8 * (e >> 2) + 4 * hh + (e & 3); xa[e] = (short)sx[s * SXP + h * 64 + pt * 32 + c31]; }
          y[pt][lt] = MFMA32(xa, s2 ? p1 : p0, y[pt][lt]);
        }
    }
  }
  if (dir == 1) {
#pragma unroll
    for (int pt = 0; pt < 2; ++pt)
#pragma unroll
      for (int lt = 0; lt < 2; ++lt)
#pragma unroll
        for (int r = 0; r < 16; ++r) xb[(lt * 32 + c31) * 257 + h * 64 + pt * 32 + crow(r, hh)] = y[pt][lt][r];
  }
  __syncthreads();
  if (dir == 0) {
    const float dsk = P.ssd_d[l * 4 + h];
#pragma unroll
    for (int lt = 0; lt < 2; ++lt) {
      const int tl = lt * 32 + c31;
#pragma unroll
      for (int pt = 0; pt < 2; ++pt)
#pragma unroll
        for (int r = 0; r < 16; ++r) {
          const int p = pt * 32 + crow(r, hh);
          xb[tl * 257 + h * 64 + p] += y[pt][lt][r] + dsk * bf2f(sx[tl * SXP + h * 64 + p]);
        }
    }
  }
  __syncthreads();
  {
    const u16* U = (const u16*)(P.ws + WS_U); u16* Y = (u16*)(P.ws + WS_XN);
#pragma unroll
    for (int q = 0; q < 4; ++q) {
      const int idx = tid + q * NTHREADS, row = idx >> 5, ch0 = (idx & 31) * 8; const size_t m = (size_t)(m0 + row);
      const uint4 zv = ld_nt((const uint4*)(U + m * UP + UD_Z + ch0));
      const float zz[8] = {bflo(zv.x), bfhi(zv.x), bflo(zv.y), bfhi(zv.y), bflo(zv.z), bfhi(zv.z), bflo(zv.w), bfhi(zv.w)};
      float v[8]; float ss = 0.f;
#pragma unroll
      for (int e = 0; e < 8; ++e) { v[e] = xb[row * 257 + ch0 + e] * siluf(zz[e]); ss += v[e] * v[e]; }
      ss += shx(ss, 1); ss += shx(ss, 2); ss += shx(ss, 4); ss += shx(ss, 8); ss += shx(ss, 16);
      const float rstd = rsqrtf(ss * (1.f / 256.f) + 1e-6f);
      const float4 n0 = *(const float4*)(P.ssd_norm_w + l * 256 + ch0), n1 = *(const float4*)(P.ssd_norm_w + l * 256 + ch0 + 4);
      uint4 ov;
      ov.x = pk2(v[0] * rstd * n0.x, v[1] * rstd * n0.y); ov.y = pk2(v[2] * rstd * n0.z, v[3] * rstd * n0.w);
      ov.z = pk2(v[4] * rstd * n1.x, v[5] * rstd * n1.y); ov.w = pk2(v[6] * rstd * n1.z, v[7] * rstd * n1.w);
      *(uint4*)(Y + m * 1024 + 768 + ch0) = ov;
    }
  }
  __syncthreads();
}

constexpr int LXP = 264;
DI float neg_expm1f(float x) { return x > -0.01f ? -x * (1.f + x * (0.5f + x * (1.f / 6.f))) : 1.f - __expf(x); }

DI void lru_stage(const Params& P, int l, int b, int cb, char* lds) {
  u16* sxc = (u16*)lds;
  const int tid = tidx();
  const u16* U = (const u16*)(P.ws + WS_U);
  const int tseq0 = cb < 4 ? cb * 64 : (cb - 4) * 64, slen = cb < 4 ? 256 : T, mseq0 = cb < 4 ? MLAT + b * 256 : b * T;
  {
    const int ch0 = (tid & 31) * 8;
    float wt[4][8], bs[8];
    { const float4 b0 = *(const float4*)(P.lru_conv_b + l * 256 + ch0), b1 = *(const float4*)(P.lru_conv_b + l * 256 + ch0 + 4);
      bs[0] = b0.x; bs[1] = b0.y; bs[2] = b0.z; bs[3] = b0.w; bs[4] = b1.x; bs[5] = b1.y; bs[6] = b1.z; bs[7] = b1.w; }
#pragma unroll
    for (int j = 0; j < 4; ++j) {
      const float* wj = gp(P.lru_conv_w + (l * 4 + j) * 256 + ch0); const float4 w0 = *(const float4*)wj, w1 = *(const float4*)(wj + 4);
      wt[j][0] = w0.x; wt[j][1] = w0.y; wt[j][2] = w0.z; wt[j][3] = w0.w; wt[j][4] = w1.x; wt[j][5] = w1.y; wt[j][6] = w1.z; wt[j][7] = w1.w;
    }
#pragma unroll 2
    for (int t = tid >> 5; t < 64; t += 16) {
      float acc[8];
#pragma unroll
      for (int i = 0; i < 8; ++i) acc[i] = bs[i];
#pragma unroll
      for (int j = 0; j < 4; ++j) {
        const int ts = tseq0 + t - 2 + j;
        if (ts >= 0 && ts < slen) {
          const uint4 v = *(const uint4*)(U + (size_t)(mseq0 + ts) * UP + UB_X + ch0);
          acc[0] += bflo(v.x) * wt[j][0]; acc[1] += bfhi(v.x) * wt[j][1]; acc[2] += bflo(v.y) * wt[j][2]; acc[3] += bfhi(v.y) * wt[j][3];
          acc[4] += bflo(v.z) * wt[j][4]; acc[5] += bfhi(v.z) * wt[j][5]; acc[6] += bflo(v.w) * wt[j][6]; acc[7] += bfhi(v.w) * wt[j][7];
        }
      }
      uint4 o; o.x = pk2(acc[0], acc[1]); o.y = pk2(acc[2], acc[3]); o.z = pk2(acc[4], acc[5]); o.w = pk2(acc[6], acc[7]);
      *(uint4*)(sxc + t * LXP + ch0) = o;
    }
  }
  __syncthreads();
}

DI void lru_gates(const Params& P, int l, int dir, int g, int ct, const u16* sxc, f32x16 (&av)[2], f32x16 (&uv)[2]) {
  const int lane = tidx() & 63, c31 = lane & 31, hh = lane >> 5;
#pragma unroll
  for (int a = 0; a < 2; ++a)
#pragma unroll
    for (int r = 0; r < 16; ++r) { av[a][r] = 0.f; uv[a][r] = 0.f; }
  const u16* wfa_p = (const u16*)(P.ws + WS_LRUW) + (size_t)((((l * 2 + dir) * 4 + g) * 2 + 0) * 4096) + (ct * 64 + lane) * 8;
  const u16* wfx_p = wfa_p + 4096;
#pragma unroll
  for (int ks = 0; ks < 4; ++ks) {
    const bf16x8 wfa = *(const bf16x8*)(wfa_p + ks * 1024), wfx = *(const bf16x8*)(wfx_p + ks * 1024);
#pragma unroll
    for (int tt = 0; tt < 2; ++tt) {
      const bf16x8 xa = *(const bf16x8*)(sxc + (tt * 32 + c31) * LXP + g * 64 + ks * 16 + hh * 8);
      av[tt] = MFMA32(xa, wfa, av[tt]); uv[tt] = MFMA32(xa, wfx, uv[tt]);
    }
  }
  const int ch = g * 64 + ct * 32 + c31;
  const float ba = P.lru_ba[(l * 2 + dir) * 256 + ch], bx = P.lru_bx[(l * 2 + dir) * 256 + ch];
  const float sp = softplusf(-P.lru_lam[(l * 2 + dir) * 256 + ch]);
#pragma unroll
  for (int tt = 0; tt < 2; ++tt)
#pragma unroll
    for (int r = 0; r < 16; ++r) {
      const float rg = sigmf(av[tt][r] + ba), ig = sigmf(uv[tt][r] + bx);
      const float la = -8.f * rg * sp;
      const float xv = bf2f(sxc[(tt * 32 + crow(r, hh)) * LXP + ch]);
      av[tt][r] = __expf(la);
      uv[tt][r] = __builtin_amdgcn_sqrtf(neg_expm1f(2.f * la)) * ig * xv;
    }
}

template <int REV>
DI void lru_scan(f32x16 (&av)[2], f32x16 (&uv)[2], float& hc, float& ap) {
  const int hh = (tidx() & 63) >> 5;
  const bool first = (hh == (REV ? 1 : 0));
  ap = 1.f;
#pragma unroll
  for (int tti = 0; tti < 2; ++tti) {
    const int tt = REV ? 1 - tti : tti;
#pragma unroll
    for (int ii = 0; ii < 4; ++ii) {
      const int i = REV ? 3 - ii : ii;
      float GA = 1.f, GU = 0.f;
#pragma unroll
      for (int ee = 0; ee < 4; ++ee) { const int r = 4 * i + (REV ? 3 - ee : ee); GU = av[tt][r] * GU + uv[tt][r]; GA *= av[tt][r]; }
      const float PA = shx(GA, 32), PU = shx(GU, 32);
      float hcur = first ? hc : PA * hc + PU;
#pragma unroll
      for (int ee = 0; ee < 4; ++ee) { const int r = 4 * i + (REV ? 3 - ee : ee); hcur = av[tt][r] * hcur + uv[tt][r]; uv[tt][r] = hcur; }
      const float pairA = GA * PA, pairU = first ? PA * GU + PU : GA * PU + GU;
      hc = pairA * hc + pairU; ap *= pairA;
    }
  }
}

DI void lru_local(const Params& P, int l, int b, int cb, char* lds) {
  lru_stage(P, l, b, cb, lds);
  const int tid = tidx(), w = tid >> 6, lane = tid & 63, c31 = lane & 31, hh = lane >> 5, dir = w >> 2, g = w & 3;
  const int ci = blk_ci(cb, dir);
#pragma unroll 1
  for (int ct = 0; ct < 2; ++ct) {
    f32x16 av[2], uv[2];
    lru_gates(P, l, dir, g, ct, (const u16*)lds, av, uv);
    float hc = 0.f, ap;
    if (dir) lru_scan<1>(av, uv, hc, ap); else lru_scan<0>(av, uv, hc, ap);
    if (hh == 0) {
      const int ch = g * 64 + ct * 32 + c31;
      ((float*)(P.ws + WS_LRUA))[((b * 2 + dir) * NCH + ci) * 256 + ch] = ap;
      ((float*)(P.ws + WS_LRUU))[((b * 2 + dir) * NCH + ci) * 256 + ch] = hc;
    }
  }
  __syncthreads();
}

DI void lru_out(const Params& P, int l, int b, int cb, char* lds) {
  lru_stage(P, l, b, cb, lds);
  const int tid = tidx(), w = tid >> 6, lane = tid & 63, c31 = lane & 31, hh = lane >> 5, dir = w >> 2, g = w & 3;
  const int ci = blk_ci(cb, dir), m0 = blk_m0(b, cb);
  float* xb = (float*)(lds + 34816);
  f32x16 hres[2][2];
#pragma unroll
  for (int ct = 0; ct < 2; ++ct) {
    f32x16 av[2], uv[2];
    lru_gates(P, l, dir, g, ct, (const u16*)lds, av, uv);
    float hc = ((const float*)(P.ws + WS_LRUU))[((b * 2 + dir) * NCH + ci) * 256 + g * 64 + ct * 32 + c31], ap;
    if (dir) lru_scan<1>(av, uv, hc, ap); else lru_scan<0>(av, uv, hc, ap);
    if (dir == 1) {
#pragma unroll
      for (int tt = 0; tt < 2; ++tt)
#pragma unroll
        for (int r = 0; r < 16; ++r) xb[(tt * 32 + crow(r, hh)) * 257 + g * 64 + ct * 32 + c31] = uv[tt][r];
    }
    hres[ct][0] = uv[0]; hres[ct][1] = uv[1];
  }
  __syncthreads();
  if (dir == 0) {
#pragma unroll
    for (int ct = 0; ct < 2; ++ct)
#pragma unroll
      for (int tt = 0; tt < 2; ++tt)
#pragma unroll
        for (int r = 0; r < 16; ++r) xb[(tt * 32 + crow(r, hh)) * 257 + g * 64 + ct * 32 + c31] += hres[ct][tt][r];
  }
  __syncthreads();
  {
    const u16* U = (const u16*)(P.ws + WS_U); u16* Y = (u16*)(P.ws + WS_XN);
#pragma unroll
    for (int q = 0; q < 4; ++q) {
      const int idx = tid + q * NTHREADS, row = idx >> 5, ch0 = (idx & 31) * 8; const size_t m = (size_t)(m0 + row);
      const uint4 gv = ld_nt((const uint4*)(U + m * UP + UB_G + ch0));
      const float* xr = xb + row * 257 + ch0;
      uint4 ov;
      ov.x = pk2(xr[0] * siluf(bflo(gv.x)), xr[1] * siluf(bfhi(gv.x))); ov.y = pk2(xr[2] * siluf(bflo(gv.y)), xr[3] * siluf(bfhi(gv.y)));
      ov.z = pk2(xr[4] * siluf(bflo(gv.z)), xr[5] * siluf(bfhi(gv.z))); ov.w = pk2(xr[6] * siluf(bflo(gv.w)), xr[7] * siluf(bfhi(gv.w)));
      *(uint4*)(Y + m * 1024 + 256 + ch0) = ov;
    }
  }
  __syncthreads();
}

template <int PS, int DS>
DI void scan_bf16(u16* p, const float* d) {
  float s = 0.f;
  u16 ua[12], ub[12]; float da[12], db[12];
#pragma unroll
  for (int j = 0; j < 12; ++j) { ua[j] = p[(size_t)j * PS]; da[j] = d[j * DS]; }
#pragma unroll 1
  for (int g = 0; g < 11; g += 2) {
    if (g + 1 < 11) {
#pragma unroll
      for (int j = 0; j < 12; ++j) { ub[j] = p[(size_t)((g + 1) * 12 + j) * PS]; db[j] = d[((g + 1) * 12 + j) * DS]; }
    }
#pragma unroll
    for (int j = 0; j < 12; ++j) { p[(size_t)(g * 12 + j) * PS] = f2bf(s); s = da[j] * s + bf2f(ua[j]); }
    if (g + 2 < 11) {
#pragma unroll
      for (int j = 0; j < 12; ++j) { ua[j] = p[(size_t)((g + 2) * 12 + j) * PS]; da[j] = d[((g + 2) * 12 + j) * DS]; }
    }
    if (g + 1 < 11) {
#pragma unroll
      for (int j = 0; j < 12; ++j) { p[(size_t)((g + 1) * 12 + j) * PS] = f2bf(s); s = db[j] * s + bf2f(ub[j]); }
    }
  }
}

DI void phase_scans(const Params& P) {
  const int tid_ = tidx(); const int w = tid_ >> 6, lane = tid_ & 63;
  for (int unit = blockIdx.x + gridDim.x * w; unit < 1552; unit += gridDim.x * 8) {
    if (unit < 512) {
      const int item = unit * 64 + lane, seq = item >> 11, kv = item & 2047;
      scan_bf16<2048, 32>((u16*)(P.ws + WS_GLA) + (size_t)seq * NCH * 2048 + kv, (const float*)(P.ws + WS_GLAD) + seq * NCH * 32 + (kv >> 6));
    } else if (unit < 1536) {
      const int item = (unit - 512) * 64 + lane, seq = item >> 12, pn = item & 4095;
      scan_bf16<4096, 1>((u16*)(P.ws + WS_SSD) + (size_t)seq * NCH * 4096 + pn, (const float*)(P.ws + WS_SSDD) + seq * NCH);
    } else {
      const int item = (unit - 1536) * 64 + lane, bd = item >> 8, ch = item & 255;
      float* pu = (float*)(P.ws + WS_LRUU) + (size_t)bd * NCH * 256 + ch; const float* pa = (const float*)(P.ws + WS_LRUA) + (size_t)bd * NCH * 256 + ch;
      float s = 0.f;
      for (int c0 = 0; c0 < NCH; c0 += 12) {
        float uu[12], dd[12];
#pragma unroll
        for (int j = 0; j < 12; ++j) { uu[j] = pu[(c0 + j) * 256]; dd[j] = pa[(c0 + j) * 256]; }
#pragma unroll
        for (int j = 0; j < 12; ++j) { pu[(c0 + j) * 256] = s; s = dd[j] * s + uu[j]; }
      }
    }
  }
}

DI void attn_tile(const Params& P, int l, int b, int h, int qpos0, int key0, int ntile, float lam, float lam_init, char* lds) {
  const int tid = tidx(), w = tid >> 6, lane = tid & 63, c31 = lane & 31, hh = lane >> 5;
  const u16* Qg = (const u16*)(P.ws + WS_Q) + (size_t)((b * 4 + h) * 2) * NKEY * 32;
  const u16* Kg = (const u16*)(P.ws + WS_K) + (size_t)((b * 4 + h) * 2) * NKEY * 32;
  const u16* Vg = (const u16*)(P.ws + WS_VT) + (size_t)((b * 4 + h) * 64) * NKEY;
  const int qp = qpos0 + w * 32 + c31;
  bf16x8 qf[2][2]; float bq[2];
#pragma unroll
  for (int c = 0; c < 2; ++c)
#pragma unroll
    for (int ks = 0; ks < 2; ++ks) qf[c][ks] = *(const bf16x8*)(Qg + ((size_t)c * NKEY + qp) * 32 + ks * 16 + hh * 8);
#pragma unroll
  for (int c = 0; c < 2; ++c) {
    float s = 0.f;
#pragma unroll
    for (int ks = 0; ks < 2; ++ks)
#pragma unroll
      for (int e = 0; e < 8; ++e) { const float v = bf2f((u16)qf[c][ks][e]); s += v * v; }
    s += shx(s, 32);
    const float km = ((const float*)(P.ws + WS_MISC))[((l * 2 + b) * 4 + h) * 2 + c];
    bq[c] = sqrtf(s * km) * 1.002f + 1e-3f;
  }
  u16* sK = (u16*)lds; u16* sV = (u16*)(lds + 20480);
  const int kc = tid >> 8, kr = (tid >> 2) & 63, kpart = tid & 3, vdv = tid >> 3, vpart = tid & 7;
  const u16* kp = Kg + ((size_t)kc * NKEY + key0 + kr) * 32 + kpart * 8;
  const u16* vp = Vg + (size_t)vdv * NKEY + key0 + vpart * 8;
  uint4 rk = *(const uint4*)kp, rv = *(const uint4*)vp;
  *(uint4*)(sK + (kc * 64 + kr) * 40 + kpart * 8) = rk; *(uint4*)(sV + vdv * 72 + vpart * 8) = rv;
  __syncthreads();
  f32x16 O[2][2]; float ls[2] = {0.f, 0.f};
#pragma unroll
  for (int a = 0; a < 2; ++a)
#pragma unroll
    for (int bb = 0; bb < 2; ++bb)
#pragma unroll
      for (int r = 0; r < 16; ++r) O[a][bb][r] = 0.f;
  if (__builtin_amdgcn_readfirstlane(tid) >= 256) __builtin_amdgcn_s_setprio(1);
#pragma unroll 1
  for (int kt = 0; kt < ntile; ++kt) {
    const int cur = kt & 1;
    if (kt + 1 < ntile) { rk = *(const uint4*)(kp + (size_t)(kt + 1) * 2048); rv = *(const uint4*)(vp + (kt + 1) * 64); }
    const u16* cK = sK + cur * 5120; const u16* cV = sV + cur * 4608;
#pragma unroll
    for (int kt2 = 0; kt2 < 2; ++kt2) {
      const bf16x8 ka0 = *(const bf16x8*)(cK + (kt2 * 32 + c31) * 40 + hh * 8), ka1 = *(const bf16x8*)(cK + (kt2 * 32 + c31) * 40 + 16 + hh * 8);
      const bf16x8 kb0 = *(const bf16x8*)(cK + (64 + kt2 * 32 + c31) * 40 + hh * 8), kb1 = *(const bf16x8*)(cK + (64 + kt2 * 32 + c31) * 40 + 16 + hh * 8);
      f32x16 Sa, Sb;
#pragma unroll
      for (int r = 0; r < 16; ++r) { Sa[r] = -bq[0]; Sb[r] = -bq[1]; }
      Sa = MFMA32(ka0, qf[0][0], Sa); Sb = MFMA32(kb0, qf[1][0], Sb);
      Sa = MFMA32(ka1, qf[0][1], Sa); Sb = MFMA32(kb1, qf[1][1], Sb);
      const bf16x8 v00 = *(const bf16x8*)(cV + (c31) * 72 + (kt2 * 2) * 16 + hh * 8), v01 = *(const bf16x8*)(cV + (c31) * 72 + (kt2 * 2 + 1) * 16 + hh * 8);
      const bf16x8 v10 = *(const bf16x8*)(cV + (32 + c31) * 72 + (kt2 * 2) * 16 + hh * 8), v11 = *(const bf16x8*)(cV + (32 + c31) * 72 + (kt2 * 2 + 1) * 16 + hh * 8);
      {
        float p[16];
#pragma unroll
        for (int r = 0; r < 16; ++r) { p[r] = __builtin_amdgcn_exp2f(Sa[r]); ls[0] += p[r]; }
        const bf16x8 p0 = pack8(p[0], p[1], p[2], p[3], p[4], p[5], p[6], p[7]), p1 = pack8(p[8], p[9], p[10], p[11], p[12], p[13], p[14], p[15]);
        O[0][0] = MFMA32(v00, p0, O[0][0]); O[0][1] = MFMA32(v10, p0, O[0][1]);
        O[0][0] = MFMA32(v01, p1, O[0][0]); O[0][1] = MFMA32(v11, p1, O[0][1]);
      }
      {
        float p[16];
#pragma unroll
        for (int r = 0; r < 16; ++r) { p[r] = __builtin_amdgcn_exp2f(Sb[r]); ls[1] += p[r]; }
        const bf16x8 p0 = pack8(p[0], p[1], p[2], p[3], p[4], p[5], p[6], p[7]), p1 = pack8(p[8], p[9], p[10], p[11], p[12], p[13], p[14], p[15]);
        O[1][0] = MFMA32(v00, p0, O[1][0]); O[1][1] = MFMA32(v10, p0, O[1][1]);
        O[1][0] = MFMA32(v01, p1, O[1][0]); O[1][1] = MFMA32(v11, p1, O[1][1]);
      }
    }
    if (kt + 1 < ntile) { *(uint4*)(sK + (cur ^ 1) * 5120 + (kc * 64 + kr) * 40 + kpart * 8) = rk; *(uint4*)(sV + (cur ^ 1) * 4608 + vdv * 72 + vpart * 8) = rv; }
    __syncthreads();
  }
  __builtin_amdgcn_s_setprio(0);
  ls[0] += shx(ls[0], 32); ls[1] += shx(ls[1], 32);
  const float i0 = 1.f / ls[0], i1 = lam / ls[1];
  float ss = 0.f;
#pragma unroll
  for (int dt = 0; dt < 2; ++dt)
#pragma unroll
    for (int r = 0; r < 16; ++r) { const float o = O[0][dt][r] * i0 - O[1][dt][r] * i1; O[0][dt][r] = o; ss += o * o; }
  ss += shx(ss, 32);
  const float rstd = rsqrtf(ss * (1.f / 64.f) + 1e-6f) * (1.f - lam_init);
  const size_t m = (qpos0 < 8192) ? (size_t)(b * T + qp) : (size_t)(MLAT + b * 256 + (qp - 8192));
  const u16* U = (const u16*)(P.ws + WS_U); u16* Y = (u16*)(P.ws + WS_XN);
#pragma unroll
  for (int dt = 0; dt < 2; ++dt)
#pragma unroll
    for (int q4 = 0; q4 < 4; ++q4) {
      const int d0 = dt * 32 + 8 * q4 + 4 * hh;
      const uint2 gv = *(const uint2*)(U + m * UP + UC_G + h * 64 + d0);
      const float4 nw = *(const float4*)(P.diff_subln_w + l * 64 + d0);
      const float y0 = O[0][dt][4 * q4 + 0] * rstd * nw.x * siluf(bflo(gv.x)), y1 = O[0][dt][4 * q4 + 1] * rstd * nw.y * siluf(bfhi(gv.x));
      const float y2 = O[0][dt][4 * q4 + 2] * rstd * nw.z * siluf(bflo(gv.y)), y3 = O[0][dt][4 * q4 + 3] * rstd * nw.w * siluf(bfhi(gv.y));
      uint2 ov; ov.x = pk2(y0, y1); ov.y = pk2(y2, y3);
      *(uint2*)(Y + m * 1024 + 512 + h * 64 + d0) = ov;
    }
  __syncthreads();
}

DI void phase_attn(const Params& P, int l, char* lds) {
  const int lane = tidx() & 63;
  const float lam_init = 0.8f - 0.6f * __expf(-0.3f * (float)l);
  float a = 0.f, bsum = 0.f;
  if (lane < 32) { const float* lv = gp(P.diff_lam + l * 128); a = lv[lane] * lv[32 + lane]; bsum = lv[64 + lane] * lv[96 + lane]; }
#pragma unroll
  for (int s = 32; s >= 1; s >>= 1) { a += shx(a, s); bsum += shx(bsum, s); }
  const float lam = __expf(a) - __expf(bsum) + lam_init;
  const int ntask = (l == 0) ? 264 : 256;
  for (int id0 = blockIdx.x; id0 < ntask; id0 += gridDim.x) {
    int tb, th, tq0, tk0, tn;
    if (id0 < 256) {
      const int id = (gridDim.x == 256) ? ((id0 & 7) * 32 + (id0 >> 3)) : id0;
      tb = id >> 7; th = (id >> 5) & 3; tq0 = (id & 31) * 256; tk0 = 0; tn = 132;
    } else {
      const int id = id0 - 256;
      tb = id >> 2; th = id & 3; tq0 = 8192; tk0 = 8192; tn = 4;
    }
    attn_tile(P, l, tb, th, tq0, tk0, tn, lam, lam_init, lds);
  }
}

#define XB_TMO      128
#define XB_XCNT(j)  (256  + 64 * (j))
#define XB_XSUB(j)  (1280 + 64 * (j))
#define XB_XGEN(j)  (2304 + 64 * (j))
#define XB_TOP      3328
#define XB_TOPGEN   3392
#define XCD_BAR_WORDS 3456
#define XB_SPIN_CAP (1u << 18)
#define LAS __attribute__((address_space(3)))
DI unsigned xb_ld(unsigned* p) { return __hip_atomic_load(p, __ATOMIC_RELAXED, __HIP_MEMORY_SCOPE_AGENT); }
DI unsigned xb_add(unsigned* p, unsigned v) { return __hip_atomic_fetch_add(p, v, __ATOMIC_RELAXED, __HIP_MEMORY_SCOPE_AGENT); }
DI unsigned xb_xcc_id() { return (unsigned)__builtin_amdgcn_s_getreg((3 << 11) | 20) & 0xFu; }
#define XB_SPIN(cond, bar) do { unsigned _sp = 0; while (cond) { __builtin_amdgcn_s_sleep(1); \
    if ((++_sp & 255u) == 0u) { if (xb_ld(&(bar)[XB_TMO])) break; if (_sp > XB_SPIN_CAP) { atomicAdd(&(bar)[XB_TMO], 1u); break; } } } } while (0)
struct XcdBarrier { unsigned* bar; unsigned x; volatile LAS unsigned* st; };
DI XcdBarrier xcd_barrier_post(unsigned* bar, volatile LAS unsigned* st) {
  XcdBarrier b; b.bar = bar; b.x = xb_xcc_id(); b.st = st;
  if (threadIdx.x == 0) (void)xb_add(&bar[XB_XCNT(b.x)], 1u);
  return b;
}
DI void xcd_barrier_complete(unsigned* bar, unsigned x, unsigned& nloc, unsigned& nx) {
  const unsigned G = gridDim.x * gridDim.y * gridDim.z;
  unsigned sum, cnt, mine, sp = 0u;
  for (;;) {
    sum = 0u; cnt = 0u; mine = 0u;
#pragma unroll
    for (unsigned j = 0; j < 16; ++j) { const unsigned c = xb_ld(&bar[XB_XCNT(j)]); sum += c; cnt += (c > 0u) ? 1u : 0u; mine = (j == x) ? c : mine; }
    if (sum == G) break;
    __builtin_amdgcn_s_sleep(1);
    if ((++sp & 255u) == 0u) { if (xb_ld(&bar[XB_TMO])) break; if (sp > XB_SPIN_CAP) { atomicAdd(&bar[XB_TMO], 1u); break; } }
  }
  nloc = mine > 0u ? mine : 1u; nx = cnt > 0u ? cnt : 1u;
}
DI void xcd_barrier(const XcdBarrier& b) {
  asm volatile("s_waitcnt vmcnt(0)" ::: "memory");
  __syncthreads();
  if (threadIdx.x == 0) {
    unsigned* bar = b.bar;
    __builtin_amdgcn_s_waitcnt(0);
    unsigned nloc = b.st[0], nx = b.st[1];
    if (nloc == 0u) { xcd_barrier_complete(bar, b.x, nloc, nx); b.st[0] = nloc; b.st[1] = nx; }
    const unsigned old = xb_add(&bar[XB_XSUB(b.x)], 1u);
    const unsigned gen = old / nloc;
    if (old + 1u == (gen + 1u) * nloc) {
      __builtin_amdgcn_fence(__ATOMIC_RELEASE, "agent");
      asm volatile("s_waitcnt vmcnt(0)" ::: "memory");
      const unsigned og = xb_add(&bar[XB_TOP], 1u);
      const unsigned tg = og / nx;
      if (og + 1u == (tg + 1u) * nx) xb_add(&bar[XB_TOPGEN], 1u);
      else XB_SPIN(xb_ld(&bar[XB_TOPGEN]) == tg, bar);
      __builtin_amdgcn_fence(__ATOMIC_ACQUIRE, "agent");
      xb_add(&bar[XB_XGEN(b.x)], 1u);
      asm volatile("s_waitcnt vmcnt(0)" ::: "memory");
    } else {
      XB_SPIN(xb_ld(&bar[XB_XGEN(b.x)]) == gen, bar);
      __builtin_amdgcn_fence(__ATOMIC_ACQUIRE, "agent");
      asm volatile("s_waitcnt vmcnt(0)" ::: "memory");
    }
  }
  __syncthreads();
}

__global__ void __launch_bounds__(NTHREADS) fwd_megakernel(Params Parg) {
  extern __shared__ __attribute__((aligned(16))) char lds[];
  __shared__ Params sP;
  __shared__ uint4 xb_words;
  if (threadIdx.x == 0) { sP = Parg; xb_words = make_uint4(0u, 0u, 0u, 0u); }
  __syncthreads();
  const Params& P = sP;
  cg::grid_group grid = cg::this_grid();
  if (blockDim.x == 12345u) grid.sync();
  (void)xcd_barrier_post((unsigned*)(Parg.ws + WS_BAR), (volatile LAS unsigned*)&xb_words);
#define GRID_BAR() do { XcdBarrier xb_; xb_.bar = (unsigned*)(P.ws + WS_BAR); xb_.x = xb_xcc_id(); xb_.st = (volatile LAS unsigned*)&xb_words; xcd_barrier(xb_); } while (0)
  MARK(0); phase_p0(P, lds);
  GRID_BAR();
#pragma unroll 1
  for (int l = 0; l < 2; ++l) {
    MARK(1); phase_norm(P, l);
    GRID_BAR(); MARK(2);
    gemm_phase<0>(P, l, (const u16*)(P.ws + WS_XN), (const u16*)(P.ws + WS_WINT) + (size_t)l * UP * 1024, 66, 25, lds);
    GRID_BAR();
    MARK(3);
    for (int t = blockIdx.x; t < 1056; t += gridDim.x) {
      const int ty = t / 264, idx = t % 264, b = idx / 132, cb = idx % 132;
      if (ty == 0) ssd_local(P, l, b, cb, lds);
      else if (ty == 1) lru_local(P, l, b, cb, lds);
      else if (ty == 2) gla_local(P, l, b, cb, lds);
      else attn_prep(P, l, idx, lds);
    }
    GRID_BAR();
    MARK(4); phase_scans(P);
    MARK(5); phase_attn(P, l, lds); MARK(6);
    GRID_BAR();
    {
      const int per = (l == 0) ? 264 : 256;
      for (int t = blockIdx.x; t < 3 * per; t += gridDim.x) {
        const int ty = t / per, idx = t % per;
        const int b = (l == 0) ? idx / 132 : (idx >> 7), cb = (l == 0) ? idx % 132 : 4 + (idx & 127);
        if (ty == 0) ssd_out(P, l, b, cb, lds);
        else if (ty == 1) lru_out(P, l, b, cb, lds);
        else gla_out(P, l, b, cb, lds);
      }
    }
    GRID_BAR();
    MARK(7); gemm_phase<1>(P, l, (const u16*)(P.ws + WS_XN), (const u16*)(P.ws + WS_WOUT) + (size_t)l * 1024 * 1024, l == 0 ? 66 : 64, 8, lds);
    GRID_BAR();
  }
  MARK(8); phase_final_norm(P);
}

extern "C" void kernel_launch(void* const* d_in, const int* in_sizes, int n_in, void* d_out, int out_size, void* d_ws, size_t ws_size, hipStream_t stream) {
  static int grid_blocks = 0;
  if (!grid_blocks) {
    int dev = 0, cus = 0, per_cu = 0;
    hipGetDevice(&dev);
    hipDeviceGetAttribute(&cus, hipDeviceAttributeMultiprocessorCount, dev);
    hipFuncSetAttribute((const void*)fwd_megakernel, hipFuncAttributeMaxDynamicSharedMemorySize, LDS_BYTES);
    hipOccupancyMaxActiveBlocksPerMultiprocessor(&per_cu, (const void*)fwd_megakernel, NTHREADS, LDS_BYTES);
    if (per_cu < 1) { fprintf(stderr, "occupancy query returned %d\n", per_cu); per_cu = 1; }
    if (per_cu > 1) per_cu = 1;
    grid_blocks = cus * per_cu;
  }
  Params p{};
  const float** pf = (const float**)&p;
  for (int i = 0; i < 28; ++i) pf[i] = (const float*)d_in[i];
  pf[28] = (const float*)d_out; pf[29] = (const float*)d_ws;
  hipMemsetAsync((char*)d_ws + WS_BAR, 0, XCD_BAR_WORDS * 4, stream);
  void* args[] = {&p};
  hipError_t e = hipLaunchCooperativeKernel((const void*)fwd_megakernel, dim3(grid_blocks), dim3(NTHREADS), args, LDS_BYTES, stream);
  if (e != hipSuccess) fprintf(stderr, "cooperative launch failed: %s (grid %d)\n", hipGetErrorString(e), grid_blocks);
}
```

```cpp
#include <hip/hip_runtime.h>
#include <hip/hip_cooperative_groups.h>
#include <cstdio>
namespace cg = cooperative_groups;

#define DI __device__ __forceinline__
typedef unsigned short u16;
typedef __attribute__((ext_vector_type(8))) short bf16x8;
typedef __attribute__((ext_vector_type(16))) float f32x16;
typedef __attribute__((ext_vector_type(4))) unsigned u32x4;
typedef __bf16 bf2_t __attribute__((ext_vector_type(2)));
typedef float fl2_t __attribute__((ext_vector_type(2)));

#define MARK(n) asm volatile("; MARK " #n)
#define MFMA32(a, b, c) __builtin_amdgcn_mfma_f32_32x32x16_bf16((a), (b), (c), 0, 0, 0)

constexpr int T = 8192, D = 1024, UP = 3200, MLAT = 16384, MTOT = 16896, NKEY = 8448, NCH = 132;
constexpr int UA_Q = 0, UA_K = 128, UA_V = 256, UA_LRF = 512, UA_G = 544;
constexpr int UB_X = 800, UB_G = 1056;
constexpr int UC_Q = 1312, UC_K = 1568, UC_V = 1824, UC_G = 2080;
constexpr int UD_XBC = 2336, UD_DTF = 2848, UD_Z = 2856;
constexpr int NTHREADS = 512;
constexpr int LDS_BYTES = 147456;

constexpr size_t WS_WINT = 0;
constexpr size_t WS_WOUT = WS_WINT + (size_t)2 * UP * 1024 * 2;
constexpr size_t WS_MOD = WS_WOUT + (size_t)2 * 1024 * 1024 * 2;
constexpr size_t WS_ROPE = WS_MOD + (size_t)2 * 3 * 3072 * 4;
constexpr size_t WS_MISC = WS_ROPE + 8192;
constexpr size_t WS_XN = WS_MISC + 4096;
constexpr size_t WS_U = WS_XN + (size_t)MTOT * 1024 * 2;
constexpr size_t WS_HCTX = WS_U + (size_t)MTOT * UP * 2;
constexpr size_t WS_Q = WS_HCTX + (size_t)512 * 1024 * 4;
constexpr size_t WS_K = WS_Q + (size_t)16 * NKEY * 32 * 2;
constexpr size_t WS_VT = WS_K + (size_t)16 * NKEY * 32 * 2;
constexpr size_t WS_GLA = WS_VT + (size_t)8 * 64 * NKEY * 2;
constexpr size_t WS_GLAD = WS_GLA + (size_t)16 * NCH * 2048 * 4;
constexpr size_t WS_SSD = WS_GLAD + (size_t)16 * NCH * 32 * 4;
constexpr size_t WS_SSDD = WS_SSD + (size_t)16 * NCH * 4096 * 4;
constexpr size_t WS_LRUA = WS_SSDD + 16384;
constexpr size_t WS_LRUU = WS_LRUA + (size_t)4 * NCH * 256 * 4;
constexpr size_t WS_BAR = WS_LRUU + (size_t)4 * NCH * 256 * 4;
constexpr size_t WS_LRUW = WS_BAR + 16384;
constexpr size_t WS_END = WS_LRUW + (size_t)64 * 4096 * 2;
static_assert(WS_END <= (size_t)256 * 1024 * 1024, "workspace");

#define GAS __attribute__((address_space(1)))
struct Params {
  const GAS float *x, *c, *ctx, *c_ctx, *w_mod, *b_mod, *norm_w, *w_in, *w_out, *gla_w2, *gla_b2, *gla_norm_w, *lru_conv_w, *lru_conv_b,
      *lru_wa, *lru_ba, *lru_wx, *lru_bx, *lru_lam, *diff_lam, *diff_subln_w, *ssd_conv_w, *ssd_conv_b, *ssd_dt_bias, *ssd_a_log, *ssd_d,
      *ssd_norm_w, *final_norm_w;
  GAS float* out;
  GAS unsigned char* ws;
};

DI unsigned pk2(float a, float b) { fl2_t v = {a, b}; return __builtin_bit_cast(unsigned, __builtin_convertvector(v, bf2_t)); }
DI u16 f2bf(float a) { return (u16)(pk2(a, 0.f) & 0xffffu); }
DI float bf2f(u16 x) { return __uint_as_float(((unsigned)x) << 16); }
DI float bflo(unsigned x) { return __uint_as_float(x << 16); }
DI float bfhi(unsigned x) { return __uint_as_float(x & 0xffff0000u); }
DI bf16x8 mk8(unsigned a, unsigned b, unsigned c, unsigned d) { u32x4 v = {a, b, c, d}; return __builtin_bit_cast(bf16x8, v); }
DI bf16x8 pack8(float a0, float a1, float a2, float a3, float a4, float a5, float a6, float a7) { return mk8(pk2(a0, a1), pk2(a2, a3), pk2(a4, a5), pk2(a6, a7)); }
template <class T> DI T* gp(GAS T* p) { return (T*)p; }
typedef __attribute__((ext_vector_type(4))) float f32x4_t;
DI float4 ld_nt(const float4* p) { const f32x4_t v = __builtin_nontemporal_load((const f32x4_t*)p); return make_float4(v.x, v.y, v.z, v.w); }
typedef __attribute__((ext_vector_type(4))) unsigned u32x4_nt;
DI uint4 ld_nt(const uint4* p) { const u32x4_nt v = __builtin_nontemporal_load((const u32x4_nt*)p); return make_uint4(v.x, v.y, v.z, v.w); }
DI float ld_nt(const float* p) { return __builtin_nontemporal_load(p); }
DI int tidx() { int t = threadIdx.x; asm volatile("" : "+v"(t)); return t; }
DI int crow(int r, int hh) { return (r & 3) + 8 * (r >> 2) + 4 * hh; }
DI float siluf(float x) { return x * __builtin_amdgcn_rcpf(1.f + __expf(-x)); }
DI float sigmf(float x) { return __builtin_amdgcn_rcpf(1.f + __expf(-x)); }
DI float softplusf(float x) { return fmaxf(x, 0.f) + __logf(1.f + __expf(-fabsf(x))); }
DI float shx(float v, int m) { return __shfl_xor(v, m, 64); }
DI int blk_m0(int b, int cb) { return cb < 4 ? MLAT + b * 256 + cb * 64 : b * T + (cb - 4) * 64; }
DI int blk_ci(int cb, int dir) { return dir == 0 ? cb : (cb < 4 ? 3 - cb : 135 - cb); }

DI void p0_transpose(const float* src, int N, u16* dst, int k0, int n0, float* lds) {
  const int tid = tidx();
  float v[8];
#pragma unroll
  for (int i = 0; i < 8; ++i) { const int e = tid + i * NTHREADS, kk = e >> 6, n = n0 + (e & 63); v[i] = (n < N) ? ld_nt(src + (size_t)(k0 + kk) * N + n) : 0.f; }
#pragma unroll
  for (int i = 0; i < 8; ++i) { const int e = tid + i * NTHREADS; lds[(e >> 6) * 65 + (e & 63)] = v[i]; }
  __syncthreads();
#pragma unroll
  for (int e = tid; e < 2048; e += NTHREADS) { int nn = e >> 5, kp = (e & 31) * 2; *(unsigned*)(dst + (size_t)(n0 + nn) * 1024 + k0 + kp) = pk2(lds[kp * 65 + nn], lds[(kp + 1) * 65 + nn]); }
  __syncthreads();
}

DI void p0_mod(const Params& P, int l, int n0, float* lds) {
  const int tid = tidx(), col = tid & 63, kg = tid >> 6;
  for (int e = tid; e < 1024; e += NTHREADS) { lds[e] = siluf(P.c[e]); lds[1024 + e] = siluf(P.c[1024 + e]); lds[2048 + e] = siluf(P.c_ctx[e]); }
  __syncthreads();
  float a0 = 0.f, a1 = 0.f, a2 = 0.f;
  const float* wm = gp(P.w_mod + (size_t)l * 1024 * 3072 + n0 + col);
  for (int k0 = kg * 128; k0 < kg * 128 + 128; k0 += 16) {
    float w[16];
#pragma unroll
    for (int j = 0; j < 16; ++j) w[j] = wm[(size_t)(k0 + j) * 3072];
#pragma unroll
    for (int j = 0; j < 16; ++j) { a0 += lds[k0 + j] * w[j]; a1 += lds[1024 + k0 + j] * w[j]; a2 += lds[2048 + k0 + j] * w[j]; }
  }
  float* red = lds + 3072;
  red[(kg * 3 + 0) * 64 + col] = a0; red[(kg * 3 + 1) * 64 + col] = a1; red[(kg * 3 + 2) * 64 + col] = a2;
  __syncthreads();
  if (tid < 192) {
    int j = tid >> 6; float sacc = P.b_mod[l * 3072 + n0 + col];
    for (int g = 0; g < 8; ++g) sacc += red[(g * 3 + j) * 64 + col];
    ((float*)(P.ws + WS_MOD))[(l * 3 + j) * 3072 + n0 + col] = sacc;
  }
  __syncthreads();
}

DI void phase_p0(const Params& P, char* lds) {
  float* fl = (float*)lds;
  for (int t0 = blockIdx.x; t0 < 2273; t0 += gridDim.x) {
    if (t0 >= 2209) {
      const int mid = t0 - 2209, gate = mid & 1, ldg = mid >> 1, tid = tidx();
      const float* wsrc = gp((gate ? P.lru_wx : P.lru_wa) + (size_t)ldg * 4096);
      const int lane = tid & 63, ct = (tid >> 6) & 1, ks = tid >> 7, c31 = lane & 31, hh = lane >> 5;
      float v[8];
#pragma unroll
      for (int e = 0; e < 8; ++e) v[e] = wsrc[(ks * 16 + hh * 8 + e) * 64 + ct * 32 + c31];
      uint4 o; o.x = pk2(v[0], v[1]); o.y = pk2(v[2], v[3]); o.z = pk2(v[4], v[5]); o.w = pk2(v[6], v[7]);
      *(uint4*)((u16*)(P.ws + WS_LRUW) + (size_t)mid * 4096 + tid * 8) = o;
      continue;
    }
    const int t = t0 < 96 ? 2112 + t0 : (t0 < 2208 ? t0 - 96 : t0);
    if (t < 1600) { int l = t / 800, rem = t % 800; p0_transpose(gp(P.w_in + (size_t)l * 1024 * 3112), 3112, (u16*)(P.ws + WS_WINT) + (size_t)l * UP * 1024, (rem & 15) * 64, (rem >> 4) * 64, fl); }
    else if (t < 2112) { int t2 = t - 1600; int l = t2 >> 8, rem = t2 & 255; p0_transpose(gp(P.w_out + (size_t)l * 1024 * 1024), 1024, (u16*)(P.ws + WS_WOUT) + (size_t)l * 1024 * 1024, (rem & 15) * 64, (rem >> 4) * 64, fl); }
    else if (t < 2208) { int t2 = t - 2112; p0_mod(P, t2 / 48, (t2 % 48) * 64, fl); }
    else {
      float* rope = (float*)(P.ws + WS_ROPE);
      const int tid = tidx();
      for (int e = tid; e < 1024; e += NTHREADS) { int pos = e >> 3, f = e & 7; float inv = exp2f(-(float)f * (13.287712379549449f / 8.f)); float ang = (float)pos * inv; rope[e] = __cosf(ang); rope[1024 + e] = __sinf(ang); }
      if (tid < 64) ((unsigned*)(P.ws + WS_MISC))[tid] = 0u;
    }
  }
}

DI const float* h_row(const Params& P, int l, int m) {
  if (l == 0) return gp(m < MLAT ? P.x + (size_t)m * 1024 : P.ctx + (size_t)(m - MLAT) * 1024);
  return m < MLAT ? (const float*)(P.out + (size_t)m * 1024) : (const float*)(P.ws + WS_HCTX) + (size_t)(m - MLAT) * 1024;
}

DI void phase_norm(const Params& P, int l) {
  const int tid_ = tidx(); const int w = tid_ >> 6, lane = tid_ & 63;
  u16* xn = (u16*)(P.ws + WS_XN);
  for (int row = blockIdx.x * 8 + w; row < MTOT; row += gridDim.x * 8) {
    const float4* src = (const float4*)h_row(P, l, row);
    const int j = row < MLAT ? (row >> 13) : 2;
    const float* mod = (const float*)(P.ws + WS_MOD) + (l * 3 + j) * 3072;
    float4 v[4]; float ss = 0.f;
#pragma unroll
    for (int i = 0; i < 4; ++i) { v[i] = ld_nt(src + i * 64 + lane); ss += v[i].x * v[i].x + v[i].y * v[i].y + v[i].z * v[i].z + v[i].w * v[i].w; }
#pragma unroll
    for (int s = 32; s >= 1; s >>= 1) ss += shx(ss, s);
    const float rstd = rsqrtf(ss * (1.f / 1024.f) + 1e-6f);
#pragma unroll
    for (int i = 0; i < 4; ++i) {
      const int k = (i * 64 + lane) * 4;
      float4 nw = *(const float4*)(P.norm_w + l * 1024 + k), sc = *(const float4*)(mod + 1024 + k), sh = *(const float4*)(mod + k);
      float y0 = v[i].x * rstd * nw.x * (1.f + sc.x) + sh.x, y1 = v[i].y * rstd * nw.y * (1.f + sc.y) + sh.y;
      float y2 = v[i].z * rstd * nw.z * (1.f + sc.z) + sh.z, y3 = v[i].w * rstd * nw.w * (1.f + sc.w) + sh.w;
      uint2 o; o.x = pk2(y0, y1); o.y = pk2(y2, y3);
      *(uint2*)(xn + (size_t)row * 1024 + k) = o;
    }
  }
}

DI void phase_final_norm(const Params& P) {
  const int tid_ = tidx(); const int w = tid_ >> 6, lane = tid_ & 63;
  for (int row = blockIdx.x * 8 + w; row < MLAT; row += gridDim.x * 8) {
    float4* src = (float4*)(P.out + (size_t)row * 1024);
    float4 v[4]; float ss = 0.f;
#pragma unroll
    for (int i = 0; i < 4; ++i) { v[i] = ld_nt(src + i * 64 + lane); ss += v[i].x * v[i].x + v[i].y * v[i].y + v[i].z * v[i].z + v[i].w * v[i].w; }
#pragma unroll
    for (int s = 32; s >= 1; s >>= 1) ss += shx(ss, s);
    const float rstd = rsqrtf(ss * (1.f / 1024.f) + 1e-6f);
#pragma unroll
    for (int i = 0; i < 4; ++i) {
      float4 nw = *(const float4*)(P.final_norm_w + (i * 64 + lane) * 4);
      float4 o; o.x = v[i].x * rstd * nw.x; o.y = v[i].y * rstd * nw.y; o.z = v[i].z * rstd * nw.z; o.w = v[i].w * rstd * nw.w;
      { const f32x4_t ov = {o.x, o.y, o.z, o.w}; __builtin_nontemporal_store(ov, (f32x4_t*)(src + i * 64 + lane)); }
    }
  }
}

constexpr int GS = 72;
template <int EPI>
DI void gemm_phase(const Params& P, int l, const u16* A, const u16* Bt, int mtiles, int ntiles, char* lds) {
  const int tid = tidx(), w = tid >> 6, lane = tid & 63, c31 = lane & 31, hh = lane >> 5, wm = w >> 1, wn = w & 1;
  const int lrow = tid >> 3, lcol = (tid & 7) * 8;
  const int ntot = mtiles * ntiles;
  const bool swz = (gridDim.x == 256);
  const int xcd = blockIdx.x & 7, jloc = blockIdx.x >> 3;
  const int per = (ntot + 7) >> 3, qbeg = xcd * per, qend = min(ntot, qbeg + per);
  for (int it = 0;; ++it) {
    int tm, tn;
    if (swz) {
      const int q = qbeg + jloc + 32 * it;
      if (q >= qend) break;
      const int band = q / (4 * ntiles), within = q - band * 4 * ntiles;
      const int rows = min(4, mtiles - band * 4);
      tn = within / rows; tm = band * 4 + (within - tn * rows);
    } else {
      const int tile = blockIdx.x + it * gridDim.x;
      if (tile >= ntot) break;
      tm = tile / ntiles; tn = tile % ntiles;
    }
    const int m0 = tm * 256, n0 = tn * 128;
    f32x16 acc[2][2];
#pragma unroll
    for (int i = 0; i < 2; ++i)
#pragma unroll
      for (int j = 0; j < 2; ++j)
#pragma unroll
        for (int r = 0; r < 16; ++r) acc[i][j][r] = 0.f;
    const u16* ga = A + (size_t)(m0 + lrow) * 1024 + lcol;
    const u16* gb = Bt + (size_t)(n0 + lrow) * 1024 + lcol;
    uint4 ra0, ra1, ra2, ra3, rb0, rb1, rc0, rc1, rc2, rc3, rd0, rd1;
#define G_LOAD(A0, A1, A2, A3, B0, B1, ko) { A0 = *(const uint4*)(ga + (ko)); A1 = *(const uint4*)(ga + (size_t)64 * 1024 + (ko)); A2 = *(const uint4*)(ga + (size_t)128 * 1024 + (ko)); A3 = *(const uint4*)(ga + (size_t)192 * 1024 + (ko)); \
      B0 = *(const uint4*)(gb + (ko)); B1 = *(const uint4*)(gb + (size_t)64 * 1024 + (ko)); }
#define G_STORE(A0, A1, A2, A3, B0, B1, buf) { u16* nA = (u16*)(lds + (buf) * 55296); u16* nB = (u16*)(lds + (buf) * 55296 + 36864); \
      *(uint4*)(nA + (lrow) * GS + lcol) = A0; *(uint4*)(nA + (lrow + 64) * GS + lcol) = A1; *(uint4*)(nA + (lrow + 128) * GS + lcol) = A2; *(uint4*)(nA + (lrow + 192) * GS + lcol) = A3; \
      *(uint4*)(nB + (lrow) * GS + lcol) = B0; *(uint4*)(nB + (lrow + 64) * GS + lcol) = B1; }
#define G_READ(buf) { const u16* sA = (const u16*)(lds + (buf) * 55296); const u16* sB = (const u16*)(lds + (buf) * 55296 + 36864); \
      _Pragma("unroll") for (int ks = 0; ks < 4; ++ks) { \
        af[ks][0] = *(const bf16x8*)(sA + (wm * 64 + c31) * GS + ks * 16 + hh * 8); af[ks][1] = *(const bf16x8*)(sA + (wm * 64 + 32 + c31) * GS + ks * 16 + hh * 8); \
        bfr[ks][0] = *(const bf16x8*)(sB + (wn * 64 + c31) * GS + ks * 16 + hh * 8); bfr[ks][1] = *(const bf16x8*)(sB + (wn * 64 + 32 + c31) * GS + ks * 16 + hh * 8); } \
      __builtin_amdgcn_sched_barrier(0); }
#define G_MMA() { __builtin_amdgcn_sched_barrier(0); \
      _Pragma("unroll") for (int ks = 0; ks < 4; ++ks) { \
        acc[0][0] = MFMA32(af[ks][0], bfr[ks][0], acc[0][0]); acc[0][1] = MFMA32(af[ks][0], bfr[ks][1], acc[0][1]); \
        acc[1][0] = MFMA32(af[ks][1], bfr[ks][0], acc[1][0]); acc[1][1] = MFMA32(af[ks][1], bfr[ks][1], acc[1][1]); } \
      __builtin_amdgcn_sched_barrier(0); }
    bf16x8 af[4][2], bfr[4][2];
#define S0 ra0, ra1, ra2, ra3, rb0, rb1
#define S1 rc0, rc1, rc2, rc3, rd0, rd1
#define GX(M, ...) M(__VA_ARGS__)
#define TK(t) (min((t), 15) * 64)
    if (w < 4) {
      GX(G_LOAD, S0, 0); GX(G_LOAD, S1, 64);
      GX(G_STORE, S0, 0); GX(G_STORE, S1, 1);
      GX(G_LOAD, S0, 128); GX(G_LOAD, S1, 192);
      __syncthreads();
      G_READ(0);
#pragma unroll 1
      for (int kt = 0; kt < 16; kt += 2) {
        G_MMA();
        __syncthreads();
        G_READ(1);
        if (kt + 2 < 16) GX(G_STORE, S0, 0);
        GX(G_LOAD, S0, TK(kt + 4));
        __syncthreads();
        G_MMA();
        __syncthreads();
        if (kt + 2 < 16) { G_READ(0); }
        if (kt + 3 < 16) GX(G_STORE, S1, 1);
        GX(G_LOAD, S1, TK(kt + 5));
        __syncthreads();
      }
    } else {
      GX(G_LOAD, S0, 0);
      GX(G_STORE, S0, 0);
      GX(G_LOAD, S1, 64); GX(G_LOAD, S0, 128);
      __syncthreads();
#pragma unroll 1
      for (int kt = 0; kt < 16; kt += 2) {
        G_READ(0);
        GX(G_STORE, S1, 1);
        GX(G_LOAD, S1, TK(kt + 3));
        __syncthreads();
        G_MMA();
        __syncthreads();
        G_READ(1);
        if (kt + 2 < 16) GX(G_STORE, S0, 0);
        GX(G_LOAD, S0, TK(kt + 4));
        __syncthreads();
        G_MMA();
        __syncthreads();
      }
    }
#undef GX
#undef S0
#undef S1
#undef TK
#undef G_READ
#undef G_MMA
#undef G_LOAD
#undef G_STORE
#undef G_COMPUTE
    if (EPI == 0) {
      u16* st = (u16*)(lds + 55296 + w * 9216);
#pragma unroll
      for (int i = 0; i < 2; ++i)
#pragma unroll
        for (int j = 0; j < 2; ++j)
#pragma unroll
          for (int r = 0; r < 16; ++r) st[(i * 32 + crow(r, hh)) * 72 + j * 32 + c31] = f2bf(acc[i][j][r]);
      u16* U = (u16*)(P.ws + WS_U) + (size_t)(m0 + wm * 64) * UP + n0 + wn * 64;
#pragma unroll
      for (int q = 0; q < 8; ++q) {
        const int idx = q * 64 + lane, row = idx >> 3, part = idx & 7;
        *(uint4*)(U + (size_t)row * UP + part * 8) = *(const uint4*)(st + row * 72 + part * 8);
      }
      __syncthreads();
    } else {
      float* st = (float*)(lds + w * 17408);
#pragma unroll
      for (int i = 0; i < 2; ++i)
#pragma unroll
        for (int j = 0; j < 2; ++j)
#pragma unroll
          for (int r = 0; r < 16; ++r) st[(i * 32 + crow(r, hh)) * 68 + j * 32 + c31] = acc[i][j][r];
      const int mrow0 = m0 + wm * 64, ncol = n0 + wn * 64 + (lane & 15) * 4;
      const int jm = mrow0 < MLAT ? (mrow0 >> 13) : 2;
      const float4 gate = *(const float4*)((const float*)(P.ws + WS_MOD) + (l * 3 + jm) * 3072 + 2048 + ncol);
#pragma unroll
      for (int half = 0; half < 2; ++half) {
        float4 hv[8];
#pragma unroll
        for (int q = 0; q < 8; ++q) { const int row = (half * 8 + q) * 4 + (lane >> 4); hv[q] = ld_nt((const float4*)(h_row(P, l, mrow0 + row) + ncol)); }
#pragma unroll
        for (int q = 0; q < 8; ++q) {
          const int row = (half * 8 + q) * 4 + (lane >> 4), m = mrow0 + row;
          const float4 a = *(const float4*)(st + row * 68 + (lane & 15) * 4);
          float4 o; o.x = hv[q].x + gate.x * a.x; o.y = hv[q].y + gate.y * a.y; o.z = hv[q].z + gate.z * a.z; o.w = hv[q].w + gate.w * a.w;
          float* dst = m < MLAT ? (float*)(P.out + (size_t)m * 1024 + ncol) : (float*)(P.ws + WS_HCTX) + (size_t)(m - MLAT) * 1024 + ncol;
          *(float4*)dst = o;
        }
      }
      __syncthreads();
    }
  }
}

DI void attn_prep(const Params& P, int l, int unit, char* lds) {
  const int tid = tidx(); const int gid = unit * NTHREADS + tid;
  const int m = gid >> 3, h = (gid >> 1) & 3, c = gid & 1;
  const u16* urow = (const u16*)(P.ws + WS_U) + (size_t)m * UP;
  float q[32], k[32];
  {
    const uint4* qs = (const uint4*)(urow + UC_Q + h * 64 + c * 32); const uint4* ks = (const uint4*)(urow + UC_K + h * 64 + c * 32);
#pragma unroll
    for (int i = 0; i < 4; ++i) {
      uint4 a = qs[i], b = ks[i];
      q[i * 8 + 0] = bflo(a.x); q[i * 8 + 1] = bfhi(a.x); q[i * 8 + 2] = bflo(a.y); q[i * 8 + 3] = bfhi(a.y); q[i * 8 + 4] = bflo(a.z); q[i * 8 + 5] = bfhi(a.z); q[i * 8 + 6] = bflo(a.w); q[i * 8 + 7] = bfhi(a.w);
      k[i * 8 + 0] = bflo(b.x); k[i * 8 + 1] = bfhi(b.x); k[i * 8 + 2] = bflo(b.y); k[i * 8 + 3] = bfhi(b.y); k[i * 8 + 4] = bflo(b.z); k[i * 8 + 5] = bfhi(b.z); k[i * 8 + 6] = bflo(b.w); k[i * 8 + 7] = bfhi(b.w);
    }
  }
  const bool lat = m < MLAT;
  const int b = lat ? (m >> 13) : ((m - MLAT) >> 8), t = lat ? (m & 8191) : ((m - MLAT) & 255);
  if (lat) {
    const float* rc = (const float*)(P.ws + WS_ROPE); const float* rs = rc + 1024;
#pragma unroll
    for (int a = 0; a < 2; ++a) {
      const int pos = a ? (t & 63) : (t >> 6);
#pragma unroll
      for (int f = 0; f < 8; ++f) {
        const float cs = rc[pos * 8 + f], sn = rs[pos * 8 + f];
        float x0 = q[a * 16 + f], x1 = q[a * 16 + 8 + f]; q[a * 16 + f] = x0 * cs - x1 * sn; q[a * 16 + 8 + f] = x1 * cs + x0 * sn;
        x0 = k[a * 16 + f]; x1 = k[a * 16 + 8 + f]; k[a * 16 + f] = x0 * cs - x1 * sn; k[a * 16 + 8 + f] = x1 * cs + x0 * sn;
      }
    }
  }
  const int pos = lat ? t : 8192 + t;
  const float QS = 0.17677669529663687f * 1.4426950408889634f;
  float k2 = 0.f;
  u16* qd = (u16*)(P.ws + WS_Q) + ((size_t)((b * 4 + h) * 2 + c) * NKEY + pos) * 32;
  u16* kd = (u16*)(P.ws + WS_K) + ((size_t)((b * 4 + h) * 2 + c) * NKEY + pos) * 32;
#pragma unroll
  for (int i = 0; i < 4; ++i) {
    uint4 a, bb;
    a.x = pk2(q[i * 8 + 0] * QS, q[i * 8 + 1] * QS); a.y = pk2(q[i * 8 + 2] * QS, q[i * 8 + 3] * QS); a.z = pk2(q[i * 8 + 4] * QS, q[i * 8 + 5] * QS); a.w = pk2(q[i * 8 + 6] * QS, q[i * 8 + 7] * QS);
    bb.x = pk2(k[i * 8 + 0], k[i * 8 + 1]); bb.y = pk2(k[i * 8 + 2], k[i * 8 + 3]); bb.z = pk2(k[i * 8 + 4], k[i * 8 + 5]); bb.w = pk2(k[i * 8 + 6], k[i * 8 + 7]);
    ((uint4*)qd)[i] = a; ((uint4*)kd)[i] = bb;
  }
#pragma unroll
  for (int i = 0; i < 32; ++i) k2 += k[i] * k[i];
  k2 = fmaxf(k2, shx(k2, 8)); k2 = fmaxf(k2, shx(k2, 16)); k2 = fmaxf(k2, shx(k2, 32));
  float* kred = (float*)(lds + 40960);
  if ((tid & 63) < 8) kred[(tid >> 6) * 8 + (tid & 7)] = k2;
  {
    u16* vt = (u16*)lds;
    const uint4* vs = (const uint4*)(urow + UC_V + h * 64 + c * 32);
    const int p64 = pos & 63, within = p64 & 15, hh = (within >> 2) & 1, jj = ((within >> 3) << 2) | (within & 3);
    const int col = (p64 & ~15) + 8 * hh + jj;
    u16* vd = vt + (h * 64 + c * 32) * 72 + col;
#pragma unroll
    for (int i = 0; i < 4; ++i) {
      uint4 a = vs[i];
      vd[(i * 8 + 0) * 72] = (u16)(a.x & 0xffff); vd[(i * 8 + 1) * 72] = (u16)(a.x >> 16);
      vd[(i * 8 + 2) * 72] = (u16)(a.y & 0xffff); vd[(i * 8 + 3) * 72] = (u16)(a.y >> 16);
      vd[(i * 8 + 4) * 72] = (u16)(a.z & 0xffff); vd[(i * 8 + 5) * 72] = (u16)(a.z >> 16);
      vd[(i * 8 + 6) * 72] = (u16)(a.w & 0xffff); vd[(i * 8 + 7) * 72] = (u16)(a.w >> 16);
    }
    __syncthreads();
    const int m0u = unit * 64;
    const int bu = m0u < MLAT ? (m0u >> 13) : ((m0u - MLAT) >> 8), pos0 = m0u < MLAT ? (m0u & 8191) : 8192 + ((m0u - MLAT) & 255);
    u16* Vg = (u16*)(P.ws + WS_VT) + (size_t)(bu * 4) * 64 * NKEY + pos0;
#pragma unroll
    for (int q = 0; q < 4; ++q) {
      const int idx = tid + q * NTHREADS, row = idx >> 3, part = idx & 7;
      *(uint4*)(Vg + (size_t)row * NKEY + part * 8) = *(const uint4*)(vt + row * 72 + part * 8);
    }
    if (tid < 8) {
      float mx = 0.f;
#pragma unroll
      for (int w8 = 0; w8 < 8; ++w8) mx = fmaxf(mx, kred[w8 * 8 + tid]);
      atomicMax((unsigned*)(P.ws + WS_MISC) + ((l * 2 + bu) * 4 + (tid >> 1)) * 2 + (tid & 1), __float_as_uint(mx));
    }
    __syncthreads();
  }
}

constexpr int QP = 136, GP = 129, GLA_SG = 2 * 64 * QP * 2 + 64 * 256 * 2, GLA_SLR = GLA_SG + 2 * 64 * GP * 4;
DI void gla_stage(const Params& P, int l, int b, int cb, char* lds) {
  u16* sq = (u16*)lds; u16* sk = sq + 64 * QP; u16* sv = sk + 64 * QP; float* sg = (float*)(lds + GLA_SG); float* slr = (float*)(lds + GLA_SLR);
  const int tid = tidx(), m0 = blk_m0(b, cb);
  const u16* U = (const u16*)(P.ws + WS_U);
#pragma unroll
  for (int e = tid; e < 1024; e += NTHREADS) {
    int t = e >> 4, part = e & 15; const u16* row = U + (size_t)(m0 + t) * UP;
    *(uint4*)(sq + t * QP + part * 8) = *(const uint4*)(row + UA_Q + part * 8);
    *(uint4*)(sk + t * QP + part * 8) = *(const uint4*)(row + UA_K + part * 8);
  }
#pragma unroll
  for (int e = tid; e < 2048; e += NTHREADS) { int t = e >> 5, part = e & 31; *(uint4*)(sv + t * 256 + part * 8) = *(const uint4*)(U + (size_t)(m0 + t) * UP + UA_V + part * 8); }
  {
    int t = tid >> 3, part = tid & 7;
    uint2 v = *(const uint2*)(U + (size_t)(m0 + t) * UP + UA_LRF + part * 4);
    int dir = part >> 2, r0 = (part & 3) * 4; float* d = slr + (dir * 64 + t) * 16 + r0;
    d[0] = bflo(v.x); d[1] = bfhi(v.x); d[2] = bflo(v.y); d[3] = bfhi(v.y);
  }
  __syncthreads();
  {
    const int hk = tid & 127, tq = tid >> 7;
#pragma unroll
    for (int dir = 0; dir < 2; ++dir) {
      float wv[16];
#pragma unroll
      for (int r = 0; r < 16; ++r) wv[r] = P.gla_w2[((l * 2 + dir) * 16 + r) * 128 + hk];
      const float bb = P.gla_b2[(l * 2 + dir) * 128 + hk];
      for (int t = tq; t < 64; t += 4) {
        const float* lr = slr + (dir * 64 + t) * 16; float z = bb;
#pragma unroll
        for (int r = 0; r < 16; ++r) z += lr[r] * wv[r];
        const float ls = fminf(z, 0.f) - __logf(1.f + __expf(-fabsf(z)));
        sg[(dir * 64 + t) * GP + hk] = ls * (1.f / 16.f);
      }
    }
  }
  __syncthreads();
  if (tid < 256) {
    const int dir = tid >> 7, hk = tid & 127; float s = 0.f;
    float* col = sg + dir * 64 * GP + hk; float v[64];
#pragma unroll
    for (int t = 0; t < 64; ++t) v[t] = col[t * GP];
    if (dir == 0) {
#pragma unroll
      for (int t = 0; t < 64; ++t) { s += v[t]; col[t * GP] = s; }
    } else {
#pragma unroll
      for (int t = 63; t >= 0; --t) { s += v[t]; col[t * GP] = s; }
    }
  }
  __syncthreads();
}

DI void gla_local(const Params& P, int l, int b, int cb, char* lds) {
  gla_stage(P, l, b, cb, lds);
  const u16* sk = (const u16*)lds + 64 * QP; const u16* sv = sk + 64 * QP; const float* sg = (const float*)(lds + GLA_SG);
  const int tid = tidx(), w = tid >> 6, lane = tid & 63, c31 = lane & 31, hh = lane >> 5, dir = w >> 2, h = w & 3;
  const float* g = sg + dir * 64 * GP;
  const float glast = g[(dir ? 0 : 63) * GP + h * 32 + c31];
  f32x16 acc[2];
#pragma unroll
  for (int r = 0; r < 16; ++r) { acc[0][r] = 0.f; acc[1][r] = 0.f; }
#pragma unroll
  for (int ks = 0; ks < 4; ++ks) {
    float av[8];
#pragma unroll
    for (int e = 0; e < 8; ++e) { const int j = ks * 16 + hh * 8 + e; av[e] = bf2f(sk[j * QP + h * 32 + c31]) * __expf(glast - g[j * GP + h * 32 + c31]); }
    const bf16x8 a = pack8(av[0], av[1], av[2], av[3], av[4], av[5], av[6], av[7]);
#pragma unroll
    for (int vt = 0; vt < 2; ++vt) {
      bf16x8 bv;
#pragma unroll
      for (int e = 0; e < 8; ++e) bv[e] = (short)sv[(ks * 16 + hh * 8 + e) * 256 + h * 64 + vt * 32 + c31];
      acc[vt] = MFMA32(a, bv, acc[vt]);
    }
  }
  const int seq = (b * 2 + dir) * 4 + h, ci = blk_ci(cb, dir);
  u16* dst = (u16*)(P.ws + WS_GLA) + (size_t)(seq * NCH + ci) * 2048;
#pragma unroll
  for (int vt = 0; vt < 2; ++vt)
#pragma unroll
    for (int r = 0; r < 16; ++r) dst[crow(r, hh) * 64 + vt * 32 + c31] = f2bf(acc[vt][r]);
  if (hh == 0) ((float*)(P.ws + WS_GLAD))[(seq * NCH + ci) * 32 + c31] = __expf(glast);
  __syncthreads();
}

DI void gla_out(const Params& P, int l, int b, int cb, char* lds) {
  gla_stage(P, l, b, cb, lds);
  const u16* sq = (const u16*)lds; const u16* sk = sq + 64 * QP; const u16* sv = sk + 64 * QP; const float* sg = (const float*)(lds + GLA_SG);
  const int tid = tidx(), w = tid >> 6, lane = tid & 63, c31 = lane & 31, hh = lane >> 5, dir = w >> 2, h = w & 3;
  const float* g = sg + dir * 64 * GP;
  const int seq = (b * 2 + dir) * 4 + h, ci = blk_ci(cb, dir), m0 = blk_m0(b, cb);
  const u16* Sin = (const u16*)(P.ws + WS_GLA) + (size_t)(seq * NCH + ci) * 2048;
  f32x16 o[2][2];
#pragma unroll
  for (int a = 0; a < 2; ++a)
#pragma unroll
    for (int bb = 0; bb < 2; ++bb)
#pragma unroll
      for (int r = 0; r < 16; ++r) o[a][bb][r] = 0.f;
  bf16x8 qg[2][2];
#pragma unroll
  for (int it = 0; it < 2; ++it)
#pragma unroll
    for (int ks = 0; ks < 2; ++ks) {
      float v[8]; const int i = it * 32 + c31;
#pragma unroll
      for (int e = 0; e < 8; ++e) { const int kk = h * 32 + ks * 16 + hh * 8 + e; v[e] = bf2f(sq[i * QP + kk]) * __expf(g[i * GP + kk]) * 0.17677669529663687f; }
      qg[it][ks] = pack8(v[0], v[1], v[2], v[3], v[4], v[5], v[6], v[7]);
    }
#pragma unroll
  for (int ks = 0; ks < 2; ++ks)
#pragma unroll
    for (int vt = 0; vt < 2; ++vt) {
      bf16x8 sa;
#pragma unroll
      for (int e = 0; e < 8; ++e) sa[e] = (short)Sin[(ks * 16 + hh * 8 + e) * 64 + vt * 32 + c31];
#pragma unroll
      for (int it = 0; it < 2; ++it) o[vt][it] = MFMA32(sa, qg[it][ks], o[vt][it]);
    }
#pragma unroll
  for (int jt = 0; jt < 2; ++jt) {
    bf16x8 kg[2];
#pragma unroll
    for (int ks = 0; ks < 2; ++ks) {
      float v[8]; const int j = jt * 32 + c31;
#pragma unroll
      for (int e = 0; e < 8; ++e) { const int kk = h * 32 + ks * 16 + hh * 8 + e; v[e] = bf2f(sk[j * QP + kk]) * __expf(-g[j * GP + kk]); }
      kg[ks] = pack8(v[0], v[1], v[2], v[3], v[4], v[5], v[6], v[7]);
    }
#pragma unroll
    for (int it = 0; it < 2; ++it) {
      const bool skip = dir == 0 ? (jt > it) : (jt < it);
      if (skip) continue;
      f32x16 s;
#pragma unroll
      for (int r = 0; r < 16; ++r) s[r] = 0.f;
      s = MFMA32(kg[0], qg[it][0], s); s = MFMA32(kg[1], qg[it][1], s);
      const int i = it * 32 + c31;
#pragma unroll
      for (int r = 0; r < 16; ++r) { const int j = jt * 32 + crow(r, hh); const bool keep = dir == 0 ? (j <= i) : (j >= i); s[r] = keep ? s[r] : 0.f; }
      const bf16x8 p0 = pack8(s[0], s[1], s[2], s[3], s[4], s[5], s[6], s[7]), p1 = pack8(s[8], s[9], s[10], s[11], s[12], s[13], s[14], s[15]);
#pragma unroll
      for (int s2 = 0; s2 < 2; ++s2)
#pragma unroll
        for (int vt = 0; vt < 2; ++vt) {
          bf16x8 va;
#pragma unroll
          for (int e = 0; e < 8; ++e) { const int j = jt * 32 + 16 * s2 + 8 * (e >> 2) + 4 * hh + (e & 3); va[e] = (short)sv[j * 256 + h * 64 + vt * 32 + c31]; }
          o[vt][it] = MFMA32(va, s2 ? p1 : p0, o[vt][it]);
        }
    }
  }
  __syncthreads();
  float* xb = (float*)(lds + GLA_SG);
  if (dir == 1) {
#pragma unroll
    for (int vt = 0; vt < 2; ++vt)
#pragma unroll
      for (int it = 0; it < 2; ++it)
#pragma unroll
        for (int r = 0; r < 16; ++r) xb[(it * 32 + c31) * 257 + h * 64 + vt * 32 + crow(r, hh)] = o[vt][it][r];
  }
  __syncthreads();
  if (dir == 0) {
#pragma unroll
    for (int vt = 0; vt < 2; ++vt)
#pragma unroll
      for (int it = 0; it < 2; ++it)
#pragma unroll
        for (int r = 0; r < 16; ++r) xb[(it * 32 + c31) * 257 + h * 64 + vt * 32 + crow(r, hh)] += o[vt][it][r];
  }
  __syncthreads();
  {
    const u16* U = (const u16*)(P.ws + WS_U); u16* Y = (u16*)(P.ws + WS_XN);
#pragma unroll
    for (int q = 0; q < 4; ++q) {
      const int idx = tid + q * NTHREADS, row = idx >> 5, ch0 = (idx & 31) * 8; const size_t m = (size_t)(m0 + row);
      const uint4 gv = ld_nt((const uint4*)(U + m * UP + UA_G + ch0));
      float v[8]; float ss = 0.f;
#pragma unroll
      for (int e = 0; e < 8; ++e) { v[e] = xb[row * 257 + ch0 + e]; ss += v[e] * v[e]; }
      ss += shx(ss, 1); ss += shx(ss, 2); ss += shx(ss, 4);
      const float rstd = rsqrtf(ss * (1.f / 64.f) + 1e-6f);
      const float4 n0 = *(const float4*)(P.gla_norm_w + l * 64 + (ch0 & 63)), n1 = *(const float4*)(P.gla_norm_w + l * 64 + (ch0 & 63) + 4);
      uint4 ov;
      ov.x = pk2(v[0] * rstd * n0.x * siluf(bflo(gv.x)), v[1] * rstd * n0.y * siluf(bfhi(gv.x)));
      ov.y = pk2(v[2] * rstd * n0.z * siluf(bflo(gv.y)), v[3] * rstd * n0.w * siluf(bfhi(gv.y)));
      ov.z = pk2(v[4] * rstd * n1.x * siluf(bflo(gv.z)), v[5] * rstd * n1.y * siluf(bfhi(gv.z)));
      ov.w = pk2(v[6] * rstd * n1.z * siluf(bflo(gv.w)), v[7] * rstd * n1.w * siluf(bfhi(gv.w)));
      *(uint4*)(Y + m * 1024 + ch0) = ov;
    }
  }
  __syncthreads();
}

constexpr int SXP = 520;
DI void ssd_stage(const Params& P, int l, int b, int cb, char* lds) {
  u16* sx = (u16*)lds; float* scum = (float*)(lds + 132352); float* sdt = scum + 512;
  const int tid = tidx(), m0 = blk_m0(b, cb);
  const u16* U = (const u16*)(P.ws + WS_U);
  const int tseq0 = cb < 4 ? cb * 64 : (cb - 4) * 64, slen = cb < 4 ? 256 : T, mseq0 = cb < 4 ? MLAT + b * 256 : b * T;
  {
    const int ch0 = (tid & 63) * 8;
    float wt[4][8], bs[8];
    { const float4 b0 = *(const float4*)(P.ssd_conv_b + l * 512 + ch0), b1 = *(const float4*)(P.ssd_conv_b + l * 512 + ch0 + 4);
      bs[0] = b0.x; bs[1] = b0.y; bs[2] = b0.z; bs[3] = b0.w; bs[4] = b1.x; bs[5] = b1.y; bs[6] = b1.z; bs[7] = b1.w; }
#pragma unroll
    for (int j = 0; j < 4; ++j) {
      const float* wj = gp(P.ssd_conv_w + (l * 4 + j) * 512 + ch0); const float4 w0 = *(const float4*)wj, w1 = *(const float4*)(wj + 4);
      wt[j][0] = w0.x; wt[j][1] = w0.y; wt[j][2] = w0.z; wt[j][3] = w0.w; wt[j][4] = w1.x; wt[j][5] = w1.y; wt[j][6] = w1.z; wt[j][7] = w1.w;
    }
#pragma unroll 2
    for (int t = tid >> 6; t < 64; t += 8) {
      float acc[8];
#pragma unroll
      for (int i = 0; i < 8; ++i) acc[i] = bs[i];
#pragma unroll
      for (int j = 0; j < 4; ++j) {
        const int ts = tseq0 + t - 2 + j;
        if (ts >= 0 && ts < slen) {
          const uint4 v = *(const uint4*)(U + (size_t)(mseq0 + ts) * UP + UD_XBC + ch0);
          acc[0] += bflo(v.x) * wt[j][0]; acc[1] += bfhi(v.x) * wt[j][1]; acc[2] += bflo(v.y) * wt[j][2]; acc[3] += bfhi(v.y) * wt[j][3];
          acc[4] += bflo(v.z) * wt[j][4]; acc[5] += bfhi(v.z) * wt[j][5]; acc[6] += bflo(v.w) * wt[j][6]; acc[7] += bfhi(v.w) * wt[j][7];
        }
      }
      uint4 o; o.x = pk2(siluf(acc[0]), siluf(acc[1])); o.y = pk2(siluf(acc[2]), siluf(acc[3])); o.z = pk2(siluf(acc[4]), siluf(acc[5])); o.w = pk2(siluf(acc[6]), siluf(acc[7]));
      *(uint4*)(sx + t * SXP + ch0) = o;
    }
  }
  {
    const int dir = tid >> 8, t = (tid >> 2) & 63, hd = tid & 3;
    const float raw = bf2f(U[(size_t)(m0 + t) * UP + UD_DTF + dir * 4 + hd]);
    const float dt = softplusf(raw + P.ssd_dt_bias[(l * 2 + dir) * 4 + hd]);
    const float a = -__expf(P.ssd_a_log[(l * 2 + dir) * 4 + hd]);
    sdt[(dir * 64 + t) * 4 + hd] = dt; scum[(dir * 64 + t) * 4 + hd] = dt * a;
  }
  __syncthreads();
  if (tid < 8) {
    const int dir = tid >> 2, hd = tid & 3; float s = 0.f;
    float* col = scum + dir * 256 + hd; float v[64];
#pragma unroll
    for (int t = 0; t < 64; ++t) v[t] = col[t * 4];
    if (dir == 0) {
#pragma unroll
      for (int t = 0; t < 64; ++t) { s += v[t]; col[t * 4] = s; }
    } else {
#pragma unroll
      for (int t = 63; t >= 0; --t) { s += v[t]; col[t * 4] = s; }
    }
  }
  __syncthreads();
}

DI void ssd_local(const Params& P, int l, int b, int cb, char* lds) {
  ssd_stage(P, l, b, cb, lds);
  const u16* sx = (const u16*)lds; const float* scum = (const float*)(lds + 132352); const float* sdt = scum + 512;
  const int tid = tidx(), w = tid >> 6, lane = tid & 63, c31 = lane & 31, hh = lane >> 5, dir = w >> 2, h = w & 3, grp = h >> 1;
  const float cl = scum[(dir * 64 + (dir ? 0 : 63)) * 4 + h];
  f32x16 acc[2][2];
#pragma unroll
  for (int a = 0; a < 2; ++a)
#pragma unroll
    for (int bb = 0; bb < 2; ++bb)
#pragma unroll
      for (int r = 0; r < 16; ++r) acc[a][bb][r] = 0.f;
#pragma unroll
  for (int ks = 0; ks < 4; ++ks) {
    float wgt[8];
#pragma unroll
    for (int e = 0; e < 8; ++e) { const int s = ks * 16 + hh * 8 + e; wgt[e] = __expf(cl - scum[(dir * 64 + s) * 4 + h]) * sdt[(dir * 64 + s) * 4 + h]; }
    bf16x8 bn[2];
#pragma unroll
    for (int nt = 0; nt < 2; ++nt)
#pragma unroll
      for (int e = 0; e < 8; ++e) bn[nt][e] = (short)sx[(ks * 16 + hh * 8 + e) * SXP + 256 + grp * 64 + nt * 32 + c31];
#pragma unroll
    for (int pt = 0; pt < 2; ++pt) {
      float v[8];
#pragma unroll
      for (int e = 0; e < 8; ++e) v[e] = bf2f(sx[(ks * 16 + hh * 8 + e) * SXP + h * 64 + pt * 32 + c31]) * wgt[e];
      const bf16x8 a = pack8(v[0], v[1], v[2], v[3], v[4], v[5], v[6], v[7]);
#pragma unroll
      for (int nt = 0; nt < 2; ++nt) acc[pt][nt] = MFMA32(a, bn[nt], acc[pt][nt]);
    }
  }
  const int seq = (b * 2 + dir) * 4 + h, ci = blk_ci(cb, dir);
  u16* dst = (u16*)(P.ws + WS_SSD) + (size_t)(seq * NCH + ci) * 4096;
#pragma unroll
  for (int pt = 0; pt < 2; ++pt)
#pragma unroll
    for (int nt = 0; nt < 2; ++nt)
#pragma unroll
      for (int r = 0; r < 16; ++r) dst[(pt * 32 + crow(r, hh)) * 64 + nt * 32 + c31] = f2bf(acc[pt][nt][r]);
  if (lane == 0) ((float*)(P.ws + WS_SSDD))[seq * NCH + ci] = __expf(cl);
  __syncthreads();
}

DI void ssd_out(const Params& P, int l, int b, int cb, char* lds) {
  ssd_stage(P, l, b, cb, lds);
  const u16* sx = (const u16*)lds; float* xb = (float*)(lds + 66560); const float* scum = (const float*)(lds + 132352); const float* sdt = scum + 512; float* ssq = (float*)(lds + 136448);
  const int tid = tidx(), w = tid >> 6, lane = tid & 63, c31 = lane & 31, hh = lane >> 5, dir = w >> 2, h = w & 3, grp = h >> 1;
  const int seq = (b * 2 + dir) * 4 + h, ci = blk_ci(cb, dir), m0 = blk_m0(b, cb);
  const u16* Sin = (const u16*)(P.ws + WS_SSD) + (size_t)(seq * NCH + ci) * 4096;
  f32x16 y[2][2];
#pragma unroll
  for (int a = 0; a < 2; ++a)
#pragma unroll
    for (int bb = 0; bb < 2; ++bb)
#pragma unroll
      for (int r = 0; r < 16; ++r) y[a][bb][r] = 0.f;
#pragma unroll
  for (int lt = 0; lt < 2; ++lt) {
    const int tl = lt * 32 + c31;
    const float cuml = scum[(dir * 64 + tl) * 4 + h];
    const float ecl = __expf(cuml);
#pragma unroll
    for (int ks = 0; ks < 4; ++ks) {
      const uint4 cv = *(const uint4*)(sx + tl * SXP + 384 + grp * 64 + ks * 16 + hh * 8);
      const bf16x8 cmf = pack8(bflo(cv.x) * ecl, bfhi(cv.x) * ecl, bflo(cv.y) * ecl, bfhi(cv.y) * ecl, bflo(cv.z) * ecl, bfhi(cv.z) * ecl, bflo(cv.w) * ecl, bfhi(cv.w) * ecl);
#pragma unroll
      for (int pt = 0; pt < 2; ++pt) {
        const uint4 sraw = ld_nt((const uint4*)(Sin + (pt * 32 + c31) * 64 + ks * 16 + hh * 8)); const bf16x8 sa = mk8(sraw.x, sraw.y, sraw.z, sraw.w);
        y[pt][lt] = MFMA32(sa, cmf, y[pt][lt]);
      }
    }
#pragma unroll
    for (int st = 0; st < 2; ++st) {
      const bool skip = dir == 0 ? (st > lt) : (st < lt);
      if (skip) continue;
      f32x16 cbt;
#pragma unroll
      for (int r = 0; r < 16; ++r) cbt[r] = 0.f;
#pragma unroll
      for (int ks = 0; ks < 4; ++ks) {
        const bf16x8 bmf = *(const bf16x8*)(sx + (st * 32 + c31) * SXP + 256 + grp * 64 + ks * 16 + hh * 8);
        const bf16x8 cmf = *(const bf16x8*)(sx + tl * SXP + 384 + grp * 64 + ks * 16 + hh * 8);
        cbt = MFMA32(bmf, cmf, cbt);
      }
#pragma unroll
      for (int r = 0; r < 16; ++r) {
        const int s = st * 32 + crow(r, hh); const bool keep = dir == 0 ? (s <= tl) : (s >= tl);
        const float dec = __expf(fminf(cuml - scum[(dir * 64 + s) * 4 + h], 0.f)) * sdt[(dir * 64 + s) * 4 + h];
        cbt[r] = keep ? cbt[r] * dec : 0.f;
      }
      const bf16x8 p0 = pack8(cbt[0], cbt[1], cbt[2], cbt[3], cbt[4], cbt[5], cbt[6], cbt[7]), p1 = pack8(cbt[8], cbt[9], cbt[10], cbt[11], cbt[12], cbt[13], cbt[14], cbt[15]);
#pragma unroll
      for (int s2 = 0; s2 < 2; ++s2)
#pragma unroll
        for (int pt = 0; pt < 2; ++pt) {
          bf16x8 xa;
#pragma unroll
          for (int e = 0; e < 8; ++e) { const int s = st * 32 + 16 * s2 + 8 * (e >> 2) + 4 * hh + (e & 3); xa[e] = (short)sx[s * SXP + h * 64 + pt * 32 + c31]; }
          y[pt][lt] = MFMA32(xa, s2 ? p1 : p0, y[pt][lt]);
        }
    }
  }
  if (dir == 1) {
#pragma unroll
    for (int pt = 0; pt < 2; ++pt)
#pragma unroll
      for (int lt = 0; lt < 2; ++lt)
#pragma unroll
        for (int r = 0; r < 16; ++r) xb[(lt * 32 + c31) * 257 + h * 64 + pt * 32 + crow(r, hh)] = y[pt][lt][r];
  }
  __syncthreads();
  if (dir == 0) {
    const float dsk = P.ssd_d[l * 4 + h];
#pragma unroll
    for (int lt = 0; lt < 2; ++lt) {
      const int tl = lt * 32 + c31;
#pragma unroll
      for (int pt = 0; pt < 2; ++pt)
#pragma unroll
        for (int r = 0; r < 16; ++r) {
          const int p = pt * 32 + crow(r, hh);
          xb[tl * 257 + h * 64 + p] += y[pt][lt][r] + dsk * bf2f(sx[tl * SXP + h * 64 + p]);
        }
    }
  }
  __syncthreads();
  {
    const u16* U = (const u16*)(P.ws + WS_U); u16* Y = (u16*)(P.ws + WS_XN);
#pragma unroll
    for (int q = 0; q < 4; ++q) {
      const int idx = tid + q * NTHREADS, row = idx >> 5, ch0 = (idx & 31) * 8; const size_t m = (size_t)(m0 + row);
      const uint4 zv = ld_nt((const uint4*)(U + m * UP + UD_Z + ch0));
      const float zz[8] = {bflo(zv.x), bfhi(zv.x), bflo(zv.y), bfhi(zv.y), bflo(zv.z), bfhi(zv.z), bflo(zv.w), bfhi(zv.w)};
      float v[8]; float ss = 0.f;
#pragma unroll
      for (int e = 0; e < 8; ++e) { v[e] = xb[row * 257 + ch0 + e] * siluf(zz[e]); ss += v[e] * v[e]; }
      ss += shx(ss, 1); ss += shx(ss, 2); ss += shx(ss, 4); ss += shx(ss, 8); ss += shx(ss, 16);
      const float rstd = rsqrtf(ss * (1.f / 256.f) + 1e-6f);
      const float4 n0 = *(const float4*)(P.ssd_norm_w + l * 256 + ch0), n1 = *(const float4*)(P.ssd_norm_w + l * 256 + ch0 + 4);
      uint4 ov;
      ov.x = pk2(v[0] * rstd * n0.x, v[1] * rstd * n0.y); ov.y = pk2(v[2] * rstd * n0.z, v[3] * rstd * n0.w);
      ov.z = pk2(v[4] * rstd * n1.x, v[5] * rstd * n1.y); ov.w = pk2(v[6] * rstd * n1.z, v[7] * rstd * n1.w);
      *(uint4*)(Y + m * 1024 + 768 + ch0) = ov;
    }
  }
  __syncthreads();
}

constexpr int LXP = 264;
DI float neg_expm1f(float x) { return x > -0.01f ? -x * (1.f + x * (0.5f + x * (1.f / 6.f))) : 1.f - __expf(x); }

DI void lru_stage(const Params& P, int l, int b, int cb, char* lds) {
  u16* sxc = (u16*)lds;
  const int tid = tidx();
  const u16* U = (const u16*)(P.ws + WS_U);
  const int tseq0 = cb < 4 ? cb * 64 : (cb - 4) * 64, slen = cb < 4 ? 256 : T, mseq0 = cb < 4 ? MLAT + b * 256 : b * T;
  {
    const int ch0 = (tid & 31) * 8;
    float wt[4][8], bs[8];
    { const float4 b0 = *(const float4*)(P.lru_conv_b + l * 256 + ch0), b1 = *(const float4*)(P.lru_conv_b + l * 256 + ch0 + 4);
      bs[0] = b0.x; bs[1] = b0.y; bs[2] = b0.z; bs[3] = b0.w; bs[4] = b1.x; bs[5] = b1.y; bs[6] = b1.z; bs[7] = b1.w; }
#pragma unroll
    for (int j = 0; j < 4; ++j) {
      const float* wj = gp(P.lru_conv_w + (l * 4 + j) * 256 + ch0); const float4 w0 = *(const float4*)wj, w1 = *(const float4*)(wj + 4);
      wt[j][0] = w0.x; wt[j][1] = w0.y; wt[j][2] = w0.z; wt[j][3] = w0.w; wt[j][4] = w1.x; wt[j][5] = w1.y; wt[j][6] = w1.z; wt[j][7] = w1.w;
    }
#pragma unroll 2
    for (int t = tid >> 5; t < 64; t += 16) {
      float acc[8];
#pragma unroll
      for (int i = 0; i < 8; ++i) acc[i] = bs[i];
#pragma unroll
      for (int j = 0; j < 4; ++j) {
        const int ts = tseq0 + t - 2 + j;
        if (ts >= 0 && ts < slen) {
          const uint4 v = *(const uint4*)(U + (size_t)(mseq0 + ts) * UP + UB_X + ch0);
          acc[0] += bflo(v.x) * wt[j][0]; acc[1] += bfhi(v.x) * wt[j][1]; acc[2] += bflo(v.y) * wt[j][2]; acc[3] += bfhi(v.y) * wt[j][3];
          acc[4] += bflo(v.z) * wt[j][4]; acc[5] += bfhi(v.z) * wt[j][5]; acc[6] += bflo(v.w) * wt[j][6]; acc[7] += bfhi(v.w) * wt[j][7];
        }
      }
      uint4 o; o.x = pk2(acc[0], acc[1]); o.y = pk2(acc[2], acc[3]); o.z = pk2(acc[4], acc[5]); o.w = pk2(acc[6], acc[7]);
      *(uint4*)(sxc + t * LXP + ch0) = o;
    }
  }
  __syncthreads();
}

DI void lru_gates(const Params& P, int l, int dir, int g, int ct, const u16* sxc, f32x16 (&av)[2], f32x16 (&uv)[2]) {
  const int lane = tidx() & 63, c31 = lane & 31, hh = lane >> 5;
#pragma unroll
  for (int a = 0; a < 2; ++a)
#pragma unroll
    for (int r = 0; r < 16; ++r) { av[a][r] = 0.f; uv[a][r] = 0.f; }
  const u16* wfa_p = (const u16*)(P.ws + WS_LRUW) + (size_t)((((l * 2 + dir) * 4 + g) * 2 + 0) * 4096) + (ct * 64 + lane) * 8;
  const u16* wfx_p = wfa_p + 4096;
#pragma unroll
  for (int ks = 0; ks < 4; ++ks) {
    const bf16x8 wfa = *(const bf16x8*)(wfa_p + ks * 1024), wfx = *(const bf16x8*)(wfx_p + ks * 1024);
#pragma unroll
    for (int tt = 0; tt < 2; ++tt) {
      const bf16x8 xa = *(const bf16x8*)(sxc + (tt * 32 + c31) * LXP + g * 64 + ks * 16 + hh * 8);
      av[tt] = MFMA32(xa, wfa, av[tt]); uv[tt] = MFMA32(xa, wfx, uv[tt]);
    }
  }
  const int ch = g * 64 + ct * 32 + c31;
  const float ba = P.lru_ba[(l * 2 + dir) * 256 + ch], bx = P.lru_bx[(l * 2 + dir) * 256 + ch];
  const float sp = softplusf(-P.lru_lam[(l * 2 + dir) * 256 + ch]);
#pragma unroll
  for (int tt = 0; tt < 2; ++tt)
#pragma unroll
    for (int r = 0; r < 16; ++r) {
      const float rg = sigmf(av[tt][r] + ba), ig = sigmf(uv[tt][r] + bx);
      const float la = -8.f * rg * sp;
      const float xv = bf2f(sxc[(tt * 32 + crow(r, hh)) * LXP + ch]);
      av[tt][r] = __expf(la);
      uv[tt][r] = __builtin_amdgcn_sqrtf(neg_expm1f(2.f * la)) * ig * xv;
    }
}

template <int REV>
DI void lru_scan(f32x16 (&av)[2], f32x16 (&uv)[2], float& hc, float& ap) {
  const int hh = (tidx() & 63) >> 5;
  const bool first = (hh == (REV ? 1 : 0));
  ap = 1.f;
#pragma unroll
  for (int tti = 0; tti < 2; ++tti) {
    const int tt = REV ? 1 - tti : tti;
#pragma unroll
    for (int ii = 0; ii < 4; ++ii) {
      const int i = REV ? 3 - ii : ii;
      float GA = 1.f, GU = 0.f;
#pragma unroll
      for (int ee = 0; ee < 4; ++ee) { const int r = 4 * i + (REV ? 3 - ee : ee); GU = av[tt][r] * GU + uv[tt][r]; GA *= av[tt][r]; }
      const float PA = shx(GA, 32), PU = shx(GU, 32);
      float hcur = first ? hc : PA * hc + PU;
#pragma unroll
      for (int ee = 0; ee < 4; ++ee) { const int r = 4 * i + (REV ? 3 - ee : ee); hcur = av[tt][r] * hcur + uv[tt][r]; uv[tt][r] = hcur; }
      const float pairA = GA * PA, pairU = first ? PA * GU + PU : GA * PU + GU;
      hc = pairA * hc + pairU; ap *= pairA;
    }
  }
}

DI void lru_local(const Params& P, int l, int b, int cb, char* lds) {
  lru_stage(P, l, b, cb, lds);
  const int tid = tidx(), w = tid >> 6, lane = tid & 63, c31 = lane & 31, hh = lane >> 5, dir = w >> 2, g = w & 3;
  const int ci = blk_ci(cb, dir);
#pragma unroll 1
  for (int ct = 0; ct < 2; ++ct) {
    f32x16 av[2], uv[2];
    lru_gates(P, l, dir, g, ct, (const u16*)lds, av, uv);
    float hc = 0.f, ap;
    if (dir) lru_scan<1>(av, uv, hc, ap); else lru_scan<0>(av, uv, hc, ap);
    if (hh == 0) {
      const int ch = g * 64 + ct * 32 + c31;
      ((float*)(P.ws + WS_LRUA))[((b * 2 + dir) * NCH + ci) * 256 + ch] = ap;
      ((float*)(P.ws + WS_LRUU))[((b * 2 + dir) * NCH + ci) * 256 + ch] = hc;
    }
  }
  __syncthreads();
}

DI void lru_out(const Params& P, int l, int b, int cb, char* lds) {
  lru_stage(P, l, b, cb, lds);
  const int tid = tidx(), w = tid >> 6, lane = tid & 63, c31 = lane & 31, hh = lane >> 5, dir = w >> 2, g = w & 3;
  const int ci = blk_ci(cb, dir), m0 = blk_m0(b, cb);
  float* xb = (float*)(lds + 34816);
  f32x16 hres[2][2];
#pragma unroll
  for (int ct = 0; ct < 2; ++ct) {
    f32x16 av[2], uv[2];
    lru_gates(P, l, dir, g, ct, (const u16*)lds, av, uv);
    float hc = ((const float*)(P.ws + WS_LRUU))[((b * 2 + dir) * NCH + ci) * 256 + g * 64 + ct * 32 + c31], ap;
    if (dir) lru_scan<1>(av, uv, hc, ap); else lru_scan<0>(av, uv, hc, ap);
    if (dir == 1) {
#pragma unroll
      for (int tt = 0; tt < 2; ++tt)
#pragma unroll
        for (int r = 0; r < 16; ++r) xb[(tt * 32 + crow(r, hh)) * 257 + g * 64 + ct * 32 + c31] = uv[tt][r];
    }
    hres[ct][0] = uv[0]; hres[ct][1] = uv[1];
  }
  __syncthreads();
  if (dir == 0) {
#pragma unroll
    for (int ct = 0; ct < 2; ++ct)
#pragma unroll
      for (int tt = 0; tt < 2; ++tt)
#pragma unroll
        for (int r = 0; r < 16; ++r) xb[(tt * 32 + crow(r, hh)) * 257 + g * 64 + ct * 32 + c31] += hres[ct][tt][r];
  }
  __syncthreads();
  {
    const u16* U = (const u16*)(P.ws + WS_U); u16* Y = (u16*)(P.ws + WS_XN);
#pragma unroll
    for (int q = 0; q < 4; ++q) {
      const int idx = tid + q * NTHREADS, row = idx >> 5, ch0 = (idx & 31) * 8; const size_t m = (size_t)(m0 + row);
      const uint4 gv = ld_nt((const uint4*)(U + m * UP + UB_G + ch0));
      const float* xr = xb + row * 257 + ch0;
      uint4 ov;
      ov.x = pk2(xr[0] * siluf(bflo(gv.x)), xr[1] * siluf(bfhi(gv.x))); ov.y = pk2(xr[2] * siluf(bflo(gv.y)), xr[3] * siluf(bfhi(gv.y)));
      ov.z = pk2(xr[4] * siluf(bflo(gv.z)), xr[5] * siluf(bfhi(gv.z))); ov.w = pk2(xr[6] * siluf(bflo(gv.w)), xr[7] * siluf(bfhi(gv.w)));
      *(uint4*)(Y + m * 1024 + 256 + ch0) = ov;
    }
  }
  __syncthreads();
}

template <int PS, int DS>
DI void scan_bf16(u16* p, const float* d) {
  float s = 0.f;
  u16 ua[12], ub[12]; float da[12], db[12];
#pragma unroll
  for (int j = 0; j < 12; ++j) { ua[j] = p[(size_t)j * PS]; da[j] = d[j * DS]; }
#pragma unroll 1
  for (int g = 0; g < 11; g += 2) {
    if (g + 1 < 11) {
#pragma unroll
      for (int j = 0; j < 12; ++j) { ub[j] = p[(size_t)((g + 1) * 12 + j) * PS]; db[j] = d[((g + 1) * 12 + j) * DS]; }
    }
#pragma unroll
    for (int j = 0; j < 12; ++j) { p[(size_t)(g * 12 + j) * PS] = f2bf(s); s = da[j] * s + bf2f(ua[j]); }
    if (g + 2 < 11) {
#pragma unroll
      for (int j = 0; j < 12; ++j) { ua[j] = p[(size_t)((g + 2) * 12 + j) * PS]; da[j] = d[((g + 2) * 12 + j) * DS]; }
    }
    if (g + 1 < 11) {
#pragma unroll
      for (int j = 0; j < 12; ++j) { p[(size_t)((g + 1) * 12 + j) * PS] = f2bf(s); s = db[j] * s + bf2f(ub[j]); }
    }
  }
}

DI void phase_scans(const Params& P) {
  const int tid_ = tidx(); const int w = tid_ >> 6, lane = tid_ & 63;
  for (int unit = blockIdx.x + gridDim.x * w; unit < 1552; unit += gridDim.x * 8) {
    if (unit < 512) {
      const int item = unit * 64 + lane, seq = item >> 11, kv = item & 2047;
      scan_bf16<2048, 32>((u16*)(P.ws + WS_GLA) + (size_t)seq * NCH * 2048 + kv, (const float*)(P.ws + WS_GLAD) + seq * NCH * 32 + (kv >> 6));
    } else if (unit < 1536) {
      const int item = (unit - 512) * 64 + lane, seq = item >> 12, pn = item & 4095;
      scan_bf16<4096, 1>((u16*)(P.ws + WS_SSD) + (size_t)seq * NCH * 4096 + pn, (const float*)(P.ws + WS_SSDD) + seq * NCH);
    } else {
      const int item = (unit - 1536) * 64 + lane, bd = item >> 8, ch = item & 255;
      float* pu = (float*)(P.ws + WS_LRUU) + (size_t)bd * NCH * 256 + ch; const float* pa = (const float*)(P.ws + WS_LRUA) + (size_t)bd * NCH * 256 + ch;
      float s = 0.f;
      for (int c0 = 0; c0 < NCH; c0 += 12) {
        float uu[12], dd[12];
#pragma unroll
        for (int j = 0; j < 12; ++j) { uu[j] = pu[(c0 + j) * 256]; dd[j] = pa[(c0 + j) * 256]; }
#pragma unroll
        for (int j = 0; j < 12; ++j) { pu[(c0 + j) * 256] = s; s = dd[j] * s + uu[j]; }
      }
    }
  }
}

DI void attn_tile(const Params& P, int l, int b, int h, int qpos0, int key0, int ntile, float lam, float lam_init, char* lds) {
  const int tid = tidx(), w = tid >> 6, lane = tid & 63, c31 = lane & 31, hh = lane >> 5;
  const u16* Qg = (const u16*)(P.ws + WS_Q) + (size_t)((b * 4 + h) * 2) * NKEY * 32;
  const u16* Kg = (const u16*)(P.ws + WS_K) + (size_t)((b * 4 + h) * 2) * NKEY * 32;
  const u16* Vg = (const u16*)(P.ws + WS_VT) + (size_t)((b * 4 + h) * 64) * NKEY;
  const int qp = qpos0 + w * 32 + c31;
  bf16x8 qf[2][2]; float bq[2];
#pragma unroll
  for (int c = 0; c < 2; ++c)
#pragma unroll
    for (int ks = 0; ks < 2; ++ks) qf[c][ks] = *(const bf16x8*)(Qg + ((size_t)c * NKEY + qp) * 32 + ks * 16 + hh * 8);
#pragma unroll
  for (int c = 0; c < 2; ++c) {
    float s = 0.f;
#pragma unroll
    for (int ks = 0; ks < 2; ++ks)
#pragma unroll
      for (int e = 0; e < 8; ++e) { const float v = bf2f((u16)qf[c][ks][e]); s += v * v; }
    s += shx(s, 32);
    const float km = ((const float*)(P.ws + WS_MISC))[((l * 2 + b) * 4 + h) * 2 + c];
    bq[c] = sqrtf(s * km) * 1.002f + 1e-3f;
  }
  u16* sK = (u16*)lds; u16* sV = (u16*)(lds + 20480);
  const int kc = tid >> 8, kr = (tid >> 2) & 63, kpart = tid & 3, vdv = tid >> 3, vpart = tid & 7;
  const u16* kp = Kg + ((size_t)kc * NKEY + key0 + kr) * 32 + kpart * 8;
  const u16* vp = Vg + (size_t)vdv * NKEY + key0 + vpart * 8;
  uint4 rk = *(const uint4*)kp, rv = *(const uint4*)vp;
  *(uint4*)(sK + (kc * 64 + kr) * 40 + kpart * 8) = rk; *(uint4*)(sV + vdv * 72 + vpart * 8) = rv;
  __syncthreads();
  f32x16 O[2][2]; float ls[2] = {0.f, 0.f};
#pragma unroll
  for (int a = 0; a < 2; ++a)
#pragma unroll
    for (int bb = 0; bb < 2; ++bb)
#pragma unroll
      for (int r = 0; r < 16; ++r) O[a][bb][r] = 0.f;
  if (__builtin_amdgcn_readfirstlane(tid) >= 256) __builtin_amdgcn_s_setprio(1);
#pragma unroll 1
  for (int kt = 0; kt < ntile; ++kt) {
    const int cur = kt & 1;
    if (kt + 1 < ntile) { rk = *(const uint4*)(kp + (size_t)(kt + 1) * 2048); rv = *(const uint4*)(vp + (kt + 1) * 64); }
    const u16* cK = sK + cur * 5120; const u16* cV = sV + cur * 4608;
#pragma unroll
    for (int kt2 = 0; kt2 < 2; ++kt2) {
      const bf16x8 ka0 = *(const bf16x8*)(cK + (kt2 * 32 + c31) * 40 + hh * 8), ka1 = *(const bf16x8*)(cK + (kt2 * 32 + c31) * 40 + 16 + hh * 8);
      const bf16x8 kb0 = *(const bf16x8*)(cK + (64 + kt2 * 32 + c31) * 40 + hh * 8), kb1 = *(const bf16x8*)(cK + (64 + kt2 * 32 + c31) * 40 + 16 + hh * 8);
      f32x16 Sa, Sb;
#pragma unroll
      for (int r = 0; r < 16; ++r) { Sa[r] = -bq[0]; Sb[r] = -bq[1]; }
      Sa = MFMA32(ka0, qf[0][0], Sa); Sb = MFMA32(kb0, qf[1][0], Sb);
      Sa = MFMA32(ka1, qf[0][1], Sa); Sb = MFMA32(kb1, qf[1][1], Sb);
      const bf16x8 v00 = *(const bf16x8*)(cV + (c31) * 72 + (kt2 * 2) * 16 + hh * 8), v01 = *(const bf16x8*)(cV + (c31) * 72 + (kt2 * 2 + 1) * 16 + hh * 8);
      const bf16x8 v10 = *(const bf16x8*)(cV + (32 + c31) * 72 + (kt2 * 2) * 16 + hh * 8), v11 = *(const bf16x8*)(cV + (32 + c31) * 72 + (kt2 * 2 + 1) * 16 + hh * 8);
      {
        float p[16];
#pragma unroll
        for (int r = 0; r < 16; ++r) { p[r] = __builtin_amdgcn_exp2f(Sa[r]); ls[0] += p[r]; }
        const bf16x8 p0 = pack8(p[0], p[1], p[2], p[3], p[4], p[5], p[6], p[7]), p1 = pack8(p[8], p[9], p[10], p[11], p[12], p[13], p[14], p[15]);
        O[0][0] = MFMA32(v00, p0, O[0][0]); O[0][1] = MFMA32(v10, p0, O[0][1]);
        O[0][0] = MFMA32(v01, p1, O[0][0]); O[0][1] = MFMA32(v11, p1, O[0][1]);
      }
      {
        float p[16];
#pragma unroll
        for (int r = 0; r < 16; ++r) { p[r] = __builtin_amdgcn_exp2f(Sb[r]); ls[1] += p[r]; }
        const bf16x8 p0 = pack8(p[0], p[1], p[2], p[3], p[4], p[5], p[6], p[7]), p1 = pack8(p[8], p[9], p[10], p[11], p[12], p[13], p[14], p[15]);
        O[1][0] = MFMA32(v00, p0, O[1][0]); O[1][1] = MFMA32(v10, p0, O[1][1]);
        O[1][0] = MFMA32(v01, p1, O[1][0]); O[1][1] = MFMA32(v11, p1, O[1][1]);
      }
    }
    if (kt + 1 < ntile) { *(uint4*)(sK + (cur ^ 1) * 5120 + (kc * 64 + kr) * 40 + kpart * 8) = rk; *(uint4*)(sV + (cur ^ 1) * 4608 + vdv * 72 + vpart * 8) = rv; }
    __syncthreads();
  }
  __builtin_amdgcn_s_setprio(0);
  ls[0] += shx(ls[0], 32); ls[1] += shx(ls[1], 32);
  const float i0 = 1.f / ls[0], i1 = lam / ls[1];
  float ss = 0.f;
#pragma unroll
  for (int dt = 0; dt < 2; ++dt)
#pragma unroll
    for (int r = 0; r < 16; ++r) { const float o = O[0][dt][r] * i0 - O[1][dt][r] * i1; O[0][dt][r] = o; ss += o * o; }
  ss += shx(ss, 32);
  const float rstd = rsqrtf(ss * (1.f / 64.f) + 1e-6f) * (1.f - lam_init);
  const size_t m = (qpos0 < 8192) ? (size_t)(b * T + qp) : (size_t)(MLAT + b * 256 + (qp - 8192));
  const u16* U = (const u16*)(P.ws + WS_U); u16* Y = (u16*)(P.ws + WS_XN);
#pragma unroll
  for (int dt = 0; dt < 2; ++dt)
#pragma unroll
    for (int q4 = 0; q4 < 4; ++q4) {
      const int d0 = dt * 32 + 8 * q4 + 4 * hh;
      const uint2 gv = *(const uint2*)(U + m * UP + UC_G + h * 64 + d0);
      const float4 nw = *(const float4*)(P.diff_subln_w + l * 64 + d0);
      const float y0 = O[0][dt][4 * q4 + 0] * rstd * nw.x * siluf(bflo(gv.x)), y1 = O[0][dt][4 * q4 + 1] * rstd * nw.y * siluf(bfhi(gv.x));
      const float y2 = O[0][dt][4 * q4 + 2] * rstd * nw.z * siluf(bflo(gv.y)), y3 = O[0][dt][4 * q4 + 3] * rstd * nw.w * siluf(bfhi(gv.y));
      uint2 ov; ov.x = pk2(y0, y1); ov.y = pk2(y2, y3);
      *(uint2*)(Y + m * 1024 + 512 + h * 64 + d0) = ov;
    }
  __syncthreads();
}

DI void phase_attn(const Params& P, int l, char* lds) {
  const int lane = tidx() & 63;
  const float lam_init = 0.8f - 0.6f * __expf(-0.3f * (float)l);
  float a = 0.f, bsum = 0.f;
  if (lane < 32) { const float* lv = gp(P.diff_lam + l * 128); a = lv[lane] * lv[32 + lane]; bsum = lv[64 + lane] * lv[96 + lane]; }
#pragma unroll
  for (int s = 32; s >= 1; s >>= 1) { a += shx(a, s); bsum += shx(bsum, s); }
  const float lam = __expf(a) - __expf(bsum) + lam_init;
  const int ntask = (l == 0) ? 264 : 256;
  for (int id0 = blockIdx.x; id0 < ntask; id0 += gridDim.x) {
    int tb, th, tq0, tk0, tn;
    if (id0 < 256) {
      const int id = (gridDim.x == 256) ? ((id0 & 7) * 32 + (id0 >> 3)) : id0;
      tb = id >> 7; th = (id >> 5) & 3; tq0 = (id & 31) * 256; tk0 = 0; tn = 132;
    } else {
      const int id = id0 - 256;
      tb = id >> 2; th = id & 3; tq0 = 8192; tk0 = 8192; tn = 4;
    }
    attn_tile(P, l, tb, th, tq0, tk0, tn, lam, lam_init, lds);
  }
}

#define XB_TMO      128
#define XB_XCNT(j)  (256  + 64 * (j))
#define XB_XSUB(j)  (1280 + 64 * (j))
#define XB_XGEN(j)  (2304 + 64 * (j))
#define XB_TOP      3328
#define XB_TOPGEN   3392
#define XCD_BAR_WORDS 3456
#define XB_SPIN_CAP (1u << 18)
#define LAS __attribute__((address_space(3)))
DI unsigned xb_ld(unsigned* p) { return __hip_atomic_load(p, __ATOMIC_RELAXED, __HIP_MEMORY_SCOPE_AGENT); }
DI unsigned xb_add(unsigned* p, unsigned v) { return __hip_atomic_fetch_add(p, v, __ATOMIC_RELAXED, __HIP_MEMORY_SCOPE_AGENT); }
DI unsigned xb_xcc_id() { return (unsigned)__builtin_amdgcn_s_getreg((3 << 11) | 20) & 0xFu; }
#define XB_SPIN(cond, bar) do { unsigned _sp = 0; while (cond) { __builtin_amdgcn_s_sleep(1); \
    if ((++_sp & 255u) == 0u) { if (xb_ld(&(bar)[XB_TMO])) break; if (_sp > XB_SPIN_CAP) { atomicAdd(&(bar)[XB_TMO], 1u); break; } } } } while (0)
struct XcdBarrier { unsigned* bar; unsigned x; volatile LAS unsigned* st; };
DI XcdBarrier xcd_barrier_post(unsigned* bar, volatile LAS unsigned* st) {
  XcdBarrier b; b.bar = bar; b.x = xb_xcc_id(); b.st = st;
  if (threadIdx.x == 0) (void)xb_add(&bar[XB_XCNT(b.x)], 1u);
  return b;
}
DI void xcd_barrier_complete(unsigned* bar, unsigned x, unsigned& nloc, unsigned& nx) {
  const unsigned G = gridDim.x * gridDim.y * gridDim.z;
  unsigned sum, cnt, mine, sp = 0u;
  for (;;) {
    sum = 0u; cnt = 0u; mine = 0u;
#pragma unroll
    for (unsigned j = 0; j < 16; ++j) { const unsigned c = xb_ld(&bar[XB_XCNT(j)]); sum += c; cnt += (c > 0u) ? 1u : 0u; mine = (j == x) ? c : mine; }
    if (sum == G) break;
    __builtin_amdgcn_s_sleep(1);
    if ((++sp & 255u) == 0u) { if (xb_ld(&bar[XB_TMO])) break; if (sp > XB_SPIN_CAP) { atomicAdd(&bar[XB_TMO], 1u); break; } }
  }
  nloc = mine > 0u ? mine : 1u; nx = cnt > 0u ? cnt : 1u;
}
DI void xcd_barrier(const XcdBarrier& b) {
  asm volatile("s_waitcnt vmcnt(0)" ::: "memory");
  __syncthreads();
  if (threadIdx.x == 0) {
    unsigned* bar = b.bar;
    __builtin_amdgcn_s_waitcnt(0);
    unsigned nloc = b.st[0], nx = b.st[1];
    if (nloc == 0u) { xcd_barrier_complete(bar, b.x, nloc, nx); b.st[0] = nloc; b.st[1] = nx; }
    const unsigned old = xb_add(&bar[XB_XSUB(b.x)], 1u);
    const unsigned gen = old / nloc;
    if (old + 1u == (gen + 1u) * nloc) {
      __builtin_amdgcn_fence(__ATOMIC_RELEASE, "agent");
      asm volatile("s_waitcnt vmcnt(0)" ::: "memory");
      const unsigned og = xb_add(&bar[XB_TOP], 1u);
      const unsigned tg = og / nx;
      if (og + 1u == (tg + 1u) * nx) xb_add(&bar[XB_TOPGEN], 1u);
      else XB_SPIN(xb_ld(&bar[XB_TOPGEN]) == tg, bar);
      __builtin_amdgcn_fence(__ATOMIC_ACQUIRE, "agent");
      xb_add(&bar[XB_XGEN(b.x)], 1u);
      asm volatile("s_waitcnt vmcnt(0)" ::: "memory");
    } else {
      XB_SPIN(xb_ld(&bar[XB_XGEN(b.x)]) == gen, bar);
      __builtin_amdgcn_fence(__ATOMIC_ACQUIRE, "agent");
      asm volatile("s_waitcnt vmcnt(0)" ::: "memory");
    }
  }
  __syncthreads();
}

__global__ void __launch_bounds__(NTHREADS) fwd_megakernel(Params Parg) {
  extern __shared__ __attribute__((aligned(16))) char lds[];
  __shared__ Params sP;
  __shared__ uint4 xb_words;
  if (threadIdx.x == 0) { sP = Parg; xb_words = make_uint4(0u, 0u, 0u, 0u); }
  __syncthreads();
  const Params& P = sP;
  cg::grid_group grid = cg::this_grid();
  if (blockDim.x == 12345u) grid.sync();
  (void)xcd_barrier_post((unsigned*)(Parg.ws + WS_BAR), (volatile LAS unsigned*)&xb_words);
#define GRID_BAR() do { XcdBarrier xb_; xb_.bar = (unsigned*)(P.ws + WS_BAR); xb_.x = xb_xcc_id(); xb_.st = (volatile LAS unsigned*)&xb_words; xcd_barrier(xb_); } while (0)
  MARK(0); phase_p0(P, lds);
  GRID_BAR();
#pragma unroll 1
  for (int l = 0; l < 2; ++l) {
    MARK(1); phase_norm(P, l);
    GRID_BAR(); MARK(2);
    gemm_phase<0>(P, l, (const u16*)(P.ws + WS_XN), (const u16*)(P.ws + WS_WINT) + (size_t)l * UP * 1024, 66, 25, lds);
    GRID_BAR();
    MARK(3);
    for (int t = blockIdx.x; t < 1056; t += gridDim.x) {
      const int ty = t / 264, idx = t % 264, b = idx / 132, cb = idx % 132;
      if (ty == 0) ssd_local(P, l, b, cb, lds);
      else if (ty == 1) lru_local(P, l, b, cb, lds);
      else if (ty == 2) gla_local(P, l, b, cb, lds);
      else attn_prep(P, l, idx, lds);
    }
    GRID_BAR();
    MARK(4); phase_scans(P);
    MARK(5); phase_attn(P, l, lds); MARK(6);
    GRID_BAR();
    {
      const int per = (l == 0) ? 264 : 256;
      for (int t = blockIdx.x; t < 3 * per; t += gridDim.x) {
        const int ty = t / per, idx = t % per;
        const int b = (l == 0) ? idx / 132 : (idx >> 7), cb = (l == 0) ? idx % 132 : 4 + (idx & 127);
        if (ty == 0) ssd_out(P, l, b, cb, lds);
        else if (ty == 1) lru_out(P, l, b, cb, lds);
        else gla_out(P, l, b, cb, lds);
      }
    }
    GRID_BAR();
    MARK(7); gemm_phase<1>(P, l, (const u16*)(P.ws + WS_XN), (const u16*)(P.ws + WS_WOUT) + (size_t)l * 1024 * 1024, l == 0 ? 66 : 64, 8, lds);
    GRID_BAR();
  }
  MARK(8); phase_final_norm(P);
}

extern "C" void kernel_launch(void* const* d_in, const int* in_sizes, int n_in, void* d_out, int out_size, void* d_ws, size_t ws_size, hipStream_t stream) {
  static int grid_blocks = 0;
  if (!grid_blocks) {
    int dev = 0, cus = 0, per_cu = 0;
    hipGetDevice(&dev);
    hipDeviceGetAttribute(&cus, hipDeviceAttributeMultiprocessorCount, dev);
    hipFuncSetAttribute((const void*)fwd_megakernel, hipFuncAttributeMaxDynamicSharedMemorySize, LDS_BYTES);
    hipOccupancyMaxActiveBlocksPerMultiprocessor(&per_cu, (const void*)fwd_megakernel, NTHREADS, LDS_BYTES);
    if (per_cu < 1) { fprintf(stderr, "occupancy query returned %d\n", per_cu); per_cu = 1; }
    if (per_cu > 1) per_cu = 1;
    grid_blocks = cus * per_cu;
  }
  Params p{};
  const float** pf = (const float**)&p;
  for (int i = 0; i < 28; ++i) pf[i] = (const float*)d_in[i];
  pf[28] = (const float*)d_out; pf[29] = (const float*)d_ws;
  hipMemsetAsync((char*)d_ws + WS_BAR, 0, XCD_BAR_WORDS * 4, stream);
  void* args[] = {&p};
  hipError_t e = hipLaunchCooperativeKernel((const void*)fwd_megakernel, dim3(grid_blocks), dim3(NTHREADS), args, LDS_BYTES, stream);
  if (e != hipSuccess) fprintf(stderr, "cooperative launch failed: %s (grid %d)\n", hipGetErrorString(e), grid_blocks);
}
```

```cpp
#include <hip/hip_runtime.h>
#include <hip/hip_cooperative_groups.h>
#include <cstdio>
namespace cg = cooperative_groups;

#define DI __device__ __forceinline__
typedef unsigned short u16;
typedef __attribute__((ext_vector_type(8))) short bf16x8;
typedef __attribute__((ext_vector_type(16))) float f32x16;
typedef __attribute__((ext_vector_type(4))) unsigned u32x4;
typedef __bf16 bf2_t __attribute__((ext_vector_type(2)));
typedef float fl2_t __attribute__((ext_vector_type(2)));

#define MARK(n) asm volatile("; MARK " #n)
#define MFMA32(a, b, c) __builtin_amdgcn_mfma_f32_32x32x16_bf16((a), (b), (c), 0, 0, 0)

constexpr int T = 8192, D = 1024, UP = 3200, MLAT = 16384, MTOT = 16896, NKEY = 8448, NCH = 132;
constexpr int UA_Q = 0, UA_K = 128, UA_V = 256, UA_LRF = 512, UA_G = 544;
constexpr int UB_X = 800, UB_G = 1056;
constexpr int UC_Q = 1312, UC_K = 1568, UC_V = 1824, UC_G = 2080;
constexpr int UD_XBC = 2336, UD_DTF = 2848, UD_Z = 2856;
constexpr int NTHREADS = 512;
constexpr int LDS_BYTES = 147456;

constexpr size_t WS_WINT = 0;
constexpr size_t WS_WOUT = WS_WINT + (size_t)2 * UP * 1024 * 2;
constexpr size_t WS_MOD = WS_WOUT + (size_t)2 * 1024 * 1024 * 2;
constexpr size_t WS_ROPE = WS_MOD + (size_t)2 * 3 * 3072 * 4;
constexpr size_t WS_MISC = WS_ROPE + 8192;
constexpr size_t WS_XN = WS_MISC + 4096;
constexpr size_t WS_U = WS_XN + (size_t)MTOT * 1024 * 2;
constexpr size_t WS_HCTX = WS_U + (size_t)MTOT * UP * 2;
constexpr size_t WS_Q = WS_HCTX + (size_t)512 * 1024 * 4;
constexpr size_t WS_K = WS_Q + (size_t)16 * NKEY * 32 * 2;
constexpr size_t WS_VT = WS_K + (size_t)16 * NKEY * 32 * 2;
constexpr size_t WS_GLA = WS_VT + (size_t)8 * 64 * NKEY * 2;
constexpr size_t WS_GLAD = WS_GLA + (size_t)16 * NCH * 2048 * 4;
constexpr size_t WS_SSD = WS_GLAD + (size_t)16 * NCH * 32 * 4;
constexpr size_t WS_SSDD = WS_SSD + (size_t)16 * NCH * 4096 * 4;
constexpr size_t WS_LRUA = WS_SSDD + 16384;
constexpr size_t WS_LRUU = WS_LRUA + (size_t)4 * NCH * 256 * 4;
constexpr size_t WS_BAR = WS_LRUU + (size_t)4 * NCH * 256 * 4;
constexpr size_t WS_LRUW = WS_BAR + 16384;
constexpr size_t WS_END = WS_LRUW + (size_t)64 * 4096 * 2;
static_assert(WS_END <= (size_t)256 * 1024 * 1024, "workspace");

#define GAS __attribute__((address_space(1)))
struct Params {
  const GAS float *x, *c, *ctx, *c_ctx, *w_mod, *b_mod, *norm_w, *w_in, *w_out, *gla_w2, *gla_b2, *gla_norm_w, *lru_conv_w, *lru_conv_b,
      *lru_wa, *lru_ba, *lru_wx, *lru_bx, *lru_lam, *diff_lam, *diff_subln_w, *ssd_conv_w, *ssd_conv_b, *ssd_dt_bias, *ssd_a_log, *ssd_d,
      *ssd_norm_w, *final_norm_w;
  GAS float* out;
  GAS unsigned char* ws;
};

DI unsigned pk2(float a, float b) { fl2_t v = {a, b}; return __builtin_bit_cast(unsigned, __builtin_convertvector(v, bf2_t)); }
DI u16 f2bf(float a) { return (u16)(pk2(a, 0.f) & 0xffffu); }
DI float bf2f(u16 x) { return __uint_as_float(((unsigned)x) << 16); }
DI float bflo(unsigned x) { return __uint_as_float(x << 16); }
DI float bfhi(unsigned x) { return __uint_as_float(x & 0xffff0000u); }
DI bf16x8 mk8(unsigned a, unsigned b, unsigned c, unsigned d) { u32x4 v = {a, b, c, d}; return __builtin_bit_cast(bf16x8, v); }
DI bf16x8 pack8(float a0, float a1, float a2, float a3, float a4, float a5, float a6, float a7) { return mk8(pk2(a0, a1), pk2(a2, a3), pk2(a4, a5), pk2(a6, a7)); }
template <class T> DI T* gp(GAS T* p) { return (T*)p; }
typedef __attribute__((ext_vector_type(4))) float f32x4_t;
DI float4 ld_nt(const float4* p) { const f32x4_t v = __builtin_nontemporal_load((const f32x4_t*)p); return make_float4(v.x, v.y, v.z, v.w); }
typedef __attribute__((ext_vector_type(4))) unsigned u32x4_nt;
DI uint4 ld_nt(const uint4* p) { const u32x4_nt v = __builtin_nontemporal_load((const u32x4_nt*)p); return make_uint4(v.x, v.y, v.z, v.w); }
DI float ld_nt(const float* p) { return __builtin_nontemporal_load(p); }
DI int tidx() { int t = threadIdx.x; asm volatile("" : "+v"(t)); return t; }
DI int crow(int r, int hh) { return (r & 3) + 8 * (r >> 2) + 4 * hh; }
DI float siluf(float x) { return x * __builtin_amdgcn_rcpf(1.f + __expf(-x)); }
DI float sigmf(float x) { return __builtin_amdgcn_rcpf(1.f + __expf(-x)); }
DI float softplusf(float x) { return fmaxf(x, 0.f) + __logf(1.f + __expf(-fabsf(x))); }
DI float shx(float v, int m) { return __shfl_xor(v, m, 64); }
DI int blk_m0(int b, int cb) { return cb < 4 ? MLAT + b * 256 + cb * 64 : b * T + (cb - 4) * 64; }
DI int blk_ci(int cb, int dir) { return dir == 0 ? cb : (cb < 4 ? 3 - cb : 135 - cb); }

DI void p0_transpose(const float* src, int N, u16* dst, int k0, int n0, float* lds) {
  const int tid = tidx();
  float v[8];
#pragma unroll
  for (int i = 0; i < 8; ++i) { const int e = tid + i * NTHREADS, kk = e >> 6, n = n0 + (e & 63); v[i] = (n < N) ? ld_nt(src + (size_t)(k0 + kk) * N + n) : 0.f; }
#pragma unroll
  for (int i = 0; i < 8; ++i) { const int e = tid + i * NTHREADS; lds[(e >> 6) * 65 + (e & 63)] = v[i]; }
  __syncthreads();
#pragma unroll
  for (int e = tid; e < 2048; e += NTHREADS) { int nn = e >> 5, kp = (e & 31) * 2; *(unsigned*)(dst + (size_t)(n0 + nn) * 1024 + k0 + kp) = pk2(lds[kp * 65 + nn], lds[(kp + 1) * 65 + nn]); }
  __syncthreads();
}

DI void p0_mod(const Params& P, int l, int n0, float* lds) {
  const int tid = tidx(), col = tid & 63, kg = tid >> 6;
  for (int e = tid; e < 1024; e += NTHREADS) { lds[e] = siluf(P.c[e]); lds[1024 + e] = siluf(P.c[1024 + e]); lds[2048 + e] = siluf(P.c_ctx[e]); }
  __syncthreads();
  float a0 = 0.f, a1 = 0.f, a2 = 0.f;
  const float* wm = gp(P.w_mod + (size_t)l * 1024 * 3072 + n0 + col);
  for (int k0 = kg * 128; k0 < kg * 128 + 128; k0 += 16) {
    float w[16];
#pragma unroll
    for (int j = 0; j < 16; ++j) w[j] = wm[(size_t)(k0 + j) * 3072];
#pragma unroll
    for (int j = 0; j < 16; ++j) { a0 += lds[k0 + j] * w[j]; a1 += lds[1024 + k0 + j] * w[j]; a2 += lds[2048 + k0 + j] * w[j]; }
  }
  float* red = lds + 3072;
  red[(kg * 3 + 0) * 64 + col] = a0; red[(kg * 3 + 1) * 64 + col] = a1; red[(kg * 3 + 2) * 64 + col] = a2;
  __syncthreads();
  if (tid < 192) {
    int j = tid >> 6; float sacc = P.b_mod[l * 3072 + n0 + col];
    for (int g = 0; g < 8; ++g) sacc += red[(g * 3 + j) * 64 + col];
    ((float*)(P.ws + WS_MOD))[(l * 3 + j) * 3072 + n0 + col] = sacc;
  }
  __syncthreads();
}

DI void phase_p0(const Params& P, char* lds) {
  float* fl = (float*)lds;
  for (int t0 = blockIdx.x; t0 < 2273; t0 += gridDim.x) {
    if (t0 >= 2209) {
      const int mid = t0 - 2209, gate = mid & 1, ldg = mid >> 1, tid = tidx();
      const float* wsrc = gp((gate ? P.lru_wx : P.lru_wa) + (size_t)ldg * 4096);
      const int lane = tid & 63, ct = (tid >> 6) & 1, ks = tid >> 7, c31 = lane & 31, hh = lane >> 5;
      float v[8];
#pragma unroll
      for (int e = 0; e < 8; ++e) v[e] = wsrc[(ks * 16 + hh * 8 + e) * 64 + ct * 32 + c31];
      uint4 o; o.x = pk2(v[0], v[1]); o.y = pk2(v[2], v[3]); o.z = pk2(v[4], v[5]); o.w = pk2(v[6], v[7]);
      *(uint4*)((u16*)(P.ws + WS_LRUW) + (size_t)mid * 4096 + tid * 8) = o;
      continue;
    }
    const int t = t0 < 96 ? 2112 + t0 : (t0 < 2208 ? t0 - 96 : t0);
    if (t < 1600) { int l = t / 800, rem = t % 800; p0_transpose(gp(P.w_in + (size_t)l * 1024 * 3112), 3112, (u16*)(P.ws + WS_WINT) + (size_t)l * UP * 1024, (rem & 15) * 64, (rem >> 4) * 64, fl); }
    else if (t < 2112) { int t2 = t - 1600; int l = t2 >> 8, rem = t2 & 255; p0_transpose(gp(P.w_out + (size_t)l * 1024 * 1024), 1024, (u16*)(P.ws + WS_WOUT) + (size_t)l * 1024 * 1024, (rem & 15) * 64, (rem >> 4) * 64, fl); }
    else if (t < 2208) { int t2 = t - 2112; p0_mod(P, t2 / 48, (t2 % 48) * 64, fl); }
    else {
      float* rope = (float*)(P.ws + WS_ROPE);
      const int tid = tidx();
      for (int e = tid; e < 1024; e += NTHREADS) { int pos = e >> 3, f = e & 7; float inv = exp2f(-(float)f * (13.287712379549449f / 8.f)); float ang = (float)pos * inv; rope[e] = __cosf(ang); rope[1024 + e] = __sinf(ang); }
      if (tid < 64) ((unsigned*)(P.ws + WS_MISC))[tid] = 0u;
    }
  }
}

DI const float* h_row(const Params& P, int l, int m) {
  if (l == 0) return gp(m < MLAT ? P.x + (size_t)m * 1024 : P.ctx + (size_t)(m - MLAT) * 1024);
  return m < MLAT ? (const float*)(P.out + (size_t)m * 1024) : (const float*)(P.ws + WS_HCTX) + (size_t)(m - MLAT) * 1024;
}

DI void phase_norm(const Params& P, int l) {
  const int tid_ = tidx(); const int w = tid_ >> 6, lane = tid_ & 63;
  u16* xn = (u16*)(P.ws + WS_XN);
  for (int row = blockIdx.x * 8 + w; row < MTOT; row += gridDim.x * 8) {
    const float4* src = (const float4*)h_row(P, l, row);
    const int j = row < MLAT ? (row >> 13) : 2;
    const float* mod = (const float*)(P.ws + WS_MOD) + (l * 3 + j) * 3072;
    float4 v[4]; float ss = 0.f;
#pragma unroll
    for (int i = 0; i < 4; ++i) { v[i] = ld_nt(src + i * 64 + lane); ss += v[i].x * v[i].x + v[i].y * v[i].y + v[i].z * v[i].z + v[i].w * v[i].w; }
#pragma unroll
    for (int s = 32; s >= 1; s >>= 1) ss += shx(ss, s);
    const float rstd = rsqrtf(ss * (1.f / 1024.f) + 1e-6f);
#pragma unroll
    for (int i = 0; i < 4; ++i) {
      const int k = (i * 64 + lane) * 4;
      float4 nw = *(const float4*)(P.norm_w + l * 1024 + k), sc = *(const float4*)(mod + 1024 + k), sh = *(const float4*)(mod + k);
      float y0 = v[i].x * rstd * nw.x * (1.f + sc.x) + sh.x, y1 = v[i].y * rstd * nw.y * (1.f + sc.y) + sh.y;
      float y2 = v[i].z * rstd * nw.z * (1.f + sc.z) + sh.z, y3 = v[i].w * rstd * nw.w * (1.f + sc.w) + sh.w;
      uint2 o; o.x = pk2(y0, y1); o.y = pk2(y2, y3);
      *(uint2*)(xn + (size_t)row * 1024 + k) = o;
    }
  }
}

DI void phase_final_norm(const Params& P) {
  const int tid_ = tidx(); const int w = tid_ >> 6, lane = tid_ & 63;
  for (int row = blockIdx.x * 8 + w; row < MLAT; row += gridDim.x * 8) {
    float4* src = (float4*)(P.out + (size_t)row * 1024);
    float4 v[4]; float ss = 0.f;
#pragma unroll
    for (int i = 0; i < 4; ++i) { v[i] = ld_nt(src + i * 64 + lane); ss += v[i].x * v[i].x + v[i].y * v[i].y + v[i].z * v[i].z + v[i].w * v[i].w; }
#pragma unroll
    for (int s = 32; s >= 1; s >>= 1) ss += shx(ss, s);
    const float rstd = rsqrtf(ss * (1.f / 1024.f) + 1e-6f);
#pragma unroll
    for (int i = 0; i < 4; ++i) {
      float4 nw = *(const float4*)(P.final_norm_w + (i * 64 + lane) * 4);
      float4 o; o.x = v[i].x * rstd * nw.x; o.y = v[i].y * rstd * nw.y; o.z = v[i].z * rstd * nw.z; o.w = v[i].w * rstd * nw.w;
      { const f32x4_t ov = {o.x, o.y, o.z, o.w}; __builtin_nontemporal_store(ov, (f32x4_t*)(src + i * 64 + lane)); }
    }
  }
}

constexpr int GS = 72;
template <int EPI>
DI void gemm_phase(const Params& P, int l, const u16* A, const u16* Bt, int mtiles, int ntiles, char* lds) {
  const int tid = tidx(), w = tid >> 6, lane = tid & 63, c31 = lane & 31, hh = lane >> 5, wm = w >> 1, wn = w & 1;
  const int lrow = tid >> 3, lcol = (tid & 7) * 8;
  const int ntot = mtiles * ntiles;
  const bool swz = (gridDim.x == 256);
  const int xcd = blockIdx.x & 7, jloc = blockIdx.x >> 3;
  const int per = (ntot + 7) >> 3, qbeg = xcd * per, qend = min(ntot, qbeg + per);
  for (int it = 0;; ++it) {
    int tm, tn;
    if (swz) {
      const int q = qbeg + jloc + 32 * it;
      if (q >= qend) break;
      const int band = q / (4 * ntiles), within = q - band * 4 * ntiles;
      const int rows = min(4, mtiles - band * 4);
      tn = within / rows; tm = band * 4 + (within - tn * rows);
    } else {
      const int tile = blockIdx.x + it * gridDim.x;
      if (tile >= ntot) break;
      tm = tile / ntiles; tn = tile % ntiles;
    }
    const int m0 = tm * 256, n0 = tn * 128;
    f32x16 acc[2][2];
#pragma unroll
    for (int i = 0; i < 2; ++i)
#pragma unroll
      for (int j = 0; j < 2; ++j)
#pragma unroll
        for (int r = 0; r < 16; ++r) acc[i][j][r] = 0.f;
    const u16* ga = A + (size_t)(m0 + lrow) * 1024 + lcol;
    const u16* gb = Bt + (size_t)(n0 + lrow) * 1024 + lcol;
    uint4 ra0, ra1, ra2, ra3, rb0, rb1, rc0, rc1, rc2, rc3, rd0, rd1;
#define G_LOAD(A0, A1, A2, A3, B0, B1, ko) { A0 = *(const uint4*)(ga + (ko)); A1 = *(const uint4*)(ga + (size_t)64 * 1024 + (ko)); A2 = *(const uint4*)(ga + (size_t)128 * 1024 + (ko)); A3 = *(const uint4*)(ga + (size_t)192 * 1024 + (ko)); \
      B0 = *(const uint4*)(gb + (ko)); B1 = *(const uint4*)(gb + (size_t)64 * 1024 + (ko)); }
#define G_STORE(A0, A1, A2, A3, B0, B1, buf) { u16* nA = (u16*)(lds + (buf) * 55296); u16* nB = (u16*)(lds + (buf) * 55296 + 36864); \
      *(uint4*)(nA + (lrow) * GS + lcol) = A0; *(uint4*)(nA + (lrow + 64) * GS + lcol) = A1; *(uint4*)(nA + (lrow + 128) * GS + lcol) = A2; *(uint4*)(nA + (lrow + 192) * GS + lcol) = A3; \
      *(uint4*)(nB + (lrow) * GS + lcol) = B0; *(uint4*)(nB + (lrow + 64) * GS + lcol) = B1; }
#define G_READ(buf) { const u16* sA = (const u16*)(lds + (buf) * 55296); const u16* sB = (const u16*)(lds + (buf) * 55296 + 36864); \
      _Pragma("unroll") for (int ks = 0; ks < 4; ++ks) { \
        af[ks][0] = *(const bf16x8*)(sA + (wm * 64 + c31) * GS + ks * 16 + hh * 8); af[ks][1] = *(const bf16x8*)(sA + (wm * 64 + 32 + c31) * GS + ks * 16 + hh * 8); \
        bfr[ks][0] = *(const bf16x8*)(sB + (wn * 64 + c31) * GS + ks * 16 + hh * 8); bfr[ks][1] = *(const bf16x8*)(sB + (wn * 64 + 32 + c31) * GS + ks * 16 + hh * 8); } \
      __builtin_amdgcn_sched_barrier(0); }
#define G_MMA() { __builtin_amdgcn_sched_barrier(0); \
      _Pragma("unroll") for (int ks = 0; ks < 4; ++ks) { \
        acc[0][0] = MFMA32(af[ks][0], bfr[ks][0], acc[0][0]); acc[0][1] = MFMA32(af[ks][0], bfr[ks][1], acc[0][1]); \
        acc[1][0] = MFMA32(af[ks][1], bfr[ks][0], acc[1][0]); acc[1][1] = MFMA32(af[ks][1], bfr[ks][1], acc[1][1]); } \
      __builtin_amdgcn_sched_barrier(0); }
    bf16x8 af[4][2], bfr[4][2];
#define S0 ra0, ra1, ra2, ra3, rb0, rb1
#define S1 rc0, rc1, rc2, rc3, rd0, rd1
#define GX(M, ...) M(__VA_ARGS__)
#define TK(t) (min((t), 15) * 64)
    if (w < 4) {
      GX(G_LOAD, S0, 0); GX(G_LOAD, S1, 64);
      GX(G_STORE, S0, 0); GX(G_STORE, S1, 1);
      GX(G_LOAD, S0, 128); GX(G_LOAD, S1, 192);
      __syncthreads();
      G_READ(0);
#pragma unroll 1
      for (int kt = 0; kt < 16; kt += 2) {
        G_MMA();
        __syncthreads();
        G_READ(1);
        if (kt + 2 < 16) GX(G_STORE, S0, 0);
        GX(G_LOAD, S0, TK(kt + 4));
        __syncthreads();
        G_MMA();
        __syncthreads();
        if (kt + 2 < 16) { G_READ(0); }
        if (kt + 3 < 16) GX(G_STORE, S1, 1);
        GX(G_LOAD, S1, TK(kt + 5));
        __syncthreads();
      }
    } else {
      GX(G_LOAD, S0, 0);
      GX(G_STORE, S0, 0);
      GX(G_LOAD, S1, 64); GX(G_LOAD, S0, 128);
      __syncthreads();
#pragma unroll 1
      for (int kt = 0; kt < 16; kt += 2) {
        G_READ(0);
        GX(G_STORE, S1, 1);
        GX(G_LOAD, S1, TK(kt + 3));
        __syncthreads();
        G_MMA();
        __syncthreads();
        G_READ(1);
        if (kt + 2 < 16) GX(G_STORE, S0, 0);
        GX(G_LOAD, S0, TK(kt + 4));
        __syncthreads();
        G_MMA();
        __syncthreads();
      }
    }
#undef GX
#undef S0
#undef S1
#undef TK
#undef G_READ
#undef G_MMA
#undef G_LOAD
#undef G_STORE
#undef G_COMPUTE
    if (EPI == 0) {
      u16* st = (u16*)(lds + 55296 + w * 9216);
#pragma unroll
      for (int i = 0; i < 2; ++i)
#pragma unroll
        for (int j = 0; j < 2; ++j)
#pragma unroll
          for (int r = 0; r < 16; ++r) st[(i * 32 + crow(r, hh)) * 72 + j * 32 + c31] = f2bf(acc[i][j][r]);
      u16* U = (u16*)(P.ws + WS_U) + (size_t)(m0 + wm * 64) * UP + n0 + wn * 64;
#pragma unroll
      for (int q = 0; q < 8; ++q) {
        const int idx = q * 64 + lane, row = idx >> 3, part = idx & 7;
        *(uint4*)(U + (size_t)row * UP + part * 8) = *(const uint4*)(st + row * 72 + part * 8);
      }
      __syncthreads();
    } else {
      float* st = (float*)(lds + w * 17408);
#pragma unroll
      for (int i = 0; i < 2; ++i)
#pragma unroll
        for (int j = 0; j < 2; ++j)
#pragma unroll
          for (int r = 0; r < 16; ++r) st[(i * 32 + crow(r, hh)) * 68 + j * 32 + c31] = acc[i][j][r];
      const int mrow0 = m0 + wm * 64, ncol = n0 + wn * 64 + (lane & 15) * 4;
      const int jm = mrow0 < MLAT ? (mrow0 >> 13) : 2;
      const float4 gate = *(const float4*)((const float*)(P.ws + WS_MOD) + (l * 3 + jm) * 3072 + 2048 + ncol);
#pragma unroll
      for (int half = 0; half < 2; ++half) {
        float4 hv[8];
#pragma unroll
        for (int q = 0; q < 8; ++q) { const int row = (half * 8 + q) * 4 + (lane >> 4); hv[q] = ld_nt((const float4*)(h_row(P, l, mrow0 + row) + ncol)); }
#pragma unroll
        for (int q = 0; q < 8; ++q) {
          const int row = (half * 8 + q) * 4 + (lane >> 4), m = mrow0 + row;
          const float4 a = *(const float4*)(st + row * 68 + (lane & 15) * 4);
          float4 o; o.x = hv[q].x + gate.x * a.x; o.y = hv[q].y + gate.y * a.y; o.z = hv[q].z + gate.z * a.z; o.w = hv[q].w + gate.w * a.w;
          float* dst = m < MLAT ? (float*)(P.out + (size_t)m * 1024 + ncol) : (float*)(P.ws + WS_HCTX) + (size_t)(m - MLAT) * 1024 + ncol;
          *(float4*)dst = o;
        }
      }
      __syncthreads();
    }
  }
}

DI void attn_prep(const Params& P, int l, int unit, char* lds) {
  const int tid = tidx(); const int gid = unit * NTHREADS + tid;
  const int m = gid >> 3, h = (gid >> 1) & 3, c = gid & 1;
  const u16* urow = (const u16*)(P.ws + WS_U) + (size_t)m * UP;
  float q[32], k[32];
  {
    const uint4* qs = (const uint4*)(urow + UC_Q + h * 64 + c * 32); const uint4* ks = (const uint4*)(urow + UC_K + h * 64 + c * 32);
#pragma unroll
    for (int i = 0; i < 4; ++i) {
      uint4 a = qs[i], b = ks[i];
      q[i * 8 + 0] = bflo(a.x); q[i * 8 + 1] = bfhi(a.x); q[i * 8 + 2] = bflo(a.y); q[i * 8 + 3] = bfhi(a.y); q[i * 8 + 4] = bflo(a.z); q[i * 8 + 5] = bfhi(a.z); q[i * 8 + 6] = bflo(a.w); q[i * 8 + 7] = bfhi(a.w);
      k[i * 8 + 0] = bflo(b.x); k[i * 8 + 1] = bfhi(b.x); k[i * 8 + 2] = bflo(b.y); k[i * 8 + 3] = bfhi(b.y); k[i * 8 + 4] = bflo(b.z); k[i * 8 + 5] = bfhi(b.z); k[i * 8 + 6] = bflo(b.w); k[i * 8 + 7] = bfhi(b.w);
    }
  }
  const bool lat = m < MLAT;
  const int b = lat ? (m >> 13) : ((m - MLAT) >> 8), t = lat ? (m & 8191) : ((m - MLAT) & 255);
  if (lat) {
    const float* rc = (const float*)(P.ws + WS_ROPE); const float* rs = rc + 1024;
#pragma unroll
    for (int a = 0; a < 2; ++a) {
      const int pos = a ? (t & 63) : (t >> 6);
#pragma unroll
      for (int f = 0; f < 8; ++f) {
        const float cs = rc[pos * 8 + f], sn = rs[pos * 8 + f];
        float x0 = q[a * 16 + f], x1 = q[a * 16 + 8 + f]; q[a * 16 + f] = x0 * cs - x1 * sn; q[a * 16 + 8 + f] = x1 * cs + x0 * sn;
        x0 = k[a * 16 + f]; x1 = k[a * 16 + 8 + f]; k[a * 16 + f] = x0 * cs - x1 * sn; k[a * 16 + 8 + f] = x1 * cs + x0 * sn;
      }
    }
  }
  const int pos = lat ? t : 8192 + t;
  const float QS = 0.17677669529663687f * 1.4426950408889634f;
  float k2 = 0.f;
  u16* qd = (u16*)(P.ws + WS_Q) + ((size_t)((b * 4 + h) * 2 + c) * NKEY + pos) * 32;
  u16* kd = (u16*)(P.ws + WS_K) + ((size_t)((b * 4 + h) * 2 + c) * NKEY + pos) * 32;
#pragma unroll
  for (int i = 0; i < 4; ++i) {
    uint4 a, bb;
    a.x = pk2(q[i * 8 + 0] * QS, q[i * 8 + 1] * QS); a.y = pk2(q[i * 8 + 2] * QS, q[i * 8 + 3] * QS); a.z = pk2(q[i * 8 + 4] * QS, q[i * 8 + 5] * QS); a.w = pk2(q[i * 8 + 6] * QS, q[i * 8 + 7] * QS);
    bb.x = pk2(k[i * 8 + 0], k[i * 8 + 1]); bb.y = pk2(k[i * 8 + 2], k[i * 8 + 3]); bb.z = pk2(k[i * 8 + 4], k[i * 8 + 5]); bb.w = pk2(k[i * 8 + 6], k[i * 8 + 7]);
    ((uint4*)qd)[i] = a; ((uint4*)kd)[i] = bb;
  }
#pragma unroll
  for (int i = 0; i < 32; ++i) k2 += k[i] * k[i];
  k2 = fmaxf(k2, shx(k2, 8)); k2 = fmaxf(k2, shx(k2, 16)); k2 = fmaxf(k2, shx(k2, 32));
  float* kred = (float*)(lds + 40960);
  if ((tid & 63) < 8) kred[(tid >> 6) * 8 + (tid & 7)] = k2;
  {
    u16* vt = (u16*)lds;
    const uint4* vs = (const uint4*)(urow + UC_V + h * 64 + c * 32);
    const int p64 = pos & 63, within = p64 & 15, hh = (within >> 2) & 1, jj = ((within >> 3) << 2) | (within & 3);
    const int col = (p64 & ~15) + 8 * hh + jj;
    u16* vd = vt + (h * 64 + c * 32) * 72 + col;
#pragma unroll
    for (int i = 0; i < 4; ++i) {
      uint4 a = vs[i];
      vd[(i * 8 + 0) * 72] = (u16)(a.x & 0xffff); vd[(i * 8 + 1) * 72] = (u16)(a.x >> 16);
      vd[(i * 8 + 2) * 72] = (u16)(a.y & 0xffff); vd[(i * 8 + 3) * 72] = (u16)(a.y >> 16);
      vd[(i * 8 + 4) * 72] = (u16)(a.z & 0xffff); vd[(i * 8 + 5) * 72] = (u16)(a.z >> 16);
      vd[(i * 8 + 6) * 72] = (u16)(a.w & 0xffff); vd[(i * 8 + 7) * 72] = (u16)(a.w >> 16);
    }
    __syncthreads();
    const int m0u = unit * 64;
    const int bu = m0u < MLAT ? (m0u >> 13) : ((m0u - MLAT) >> 8), pos0 = m0u < MLAT ? (m0u & 8191) : 8192 + ((m0u - MLAT) & 255);
    u16* Vg = (u16*)(P.ws + WS_VT) + (size_t)(bu * 4) * 64 * NKEY + pos0;
#pragma unroll
    for (int q = 0; q < 4; ++q) {
      const int idx = tid + q * NTHREADS, row = idx >> 3, part = idx & 7;
      *(uint4*)(Vg + (size_t)row * NKEY + part * 8) = *(const uint4*)(vt + row * 72 + part * 8);
    }
    if (tid < 8) {
      float mx = 0.f;
#pragma unroll
      for (int w8 = 0; w8 < 8; ++w8) mx = fmaxf(mx, kred[w8 * 8 + tid]);
      atomicMax((unsigned*)(P.ws + WS_MISC) + ((l * 2 + bu) * 4 + (tid >> 1)) * 2 + (tid & 1), __float_as_uint(mx));
    }
    __syncthreads();
  }
}

constexpr int QP = 136, GP = 129, GLA_SG = 2 * 64 * QP * 2 + 64 * 256 * 2, GLA_SLR = GLA_SG + 2 * 64 * GP * 4;
DI void gla_stage(const Params& P, int l, int b, int cb, char* lds) {
  u16* sq = (u16*)lds; u16* sk = sq + 64 * QP; u16* sv = sk + 64 * QP; float* sg = (float*)(lds + GLA_SG); float* slr = (float*)(lds + GLA_SLR);
  const int tid = tidx(), m0 = blk_m0(b, cb);
  const u16* U = (const u16*)(P.ws + WS_U);
#pragma unroll
  for (int e = tid; e < 1024; e += NTHREADS) {
    int t = e >> 4, part = e & 15; const u16* row = U + (size_t)(m0 + t) * UP;
    *(uint4*)(sq + t * QP + part * 8) = *(const uint4*)(row + UA_Q + part * 8);
    *(uint4*)(sk + t * QP + part * 8) = *(const uint4*)(row + UA_K + part * 8);
  }
#pragma unroll
  for (int e = tid; e < 2048; e += NTHREADS) { int t = e >> 5, part = e & 31; *(uint4*)(sv + t * 256 + part * 8) = *(const uint4*)(U + (size_t)(m0 + t) * UP + UA_V + part * 8); }
  {
    int t = tid >> 3, part = tid & 7;
    uint2 v = *(const uint2*)(U + (size_t)(m0 + t) * UP + UA_LRF + part * 4);
    int dir = part >> 2, r0 = (part & 3) * 4; float* d = slr + (dir * 64 + t) * 16 + r0;
    d[0] = bflo(v.x); d[1] = bfhi(v.x); d[2] = bflo(v.y); d[3] = bfhi(v.y);
  }
  __syncthreads();
  {
    const int hk = tid & 127, tq = tid >> 7;
#pragma unroll
    for (int dir = 0; dir < 2; ++dir) {
      float wv[16];
#pragma unroll
      for (int r = 0; r < 16; ++r) wv[r] = P.gla_w2[((l * 2 + dir) * 16 + r) * 128 + hk];
      const float bb = P.gla_b2[(l * 2 + dir) * 128 + hk];
      for (int t = tq; t < 64; t += 4) {
        const float* lr = slr + (dir * 64 + t) * 16; float z = bb;
#pragma unroll
        for (int r = 0; r < 16; ++r) z += lr[r] * wv[r];
        const float ls = fminf(z, 0.f) - __logf(1.f + __expf(-fabsf(z)));
        sg[(dir * 64 + t) * GP + hk] = ls * (1.f / 16.f);
      }
    }
  }
  __syncthreads();
  if (tid < 256) {
    const int dir = tid >> 7, hk = tid & 127; float s = 0.f;
    float* col = sg + dir * 64 * GP + hk; float v[64];
#pragma unroll
    for (int t = 0; t < 64; ++t) v[t] = col[t * GP];
    if (dir == 0) {
#pragma unroll
      for (int t = 0; t < 64; ++t) { s += v[t]; col[t * GP] = s; }
    } else {
#pragma unroll
      for (int t = 63; t >= 0; --t) { s += v[t]; col[t * GP] = s; }
    }
  }
  __syncthreads();
}

DI void gla_local(const Params& P, int l, int b, int cb, char* lds) {
  gla_stage(P, l, b, cb, lds);
  const u16* sk = (const u16*)lds + 64 * QP; const u16* sv = sk + 64 * QP; const float* sg = (const float*)(lds + GLA_SG);
  const int tid = tidx(), w = tid >> 6, lane = tid & 63, c31 = lane & 31, hh = lane >> 5, dir = w >> 2, h = w & 3;
  const float* g = sg + dir * 64 * GP;
  const float glast = g[(dir ? 0 : 63) * GP + h * 32 + c31];
  f32x16 acc[2];
#pragma unroll
  for (int r = 0; r < 16; ++r) { acc[0][r] = 0.f; acc[1][r] = 0.f; }
#pragma unroll
  for (int ks = 0; ks < 4; ++ks) {
    float av[8];
#pragma unroll
    for (int e = 0; e < 8; ++e) { const int j = ks * 16 + hh * 8 + e; av[e] = bf2f(sk[j * QP + h * 32 + c31]) * __expf(glast - g[j * GP + h * 32 + c31]); }
    const bf16x8 a = pack8(av[0], av[1], av[2], av[3], av[4], av[5], av[6], av[7]);
#pragma unroll
    for (int vt = 0; vt < 2; ++vt) {
      bf16x8 bv;
#pragma unroll
      for (int e = 0; e < 8; ++e) bv[e] = (short)sv[(ks * 16 + hh * 8 + e) * 256 + h * 64 + vt * 32 + c31];
      acc[vt] = MFMA32(a, bv, acc[vt]);
    }
  }
  const int seq = (b * 2 + dir) * 4 + h, ci = blk_ci(cb, dir);
  u16* dst = (u16*)(P.ws + WS_GLA) + (size_t)(seq * NCH + ci) * 2048;
#pragma unroll
  for (int vt = 0; vt < 2; ++vt)
#pragma unroll
    for (int r = 0; r < 16; ++r) dst[crow(r, hh) * 64 + vt * 32 + c31] = f2bf(acc[vt][r]);
  if (hh == 0) ((float*)(P.ws + WS_GLAD))[(seq * NCH + ci) * 32 + c31] = __expf(glast);
  __syncthreads();
}

DI void gla_out(const Params& P, int l, int b, int cb, char* lds) {
  gla_stage(P, l, b, cb, lds);
  const u16* sq = (const u16*)lds; const u16* sk = sq + 64 * QP; const u16* sv = sk + 64 * QP; const float* sg = (const float*)(lds + GLA_SG);
  const int tid = tidx(), w = tid >> 6, lane = tid & 63, c31 = lane & 31, hh = lane >> 5, dir = w >> 2, h = w & 3;
  const float* g = sg + dir * 64 * GP;
  const int seq = (b * 2 + dir) * 4 + h, ci = blk_ci(cb, dir), m0 = blk_m0(b, cb);
  const u16* Sin = (const u16*)(P.ws + WS_GLA) + (size_t)(seq * NCH + ci) * 2048;
  f32x16 o[2][2];
#pragma unroll
  for (int a = 0; a < 2; ++a)
#pragma unroll
    for (int bb = 0; bb < 2; ++bb)
#pragma unroll
      for (int r = 0; r < 16; ++r) o[a][bb][r] = 0.f;
  bf16x8 qg[2][2];
#pragma unroll
  for (int it = 0; it < 2; ++it)
#pragma unroll
    for (int ks = 0; ks < 2; ++ks) {
      float v[8]; const int i = it * 32 + c31;
#pragma unroll
      for (int e = 0; e < 8; ++e) { const int kk = h * 32 + ks * 16 + hh * 8 + e; v[e] = bf2f(sq[i * QP + kk]) * __expf(g[i * GP + kk]) * 0.17677669529663687f; }
      qg[it][ks] = pack8(v[0], v[1], v[2], v[3], v[4], v[5], v[6], v[7]);
    }
#pragma unroll
  for (int ks = 0; ks < 2; ++ks)
#pragma unroll
    for (int vt = 0; vt < 2; ++vt) {
      bf16x8 sa;
#pragma unroll
      for (int e = 0; e < 8; ++e) sa[e] = (short)Sin[(ks * 16 + hh * 8 + e) * 64 + vt * 32 + c31];
#pragma unroll
      for (int it = 0; it < 2; ++it) o[vt][it] = MFMA32(sa, qg[it][ks], o[vt][it]);
    }
#pragma unroll
  for (int jt = 0; jt < 2; ++jt) {
    bf16x8 kg[2];
#pragma unroll
    for (int ks = 0; ks < 2; ++ks) {
      float v[8]; const int j = jt * 32 + c31;
#pragma unroll
      for (int e = 0; e < 8; ++e) { const int kk = h * 32 + ks * 16 + hh * 8 + e; v[e] = bf2f(sk[j * QP + kk]) * __expf(-g[j * GP + kk]); }
      kg[ks] = pack8(v[0], v[1], v[2], v[3], v[4], v[5], v[6], v[7]);
    }
#pragma unroll
    for (int it = 0; it < 2; ++it) {
      const bool skip = dir == 0 ? (jt > it) : (jt < it);
      if (skip) continue;
      f32x16 s;
#pragma unroll
      for (int r = 0; r < 16; ++r) s[r] = 0.f;
      s = MFMA32(kg[0], qg[it][0], s); s = MFMA32(kg[1], qg[it][1], s);
      const int i = it * 32 + c31;
#pragma unroll
      for (int r = 0; r < 16; ++r) { const int j = jt * 32 + crow(r, hh); const bool keep = dir == 0 ? (j <= i) : (j >= i); s[r] = keep ? s[r] : 0.f; }
      const bf16x8 p0 = pack8(s[0], s[1], s[2], s[3], s[4], s[5], s[6], s[7]), p1 = pack8(s[8], s[9], s[10], s[11], s[12], s[13], s[14], s[15]);
#pragma unroll
      for (int s2 = 0; s2 < 2; ++s2)
#pragma unroll
        for (int vt = 0; vt < 2; ++vt) {
          bf16x8 va;
#pragma unroll
          for (int e = 0; e < 8; ++e) { const int j = jt * 32 + 16 * s2 + 8 * (e >> 2) + 4 * hh + (e & 3); va[e] = (short)sv[j * 256 + h * 64 + vt * 32 + c31]; }
          o[vt][it] = MFMA32(va, s2 ? p1 : p0, o[vt][it]);
        }
    }
  }
  __syncthreads();
  float* xb = (float*)(lds + GLA_SG);
  if (dir == 1) {
#pragma unroll
    for (int vt = 0; vt < 2; ++vt)
#pragma unroll
      for (int it = 0; it < 2; ++it)
#pragma unroll
        for (int r = 0; r < 16; ++r) xb[(it * 32 + c31) * 257 + h * 64 + vt * 32 + crow(r, hh)] = o[vt][it][r];
  }
  __syncthreads();
  if (dir == 0) {
#pragma unroll
    for (int vt = 0; vt < 2; ++vt)
#pragma unroll
      for (int it = 0; it < 2; ++it)
#pragma unroll
        for (int r = 0; r < 16; ++r) xb[(it * 32 + c31) * 257 + h * 64 + vt * 32 + crow(r, hh)] += o[vt][it][r];
  }
  __syncthreads();
  {
    const u16* U = (const u16*)(P.ws + WS_U); u16* Y = (u16*)(P.ws + WS_XN);
#pragma unroll
    for (int q = 0; q < 4; ++q) {
      const int idx = tid + q * NTHREADS, row = idx >> 5, ch0 = (idx & 31) * 8; const size_t m = (size_t)(m0 + row);
      const uint4 gv = ld_nt((const uint4*)(U + m * UP + UA_G + ch0));
      float v[8]; float ss = 0.f;
#pragma unroll
      for (int e = 0; e < 8; ++e) { v[e] = xb[row * 257 + ch0 + e]; ss += v[e] * v[e]; }
      ss += shx(ss, 1); ss += shx(ss, 2); ss += shx(ss, 4);
      const float rstd = rsqrtf(ss * (1.f / 64.f) + 1e-6f);
      const float4 n0 = *(const float4*)(P.gla_norm_w + l * 64 + (ch0 & 63)), n1 = *(const float4*)(P.gla_norm_w + l * 64 + (ch0 & 63) + 4);
      uint4 ov;
      ov.x = pk2(v[0] * rstd * n0.x * siluf(bflo(gv.x)), v[1] * rstd * n0.y * siluf(bfhi(gv.x)));
      ov.y = pk2(v[2] * rstd * n0.z * siluf(bflo(gv.y)), v[3] * rstd * n0.w * siluf(bfhi(gv.y)));
      ov.z = pk2(v[4] * rstd * n1.x * siluf(bflo(gv.z)), v[5] * rstd * n1.y * siluf(bfhi(gv.z)));
      ov.w = pk2(v[6] * rstd * n1.z * siluf(bflo(gv.w)), v[7] * rstd * n1.w * siluf(bfhi(gv.w)));
      *(uint4*)(Y + m * 1024 + ch0) = ov;
    }
  }
  __syncthreads();
}

constexpr int SXP = 520;
DI void ssd_stage(const Params& P, int l, int b, int cb, char* lds) {
  u16* sx = (u16*)lds; float* scum = (float*)(lds + 132352); float* sdt = scum + 512;
  const int tid = tidx(), m0 = blk_m0(b, cb);
  const u16* U = (const u16*)(P.ws + WS_U);
  const int tseq0 = cb < 4 ? cb * 64 : (cb - 4) * 64, slen = cb < 4 ? 256 : T, mseq0 = cb < 4 ? MLAT + b * 256 : b * T;
  {
    const int ch0 = (tid & 63) * 8;
    float wt[4][8], bs[8];
    { const float4 b0 = *(const float4*)(P.ssd_conv_b + l * 512 + ch0), b1 = *(const float4*)(P.ssd_conv_b + l * 512 + ch0 + 4);
      bs[0] = b0.x; bs[1] = b0.y; bs[2] = b0.z; bs[3] = b0.w; bs[4] = b1.x; bs[5] = b1.y; bs[6] = b1.z; bs[7] = b1.w; }
#pragma unroll
    for (int j = 0; j < 4; ++j) {
      const float* wj = gp(P.ssd_conv_w + (l * 4 + j) * 512 + ch0); const float4 w0 = *(const float4*)wj, w1 = *(const float4*)(wj + 4);
      wt[j][0] = w0.x; wt[j][1] = w0.y; wt[j][2] = w0.z; wt[j][3] = w0.w; wt[j][4] = w1.x; wt[j][5] = w1.y; wt[j][6] = w1.z; wt[j][7] = w1.w;
    }
#pragma unroll 2
    for (int t = tid >> 6; t < 64; t += 8) {
      float acc[8];
#pragma unroll
      for (int i = 0; i < 8; ++i) acc[i] = bs[i];
#pragma unroll
      for (int j = 0; j < 4; ++j) {
        const int ts = tseq0 + t - 2 + j;
        if (ts >= 0 && ts < slen) {
          const uint4 v = *(const uint4*)(U + (size_t)(mseq0 + ts) * UP + UD_XBC + ch0);
          acc[0] += bflo(v.x) * wt[j][0]; acc[1] += bfhi(v.x) * wt[j][1]; acc[2] += bflo(v.y) * wt[j][2]; acc[3] += bfhi(v.y) * wt[j][3];
          acc[4] += bflo(v.z) * wt[j][4]; acc[5] += bfhi(v.z) * wt[j][5]; acc[6] += bflo(v.w) * wt[j][6]; acc[7] += bfhi(v.w) * wt[j][7];
        }
      }
      uint4 o; o.x = pk2(siluf(acc[0]), siluf(acc[1])); o.y = pk2(siluf(acc[2]), siluf(acc[3])); o.z = pk2(siluf(acc[4]), siluf(acc[5])); o.w = pk2(siluf(acc[6]), siluf(acc[7]));
      *(uint4*)(sx + t * SXP + ch0) = o;
    }
  }
  {
    const int dir = tid >> 8, t = (tid >> 2) & 63, hd = tid & 3;
    const float raw = bf2f(U[(size_t)(m0 + t) * UP + UD_DTF + dir * 4 + hd]);
    const float dt = softplusf(raw + P.ssd_dt_bias[(l * 2 + dir) * 4 + hd]);
    const float a = -__expf(P.ssd_a_log[(l * 2 + dir) * 4 + hd]);
    sdt[(dir * 64 + t) * 4 + hd] = dt; scum[(dir * 64 + t) * 4 + hd] = dt * a;
  }
  __syncthreads();
  if (tid < 8) {
    const int dir = tid >> 2, hd = tid & 3; float s = 0.f;
    float* col = scum + dir * 256 + hd; float v[64];
#pragma unroll
    for (int t = 0; t < 64; ++t) v[t] = col[t * 4];
    if (dir == 0) {
#pragma unroll
      for (int t = 0; t < 64; ++t) { s += v[t]; col[t * 4] = s; }
    } else {
#pragma unroll
      for (int t = 63; t >= 0; --t) { s += v[t]; col[t * 4] = s; }
    }
  }
  __syncthreads();
}

DI void ssd_local(const Params& P, int l, int b, int cb, char* lds) {
  ssd_stage(P, l, b, cb, lds);
  const u16* sx = (const u16*)lds; const float* scum = (const float*)(lds + 132352); const float* sdt = scum + 512;
  const int tid = tidx(), w = tid >> 6, lane = tid & 63, c31 = lane & 31, hh = lane >> 5, dir = w >> 2, h = w & 3, grp = h >> 1;
  const float cl = scum[(dir * 64 + (dir ? 0 : 63)) * 4 + h];
  f32x16 acc[2][2];
#pragma unroll
  for (int a = 0; a < 2; ++a)
#pragma unroll
    for (int bb = 0; bb < 2; ++bb)
#pragma unroll
      for (int r = 0; r < 16; ++r) acc[a][bb][r] = 0.f;
#pragma unroll
  for (int ks = 0; ks < 4; ++ks) {
    float wgt[8];
#pragma unroll
    for (int e = 0; e < 8; ++e) { const int s = ks * 16 + hh * 8 + e; wgt[e] = __expf(cl - scum[(dir * 64 + s) * 4 + h]) * sdt[(dir * 64 + s) * 4 + h]; }
    bf16x8 bn[2];
#pragma unroll
    for (int nt = 0; nt < 2; ++nt)
#pragma unroll
      for (int e = 0; e < 8; ++e) bn[nt][e] = (short)sx[(ks * 16 + hh * 8 + e) * SXP + 256 + grp * 64 + nt * 32 + c31];
#pragma unroll
    for (int pt = 0; pt < 2; ++pt) {
      float v[8];
#pragma unroll
      for (int e = 0; e < 8; ++e) v[e] = bf2f(sx[(ks * 16 + hh * 8 + e) * SXP + h * 64 + pt * 32 + c31]) * wgt[e];
      const bf16x8 a = pack8(v[0], v[1], v[2], v[3], v[4], v[5], v[6], v[7]);
#pragma unroll
      for (int nt = 0; nt < 2; ++nt) acc[pt][nt] = MFMA32(a, bn[nt], acc[pt][nt]);
    }
  }
  const int seq = (b * 2 + dir) * 4 + h, ci = blk_ci(cb, dir);
  u16* dst = (u16*)(P.ws + WS_SSD) + (size_t)(seq * NCH + ci) * 4096;
#pragma unroll
  for (int pt = 0; pt < 2; ++pt)
#pragma unroll
    for (int nt = 0; nt < 2; ++nt)
#pragma unroll
      for (int r = 0; r < 16; ++r) dst[(pt * 32 + crow(r, hh)) * 64 + nt * 32 + c31] = f2bf(acc[pt][nt][r]);
  if (lane == 0) ((float*)(P.ws + WS_SSDD))[seq * NCH + ci] = __expf(cl);
  __syncthreads();
}

DI void ssd_out(const Params& P, int l, int b, int cb, char* lds) {
  ssd_stage(P, l, b, cb, lds);
  const u16* sx = (const u16*)lds; float* xb = (float*)(lds + 66560); const float* scum = (const float*)(lds + 132352); const float* sdt = scum + 512; float* ssq = (float*)(lds + 136448);
  const int tid = tidx(), w = tid >> 6, lane = tid & 63, c31 = lane & 31, hh = lane >> 5, dir = w >> 2, h = w & 3, grp = h >> 1;
  const int seq = (b * 2 + dir) * 4 + h, ci = blk_ci(cb, dir), m0 = blk_m0(b, cb);
  const u16* Sin = (const u16*)(P.ws + WS_SSD) + (size_t)(seq * NCH + ci) * 4096;
  f32x16 y[2][2];
#pragma unroll
  for (int a = 0; a < 2; ++a)
#pragma unroll
    for (int bb = 0; bb < 2; ++bb)
#pragma unroll
      for (int r = 0; r < 16; ++r) y[a][bb][r] = 0.f;
#pragma unroll
  for (int lt = 0; lt < 2; ++lt) {
    const int tl = lt * 32 + c31;
    const float cuml = scum[(dir * 64 + tl) * 4 + h];
    const float ecl = __expf(cuml);
#pragma unroll
    for (int ks = 0; ks < 4; ++ks) {
      const uint4 cv = *(const uint4*)(sx + tl * SXP + 384 + grp * 64 + ks * 16 + hh * 8);
      const bf16x8 cmf = pack8(bflo(cv.x) * ecl, bfhi(cv.x) * ecl, bflo(cv.y) * ecl, bfhi(cv.y) * ecl, bflo(cv.z) * ecl, bfhi(cv.z) * ecl, bflo(cv.w) * ecl, bfhi(cv.w) * ecl);
#pragma unroll
      for (int pt = 0; pt < 2; ++pt) {
        const uint4 sraw = ld_nt((const uint4*)(Sin + (pt * 32 + c31) * 64 + ks * 16 + hh * 8)); const bf16x8 sa = mk8(sraw.x, sraw.y, sraw.z, sraw.w);
        y[pt][lt] = MFMA32(sa, cmf, y[pt][lt]);
      }
    }
#pragma unroll
    for (int st = 0; st < 2; ++st) {
      const bool skip = dir == 0 ? (st > lt) : (st < lt);
      if (skip) continue;
      f32x16 cbt;
#pragma unroll
      for (int r = 0; r < 16; ++r) cbt[r] = 0.f;
#pragma unroll
      for (int ks = 0; ks < 4; ++ks) {
        const bf16x8 bmf = *(const bf16x8*)(sx + (st * 32 + c31) * SXP + 256 + grp * 64 + ks * 16 + hh * 8);
        const bf16x8 cmf = *(const bf16x8*)(sx + tl * SXP + 384 + grp * 64 + ks * 16 + hh * 8);
        cbt = MFMA32(bmf, cmf, cbt);
      }
#pragma unroll
      for (int r = 0; r < 16; ++r) {
        const int s = st * 32 + crow(r, hh); const bool keep = dir == 0 ? (s <= tl) : (s >= tl);
        const float dec = __expf(fminf(cuml - scum[(dir * 64 + s) * 4 + h], 0.f)) * sdt[(dir * 64 + s) * 4 + h];
        cbt[r] = keep ? cbt[r] * dec : 0.f;
      }
      const bf16x8 p0 = pack8(cbt[0], cbt[1], cbt[2], cbt[3], cbt[4], cbt[5], cbt[6], cbt[7]), p1 = pack8(cbt[8], cbt[9], cbt[10], cbt[11], cbt[12], cbt[13], cbt[14], cbt[15]);
#pragma unroll
      for (int s2 = 0; s2 < 2; ++s2)
#pragma unroll
        for (int pt = 0; pt < 2; ++pt) {
          bf16x8 xa;
#pragma unroll
          for (int e = 0; e < 8; ++e) { const int s = st * 32 + 16 * s2 + 8 * (e >> 2) + 4 * hh + (e & 3); xa[e] = (short)sx[s * SXP + h * 64 + pt * 32 + c31]; }
          y[pt][lt] = MFMA32(xa, s2 ? p1 : p0, y[pt][lt]);
        }
    }
  }
  if (dir == 1) {
#pragma unroll
    for (int pt = 0; pt < 2; ++pt)
#pragma unroll
      for (int lt = 0; lt < 2; ++lt)
#pragma unroll
        for (int r = 0; r < 16; ++r) xb[(lt * 32 + c31) * 257 + h * 64 + pt * 32 + crow(r, hh)] = y[pt][lt][r];
  }
  __syncthreads();
  if (dir == 0) {
    const float dsk = P.ssd_d[l * 4 + h];
#pragma unroll
    for (int lt = 0; lt < 2; ++lt) {
      const int tl = lt * 32 + c31;
#pragma unroll
      for (int pt = 0; pt < 2; ++pt)
#pragma unroll
        for (int r = 0; r < 16; ++r) {
          const int p = pt * 32 + crow(r, hh);
          xb[tl * 257 + h * 64 + p] += y[pt][lt][r] + dsk * bf2f(sx[tl * SXP + h * 64 + p]);
        }
    }
  }
  __syncthreads();
  {
    const u16* U = (const u16*)(P.ws + WS_U); u16* Y = (u16*)(P.ws + WS_XN);
#pragma unroll
    for (int q = 0; q < 4; ++q) {
      const int idx = tid + q * NTHREADS, row = idx >> 5, ch0 = (idx & 31) * 8; const size_t m = (size_t)(m0 + row);
      const uint4 zv = ld_nt((const uint4*)(U + m * UP + UD_Z + ch0));
      const float zz[8] = {bflo(zv.x), bfhi(zv.x), bflo(zv.y), bfhi(zv.y), bflo(zv.z), bfhi(zv.z), bflo(zv.w), bfhi(zv.w)};
      float v[8]; float ss = 0.f;
#pragma unroll
      for (int e = 0; e < 8; ++e) { v[e] = xb[row * 257 + ch0 + e] * siluf(zz[e]); ss += v[e] * v[e]; }
      ss += shx(ss, 1); ss += shx(ss, 2); ss += shx(ss, 4); ss += shx(ss, 8); ss += shx(ss, 16);
      const float rstd = rsqrtf(ss * (1.f / 256.f) + 1e-6f);
      const float4 n0 = *(const float4*)(P.ssd_norm_w + l * 256 + ch0), n1 = *(const float4*)(P.ssd_norm_w + l * 256 + ch0 + 4);
      uint4 ov;
      ov.x = pk2(v[0] * rstd * n0.x, v[1] * rstd * n0.y); ov.y = pk2(v[2] * rstd * n0.z, v[3] * rstd * n0.w);
      ov.z = pk2(v[4] * rstd * n1.x, v[5] * rstd * n1.y); ov.w = pk2(v[6] * rstd * n1.z, v[7] * rstd * n1.w);
      *(uint4*)(Y + m * 1024 + 768 + ch0) = ov;
    }
  }
  __syncthreads();
}

constexpr int LXP = 264;
DI float neg_expm1f(float x) { return x > -0.01f ? -x * (1.f + x * (0.5f + x * (1.f / 6.f))) : 1.f - __expf(x); }

DI void lru_stage(const Params& P, int l, int b, int cb, char* lds) {
  u16* sxc = (u16*)lds;
  const int tid = tidx();
  const u16* U = (const u16*)(P.ws + WS_U);
  const int tseq0 = cb < 4 ? cb * 64 : (cb - 4) * 64, slen = cb < 4 ? 256 : T, mseq0 = cb < 4 ? MLAT + b * 256 : b * T;
  {
    const int ch0 = (tid & 31) * 8;
    float wt[4][8], bs[8];
    { const float4 b0 = *(const float4*)(P.lru_conv_b + l * 256 + ch0), b1 = *(const float4*)(P.lru_conv_b + l * 256 + ch0 + 4);
      bs[0] = b0.x; bs[1] = b0.y; bs[2] = b0.z; bs[3] = b0.w; bs[4] = b1.x; bs[5] = b1.y; bs[6] = b1.z; bs[7] = b1.w; }
#pragma unroll
    for (int j = 0; j < 4; ++j) {
      const float* wj = gp(P.lru_conv_w + (l * 4 + j) * 256 + ch0); const float4 w0 = *(const float4*)wj, w1 = *(const float4*)(wj + 4);
      wt[j][0] = w0.x; wt[j][1] = w0.y; wt[j][2] = w0.z; wt[j][3] = w0.w; wt[j][4] = w1.x; wt[j][5] = w1.y; wt[j][6] = w1.z; wt[j][7] = w1.w;
    }
#pragma unroll 2
    for (int t = tid >> 5; t < 64; t += 16) {
      float acc[8];
#pragma unroll
      for (int i = 0; i < 8; ++i) acc[i] = bs[i];
#pragma unroll
      for (int j = 0; j < 4; ++j) {
        const int ts = tseq0 + t - 2 + j;
        if (ts >= 0 && ts < slen) {
          const uint4 v = *(const uint4*)(U + (size_t)(mseq0 + ts) * UP + UB_X + ch0);
          acc[0] += bflo(v.x) * wt[j][0]; acc[1] += bfhi(v.x) * wt[j][1]; acc[2] += bflo(v.y) * wt[j][2]; acc[3] += bfhi(v.y) * wt[j][3];
          acc[4] += bflo(v.z) * wt[j][4]; acc[5] += bfhi(v.z) * wt[j][5]; acc[6] += bflo(v.w) * wt[j][6]; acc[7] += bfhi(v.w) * wt[j][7];
        }
      }
      uint4 o; o.x = pk2(acc[0], acc[1]); o.y = pk2(acc[2], acc[3]); o.z = pk2(acc[4], acc[5]); o.w = pk2(acc[6], acc[7]);
      *(uint4*)(sxc + t * LXP + ch0) = o;
    }
  }
  __syncthreads();
}

DI void lru_gates(const Params& P, int l, int dir, int g, int ct, const u16* sxc, f32x16 (&av)[2], f32x16 (&uv)[2]) {
  const int lane = tidx() & 63, c31 = lane & 31, hh = lane >> 5;
#pragma unroll
  for (int a = 0; a < 2; ++a)
#pragma unroll
    for (int r = 0; r < 16; ++r) { av[a][r] = 0.f; uv[a][r] = 0.f; }
  const u16* wfa_p = (const u16*)(P.ws + WS_LRUW) + (size_t)((((l * 2 + dir) * 4 + g) * 2 + 0) * 4096) + (ct * 64 + lane) * 8;
  const u16* wfx_p = wfa_p + 4096;
#pragma unroll
  for (int ks = 0; ks < 4; ++ks) {
    const bf16x8 wfa = *(const bf16x8*)(wfa_p + ks * 1024), wfx = *(const bf16x8*)(wfx_p + ks * 1024);
#pragma unroll
    for (int tt = 0; tt < 2; ++tt) {
      const bf16x8 xa = *(const bf16x8*)(sxc + (tt * 32 + c31) * LXP + g * 64 + ks * 16 + hh * 8);
      av[tt] = MFMA32(xa, wfa, av[tt]); uv[tt] = MFMA32(xa, wfx, uv[tt]);
    }
  }
  const int ch = g * 64 + ct * 32 + c31;
  const float ba = P.lru_ba[(l * 2 + dir) * 256 + ch], bx = P.lru_bx[(l * 2 + dir) * 256 + ch];
  const float sp = softplusf(-P.lru_lam[(l * 2 + dir) * 256 + ch]);
#pragma unroll
  for (int tt = 0; tt < 2; ++tt)
#pragma unroll
    for (int r = 0; r < 16; ++r) {
      const float rg = sigmf(av[tt][r] + ba), ig = sigmf(uv[tt][r] + bx);
      const float la = -8.f * rg * sp;
      const float xv = bf2f(sxc[(tt * 32 + crow(r, hh)) * LXP + ch]);
      av[tt][r] = __expf(la);
      uv[tt][r] = __builtin_amdgcn_sqrtf(neg_expm1f(2.f * la)) * ig * xv;
    }
}

template <int REV>
DI void lru_scan(f32x16 (&av)[2], f32x16 (&uv)[2], float& hc, float& ap) {
  const int hh = (tidx() & 63) >> 5;
  const bool first = (hh == (REV ? 1 : 0));
  ap = 1.f;
#pragma unroll
  for (int tti = 0; tti < 2; ++tti) {
    const int tt = REV ? 1 - tti : tti;
#pragma unroll
    for (int ii = 0; ii < 4; ++ii) {
      const int i = REV ? 3 - ii : ii;
      float GA = 1.f, GU = 0.f;
#pragma unroll
      for (int ee = 0; ee < 4; ++ee) { const int r = 4 * i + (REV ? 3 - ee : ee); GU = av[tt][r] * GU + uv[tt][r]; GA *= av[tt][r]; }
      const float PA = shx(GA, 32), PU = shx(GU, 32);
      float hcur = first ? hc : PA * hc + PU;
#pragma unroll
      for (int ee = 0; ee < 4; ++ee) { const int r = 4 * i + (REV ? 3 - ee : ee); hcur = av[tt][r] * hcur + uv[tt][r]; uv[tt][r] = hcur; }
      const float pairA = GA * PA, pairU = first ? PA * GU + PU : GA * PU + GU;
      hc = pairA * hc + pairU; ap *= pairA;
    }
  }
}

DI void lru_local(const Params& P, int l, int b, int cb, char* lds) {
  lru_stage(P, l, b, cb, lds);
  const int tid = tidx(), w = tid >> 6, lane = tid & 63, c31 = lane & 31, hh = lane >> 5, dir = w >> 2, g = w & 3;
  const int ci = blk_ci(cb, dir);
#pragma unroll 1
  for (int ct = 0; ct < 2; ++ct) {
    f32x16 av[2], uv[2];
    lru_gates(P, l, dir, g, ct, (const u16*)lds, av, uv);
    float hc = 0.f, ap;
    if (dir) lru_scan<1>(av, uv, hc, ap); else lru_scan<0>(av, uv, hc, ap);
    if (hh == 0) {
      const int ch = g * 64 + ct * 32 + c31;
      ((float*)(P.ws + WS_LRUA))[((b * 2 + dir) * NCH + ci) * 256 + ch] = ap;
      ((float*)(P.ws + WS_LRUU))[((b * 2 + dir) * NCH + ci) * 256 + ch] = hc;
    }
  }
  __syncthreads();
}

DI void lru_out(const Params& P, int l, int b, int cb, char* lds) {
  lru_stage(P, l, b, cb, lds);
  const int tid = tidx(), w = tid >> 6, lane = tid & 63, c31 = lane & 31, hh = lane >> 5, dir = w >> 2, g = w & 3;
  const int ci = blk_ci(cb, dir), m0 = blk_m0(b, cb);
  float* xb = (float*)(lds + 34816);
  f32x16 hres[2][2];
#pragma unroll
  for (int ct = 0; ct < 2; ++ct) {
    f32x16 av[2], uv[2];
    lru_gates(P, l, dir, g, ct, (const u16*)lds, av, uv);
    float hc = ((const float*)(P.ws + WS_LRUU))[((b * 2 + dir) * NCH + ci) * 256 + g * 64 + ct * 32 + c31], ap;
    if (dir) lru_scan<1>(av, uv, hc, ap); else lru_scan<0>(av, uv, hc, ap);
    if (dir == 1) {
#pragma unroll
      for (int tt = 0; tt < 2; ++tt)
#pragma unroll
        for (int r = 0; r < 16; ++r) xb[(tt * 32 + crow(r, hh)) * 257 + g * 64 + ct * 32 + c31] = uv[tt][r];
    }
    hres[ct][0] = uv[0]; hres[ct][1] = uv[1];
  }
  __syncthreads();
  if (dir == 0) {
#pragma unroll
    for (int ct = 0; ct < 2; ++ct)
#pragma unroll
      for (int tt = 0; tt < 2; ++tt)
#pragma unroll
        for (int r = 0; r < 16; ++r) xb[(tt * 32 + crow(r, hh)) * 257 + g * 64 + ct * 32 + c31] += hres[ct][tt][r];
  }
  __syncthreads();
  {
    const u16* U = (const u16*)(P.ws + WS_U); u16* Y = (u16*)(P.ws + WS_XN);
#pragma unroll
    for (int q = 0; q < 4; ++q) {
      const int idx = tid + q * NTHREADS, row = idx >> 5, ch0 = (idx & 31) * 8; const size_t m = (size_t)(m0 + row);
      const uint4 gv = ld_nt((const uint4*)(U + m * UP + UB_G + ch0));
      const float* xr = xb + row * 257 + ch0;
      uint4 ov;
      ov.x = pk2(xr[0] * siluf(bflo(gv.x)), xr[1] * siluf(bfhi(gv.x))); ov.y = pk2(xr[2] * siluf(bflo(gv.y)), xr[3] * siluf(bfhi(gv.y)));
      ov.z = pk2(xr[4] * siluf(bflo(gv.z)), xr[5] * siluf(bfhi(gv.z))); ov.w = pk2(xr[6] * siluf(bflo(gv.w)), xr[7] * siluf(bfhi(gv.w)));
      *(uint4*)(Y + m * 1024 + 256 + ch0) = ov;
    }
  }
  __syncthreads();
}

template <int PS, int DS>
DI void scan_bf16(u16* p, const float* d) {
  float s = 0.f;
  u16 ua[12], ub[12]; float da[12], db[12];
#pragma unroll
  for (int j = 0; j < 12; ++j) { ua[j] = p[(size_t)j * PS]; da[j] = d[j * DS]; }
#pragma unroll 1
  for (int g = 0; g < 11; g += 2) {
    if (g + 1 < 11) {
#pragma unroll
      for (int j = 0; j < 12; ++j) { ub[j] = p[(size_t)((g + 1) * 12 + j) * PS]; db[j] = d[((g + 1) * 12 + j) * DS]; }
    }
#pragma unroll
    for (int j = 0; j < 12; ++j) { p[(size_t)(g * 12 + j) * PS] = f2bf(s); s = da[j] * s + bf2f(ua[j]); }
    if (g + 2 < 11) {
#pragma unroll
      for (int j = 0; j < 12; ++j) { ua[j] = p[(size_t)((g + 2) * 12 + j) * PS]; da[j] = d[((g + 2) * 12 + j) * DS]; }
    }
    if (g + 1 < 11) {
#pragma unroll
      for (int j = 0; j < 12; ++j) { p[(size_t)((g + 1) * 12 + j) * PS] = f2bf(s); s = db[j] * s + bf2f(ub[j]); }
    }
  }
}

DI void phase_scans(const Params& P) {
  const int tid_ = tidx(); const int w = tid_ >> 6, lane = tid_ & 63;
  for (int unit = blockIdx.x + gridDim.x * w; unit < 1552; unit += gridDim.x * 8) {
    if (unit < 512) {
      const int item = unit * 64 + lane, seq = item >> 11, kv = item & 2047;
      scan_bf16<2048, 32>((u16*)(P.ws + WS_GLA) + (size_t)seq * NCH * 2048 + kv, (const float*)(P.ws + WS_GLAD) + seq * NCH * 32 + (kv >> 6));
    } else if (unit < 1536) {
      const int item = (unit - 512) * 64 + lane, seq = item >> 12, pn = item & 4095;
      scan_bf16<4096, 1>((u16*)(P.ws + WS_SSD) + (size_t)seq * NCH * 4096 + pn, (const float*)(P.ws + WS_SSDD) + seq * NCH);
    } else {
      const int item = (unit - 1536) * 64 + lane, bd = item >> 8, ch = item & 255;
      float* pu = (float*)(P.ws + WS_LRUU) + (size_t)bd * NCH * 256 + ch; const float* pa = (const float*)(P.ws + WS_LRUA) + (size_t)bd * NCH * 256 + ch;
      float s = 0.f;
      for (int c0 = 0; c0 < NCH; c0 += 12) {
        float uu[12], dd[12];
#pragma unroll
        for (int j = 0; j < 12; ++j) { uu[j] = pu[(c0 + j) * 256]; dd[j] = pa[(c0 + j) * 256]; }
#pragma unroll
        for (int j = 0; j < 12; ++j) { pu[(c0 + j) * 256] = s; s = dd[j] * s + uu[j]; }
      }
    }
  }
}

DI void attn_tile(const Params& P, int l, int b, int h, int qpos0, int key0, int ntile, float lam, float lam_init, char* lds) {
  const int tid = tidx(), w = tid >> 6, lane = tid & 63, c31 = lane & 31, hh = lane >> 5;
  const u16* Qg = (const u16*)(P.ws + WS_Q) + (size_t)((b * 4 + h) * 2) * NKEY * 32;
  const u16* Kg = (const u16*)(P.ws + WS_K) + (size_t)((b * 4 + h) * 2) * NKEY * 32;
  const u16* Vg = (const u16*)(P.ws + WS_VT) + (size_t)((b * 4 + h) * 64) * NKEY;
  const int qp = qpos0 + w * 32 + c31;
  bf16x8 qf[2][2]; float bq[2];
#pragma unroll
  for (int c = 0; c < 2; ++c)
#pragma unroll
    for (int ks = 0; ks < 2; ++ks) qf[c][ks] = *(const bf16x8*)(Qg + ((size_t)c * NKEY + qp) * 32 + ks * 16 + hh * 8);
#pragma unroll
  for (int c = 0; c < 2; ++c) {
    float s = 0.f;
#pragma unroll
    for (int ks = 0; ks < 2; ++ks)
#pragma unroll
      for (int e = 0; e < 8; ++e) { const float v = bf2f((u16)qf[c][ks][e]); s += v * v; }
    s += shx(s, 32);
    const float km = ((const float*)(P.ws + WS_MISC))[((l * 2 + b) * 4 + h) * 2 + c];
    bq[c] = sqrtf(s * km) * 1.002f + 1e-3f;
  }
  u16* sK = (u16*)lds; u16* sV = (u16*)(lds + 20480);
  const int kc = tid >> 8, kr = (tid >> 2) & 63, kpart = tid & 3, vdv = tid >> 3, vpart = tid & 7;
  const u16* kp = Kg + ((size_t)kc * NKEY + key0 + kr) * 32 + kpart * 8;
  const u16* vp = Vg + (size_t)vdv * NKEY + key0 + vpart * 8;
  uint4 rk = *(const uint4*)kp, rv = *(const uint4*)vp;
  *(uint4*)(sK + (kc * 64 + kr) * 40 + kpart * 8) = rk; *(uint4*)(sV + vdv * 72 + vpart * 8) = rv;
  __syncthreads();
  f32x16 O[2][2]; float ls[2] = {0.f, 0.f};
#pragma unroll
  for (int a = 0; a < 2; ++a)
#pragma unroll
    for (int bb = 0; bb < 2; ++bb)
#pragma unroll
      for (int r = 0; r < 16; ++r) O[a][bb][r] = 0.f;
  if (__builtin_amdgcn_readfirstlane(tid) >= 256) __builtin_amdgcn_s_setprio(1);
#pragma unroll 1
  for (int kt = 0; kt < ntile; ++kt) {
    const int cur = kt & 1;
    if (kt + 1 < ntile) { rk = *(const uint4*)(kp + (size_t)(kt + 1) * 2048); rv = *(const uint4*)(vp + (kt + 1) * 64); }
    const u16* cK = sK + cur * 5120; const u16* cV = sV + cur * 4608;
#pragma unroll
    for (int kt2 = 0; kt2 < 2; ++kt2) {
      const bf16x8 ka0 = *(const bf16x8*)(cK + (kt2 * 32 + c31) * 40 + hh * 8), ka1 = *(const bf16x8*)(cK + (kt2 * 32 + c31) * 40 + 16 + hh * 8);
      const bf16x8 kb0 = *(const bf16x8*)(cK + (64 + kt2 * 32 + c31) * 40 + hh * 8), kb1 = *(const bf16x8*)(cK + (64 + kt2 * 32 + c31) * 40 + 16 + hh * 8);
      f32x16 Sa, Sb;
#pragma unroll
      for (int r = 0; r < 16; ++r) { Sa[r] = -bq[0]; Sb[r] = -bq[1]; }
      Sa = MFMA32(ka0, qf[0][0], Sa); Sb = MFMA32(kb0, qf[1][0], Sb);
      Sa = MFMA32(ka1, qf[0][1], Sa); Sb = MFMA32(kb1, qf[1][1], Sb);
      const bf16x8 v00 = *(const bf16x8*)(cV + (c31) * 72 + (kt2 * 2) * 16 + hh * 8), v01 = *(const bf16x8*)(cV + (c31) * 72 + (kt2 * 2 + 1) * 16 + hh * 8);
      const bf16x8 v10 = *(const bf16x8*)(cV + (32 + c31) * 72 + (kt2 * 2) * 16 + hh * 8), v11 = *(const bf16x8*)(cV + (32 + c31) * 72 + (kt2 * 2 + 1) * 16 + hh * 8);
      {
        float p[16];
#pragma unroll
        for (int r = 0; r < 16; ++r) { p[r] = __builtin_amdgcn_exp2f(Sa[r]); ls[0] += p[r]; }
        const bf16x8 p0 = pack8(p[0], p[1], p[2], p[3], p[4], p[5], p[6], p[7]), p1 = pack8(p[8], p[9], p[10], p[11], p[12], p[13], p[14], p[15]);
        O[0][0] = MFMA32(v00, p0, O[0][0]); O[0][1] = MFMA32(v10, p0, O[0][1]);
        O[0][0] = MFMA32(v01, p1, O[0][0]); O[0][1] = MFMA32(v11, p1, O[0][1]);
      }
      {
        float p[16];
#pragma unroll
        for (int r = 0; r < 16; ++r) { p[r] = __builtin_amdgcn_exp2f(Sb[r]); ls[1] += p[r]; }
        const bf16x8 p0 = pack8(p[0], p[1], p[2], p[3], p[4], p[5], p[6], p[7]), p1 = pack8(p[8], p[9], p[10], p[11], p[12], p[13], p[14], p[15]);
        O[1][0] = MFMA32(v00, p0, O[1][0]); O[1][1] = MFMA32(v10, p0, O[1][1]);
        O[1][0] = MFMA32(v01, p1, O[1][0]); O[1][1] = MFMA32(v11, p1, O[1][1]);
      }
    }
    if (kt + 1 < ntile) { *(uint4*)(sK + (cur ^ 1) * 5120 + (kc * 64 + kr) * 40 + kpart * 8) = rk; *(uint4*)(sV + (cur ^ 1) * 4608 + vdv * 72 + vpart * 8) = rv; }
    __syncthreads();
  }
  __builtin_amdgcn_s_setprio(0);
  ls[0] += shx(ls[0], 32); ls[1] += shx(ls[1], 32);
  const float i0 = 1.f / ls[0], i1 = lam / ls[1];
  float ss = 0.f;
#pragma unroll
  for (int dt = 0; dt < 2; ++dt)
#pragma unroll
    for (int r = 0; r < 16; ++r) { const float o = O[0][dt][r] * i0 - O[1][dt][r] * i1; O[0][dt][r] = o; ss += o * o; }
  ss += shx(ss, 32);
  const float rstd = rsqrtf(ss * (1.f / 64.f) + 1e-6f) * (1.f - lam_init);
  const size_t m = (qpos0 < 8192) ? (size_t)(b * T + qp) : (size_t)(MLAT + b * 256 + (qp - 8192));
  const u16* U = (const u16*)(P.ws + WS_U); u16* Y = (u16*)(P.ws + WS_XN);
#pragma unroll
  for (int dt = 0; dt < 2; ++dt)
#pragma unroll
    for (int q4 = 0; q4 < 4; ++q4) {
      const int d0 = dt * 32 + 8 * q4 + 4 * hh;
      const uint2 gv = *(const uint2*)(U + m * UP + UC_G + h * 64 + d0);
      const float4 nw = *(const float4*)(P.diff_subln_w + l * 64 + d0);
      const float y0 = O[0][dt][4 * q4 + 0] * rstd * nw.x * siluf(bflo(gv.x)), y1 = O[0][dt][4 * q4 + 1] * rstd * nw.y * siluf(bfhi(gv.x));
      const float y2 = O[0][dt][4 * q4 + 2] * rstd * nw.z * siluf(bflo(gv.y)), y3 = O[0][dt][4 * q4 + 3] * rstd * nw.w * siluf(bfhi(gv.y));
      uint2 ov; ov.x = pk2(y0, y1); ov.y = pk2(y2, y3);
      *(uint2*)(Y + m * 1024 + 512 + h * 64 + d0) = ov;
    }
  __syncthreads();
}

DI void phase_attn(const Params& P, int l, char* lds, int lo, int hi, int shift) {
  const int lane = tidx() & 63;
  const float lam_init = 0.8f - 0.6f * __expf(-0.3f * (float)l);
  float a = 0.f, bsum = 0.f;
  if (lane < 32) { const float* lv = gp(P.diff_lam + l * 128); a = lv[lane] * lv[32 + lane]; bsum = lv[64 + lane] * lv[96 + lane]; }
#pragma unroll
  for (int s = 32; s >= 1; s >>= 1) { a += shx(a, s); bsum += shx(bsum, s); }
  const float lam = __expf(a) - __expf(bsum) + lam_init;
  int first = (int)blockIdx.x + shift; first = first >= (int)gridDim.x ? first - (int)gridDim.x : first;
  for (int id0 = lo + first; id0 < hi; id0 += gridDim.x) {
    int tb, th, tq0, tk0, tn;
    if (id0 < 256) {
      const int id = (gridDim.x == 256) ? ((id0 & 7) * 32 + (id0 >> 3)) : id0;
      tb = id >> 7; th = (id >> 5) & 3; tq0 = (id & 31) * 256; tk0 = 0; tn = 132;
    } else {
      const int id = id0 - 256;
      tb = id >> 2; th = id & 3; tq0 = 8192; tk0 = 8192; tn = 4;
    }
    attn_tile(P, l, tb, th, tq0, tk0, tn, lam, lam_init, lds);
  }
}

#define XB_TMO      128
#define XB_XCNT(j)  (256  + 64 * (j))
#define XB_XSUB(j)  (1280 + 64 * (j))
#define XB_XGEN(j)  (2304 + 64 * (j))
#define XB_TOP      3328
#define XB_TOPGEN   3392
#define XCD_BAR_WORDS 3456
#define XB_SPIN_CAP (1u << 18)
#define LAS __attribute__((address_space(3)))
DI unsigned xb_ld(unsigned* p) { return __hip_atomic_load(p, __ATOMIC_RELAXED, __HIP_MEMORY_SCOPE_AGENT); }
DI unsigned xb_add(unsigned* p, unsigned v) { return __hip_atomic_fetch_add(p, v, __ATOMIC_RELAXED, __HIP_MEMORY_SCOPE_AGENT); }
DI unsigned xb_xcc_id() { return (unsigned)__builtin_amdgcn_s_getreg((3 << 11) | 20) & 0xFu; }
#define XB_SPIN(cond, bar) do { unsigned _sp = 0; while (cond) { __builtin_amdgcn_s_sleep(1); \
    if ((++_sp & 255u) == 0u) { if (xb_ld(&(bar)[XB_TMO])) break; if (_sp > XB_SPIN_CAP) { atomicAdd(&(bar)[XB_TMO], 1u); break; } } } } while (0)
struct XcdBarrier { unsigned* bar; unsigned x; volatile LAS unsigned* st; };
DI XcdBarrier xcd_barrier_post(unsigned* bar, volatile LAS unsigned* st) {
  XcdBarrier b; b.bar = bar; b.x = xb_xcc_id(); b.st = st;
  if (threadIdx.x == 0) (void)xb_add(&bar[XB_XCNT(b.x)], 1u);
  return b;
}
DI void xcd_barrier_complete(unsigned* bar, unsigned x, unsigned& nloc, unsigned& nx) {
  const unsigned G = gridDim.x * gridDim.y * gridDim.z;
  unsigned sum, cnt, mine, sp = 0u;
  for (;;) {
    sum = 0u; cnt = 0u; mine = 0u;
#pragma unroll
    for (unsigned j = 0; j < 16; ++j) { const unsigned c = xb_ld(&bar[XB_XCNT(j)]); sum += c; cnt += (c > 0u) ? 1u : 0u; mine = (j == x) ? c : mine; }
    if (sum == G) break;
    __builtin_amdgcn_s_sleep(1);
    if ((++sp & 255u) == 0u) { if (xb_ld(&bar[XB_TMO])) break; if (sp > XB_SPIN_CAP) { atomicAdd(&bar[XB_TMO], 1u); break; } }
  }
  nloc = mine > 0u ? mine : 1u; nx = cnt > 0u ? cnt : 1u;
}
DI void xcd_barrier(const XcdBarrier& b) {
  asm volatile("s_waitcnt vmcnt(0)" ::: "memory");
  __syncthreads();
  if (threadIdx.x == 0) {
    unsigned* bar = b.bar;
    __builtin_amdgcn_s_waitcnt(0);
    unsigned nloc = b.st[0], nx = b.st[1];
    if (nloc == 0u) { xcd_barrier_complete(bar, b.x, nloc, nx); b.st[0] = nloc; b.st[1] = nx; }
    const unsigned old = xb_add(&bar[XB_XSUB(b.x)], 1u);
    const unsigned gen = old / nloc;
    if (old + 1u == (gen + 1u) * nloc) {
      __builtin_amdgcn_fence(__ATOMIC_RELEASE, "agent");
      asm volatile("s_waitcnt vmcnt(0)" ::: "memory");
      const unsigned og = xb_add(&bar[XB_TOP], 1u);
      const unsigned tg = og / nx;
      if (og + 1u == (tg + 1u) * nx) xb_add(&bar[XB_TOPGEN], 1u);
      else XB_SPIN(xb_ld(&bar[XB_TOPGEN]) == tg, bar);
      __builtin_amdgcn_fence(__ATOMIC_ACQUIRE, "agent");
      xb_add(&bar[XB_XGEN(b.x)], 1u);
      asm volatile("s_waitcnt vmcnt(0)" ::: "memory");
    } else {
      XB_SPIN(xb_ld(&bar[XB_XGEN(b.x)]) == gen, bar);
      __builtin_amdgcn_fence(__ATOMIC_ACQUIRE, "agent");
      asm volatile("s_waitcnt vmcnt(0)" ::: "memory");
    }
  }
  __syncthreads();
}

__global__ void __launch_bounds__(NTHREADS) fwd_megakernel(Params Parg) {
  extern __shared__ __attribute__((aligned(16))) char lds[];
  __shared__ Params sP;
  __shared__ uint4 xb_words;
  if (threadIdx.x == 0) { sP = Parg; xb_words = make_uint4(0u, 0u, 0u, 0u); }
  __syncthreads();
  const Params& P = sP;
  cg::grid_group grid = cg::this_grid();
  if (blockDim.x == 12345u) grid.sync();
  (void)xcd_barrier_post((unsigned*)(Parg.ws + WS_BAR), (volatile LAS unsigned*)&xb_words);
#define GRID_BAR() do { XcdBarrier xb_; xb_.bar = (unsigned*)(P.ws + WS_BAR); xb_.x = xb_xcc_id(); xb_.st = (volatile LAS unsigned*)&xb_words; xcd_barrier(xb_); } while (0)
  MARK(0); phase_p0(P, lds);
  GRID_BAR();
#pragma unroll 1
  for (int l = 0; l < 2; ++l) {
    MARK(1); phase_norm(P, l);
    GRID_BAR(); MARK(2);
    gemm_phase<0>(P, l, (const u16*)(P.ws + WS_XN), (const u16*)(P.ws + WS_WINT) + (size_t)l * UP * 1024, 66, 25, lds);
    GRID_BAR();
    MARK(3);
    for (int t = blockIdx.x; t < 1056; t += gridDim.x) {
      const int ty = t / 264, idx = t % 264, b = idx / 132, cb = idx % 132;
      if (ty == 0) ssd_local(P, l, b, cb, lds);
      else if (ty == 1) lru_local(P, l, b, cb, lds);
      else if (ty == 2) gla_local(P, l, b, cb, lds);
      else attn_prep(P, l, idx, lds);
    }
    GRID_BAR();
    MARK(4); phase_scans(P);
    MARK(5); phase_attn(P, l, lds, 0, 256, 0); MARK(6);
    GRID_BAR();
    if (l == 0) phase_attn(P, l, lds, 256, 264, 8);
    {
      const int per = (l == 0) ? 264 : 256;
      for (int t = blockIdx.x; t < 3 * per; t += gridDim.x) {
        const int ty = t / per, idx = t % per;
        const int b = (l == 0) ? idx / 132 : (idx >> 7), cb = (l == 0) ? idx % 132 : 4 + (idx & 127);
        if (ty == 0) ssd_out(P, l, b, cb, lds);
        else if (ty == 1) lru_out(P, l, b, cb, lds);
        else gla_out(P, l, b, cb, lds);
      }
    }
    GRID_BAR();
    MARK(7); gemm_phase<1>(P, l, (const u16*)(P.ws + WS_XN), (const u16*)(P.ws + WS_WOUT) + (size_t)l * 1024 * 1024, l == 0 ? 66 : 64, 8, lds);
    GRID_BAR();
  }
  MARK(8); phase_final_norm(P);
}

extern "C" void kernel_launch(void* const* d_in, const int* in_sizes, int n_in, void* d_out, int out_size, void* d_ws, size_t ws_size, hipStream_t stream) {
  static int grid_blocks = 0;
  if (!grid_blocks) {
    int dev = 0, cus = 0, per_cu = 0;
    hipGetDevice(&dev);
    hipDeviceGetAttribute(&cus, hipDeviceAttributeMultiprocessorCount, dev);
    hipFuncSetAttribute((const void*)fwd_megakernel, hipFuncAttributeMaxDynamicSharedMemorySize, LDS_BYTES);
    hipOccupancyMaxActiveBlocksPerMultiprocessor(&per_cu, (const void*)fwd_megakernel, NTHREADS, LDS_BYTES);
    if (per_cu < 1) { fprintf(stderr, "occupancy query returned %d\n", per_cu); per_cu = 1; }
    if (per_cu > 1) per_cu = 1;
    grid_blocks = cus * per_cu;
  }
  Params p{};
  const float** pf = (const float**)&p;
  for (int i = 0; i < 28; ++i) pf[i] = (const float*)d_in[i];
  pf[28] = (const float*)d_out; pf[29] = (const float*)d_ws;
  hipMemsetAsync((char*)d_ws + WS_BAR, 0, XCD_BAR_WORDS * 4, stream);
  void* args[] = {&p};
  hipError_t e = hipLaunchCooperativeKernel((const void*)fwd_megakernel, dim3(grid_blocks), dim3(NTHREADS), args, LDS_BYTES, stream);
  if (e != hipSuccess) fprintf(stderr, "cooperative launch failed: %s (grid %d)\n", hipGetErrorString(e), grid_blocks);
}
```

```cpp
#include <hip/hip_runtime.h>
#include <hip/hip_cooperative_groups.h>
#include <cstdio>
namespace cg = cooperative_groups;

#define DI __device__ __forceinline__
typedef unsigned short u16;
typedef __attribute__((ext_vector_type(8))) short bf16x8;
typedef __attribute__((ext_vector_type(16))) float f32x16;
typedef __attribute__((ext_vector_type(4))) unsigned u32x4;
typedef __bf16 bf2_t __attribute__((ext_vector_type(2)));
typedef float fl2_t __attribute__((ext_vector_type(2)));

#define MARK(n) asm volatile("; MARK " #n)
#define MFMA32(a, b, c) __builtin_amdgcn_mfma_f32_32x32x16_bf16((a), (b), (c), 0, 0, 0)

constexpr int T = 8192, D = 1024, UP = 3200, MLAT = 16384, MTOT = 16896, NKEY = 8448, NCH = 132;
constexpr int UA_Q = 0, UA_K = 128, UA_V = 256, UA_LRF = 512, UA_G = 544;
constexpr int UB_X = 800, UB_G = 1056;
constexpr int UC_Q = 1312, UC_K = 1568, UC_V = 1824, UC_G = 2080;
constexpr int UD_XBC = 2336, UD_DTF = 2848, UD_Z = 2856;
constexpr int NTHREADS = 512;
constexpr int LDS_BYTES = 147456;

constexpr size_t WS_WINT = 0;
constexpr size_t WS_WOUT = WS_WINT + (size_t)2 * UP * 1024 * 2;
constexpr size_t WS_MOD = WS_WOUT + (size_t)2 * 1024 * 1024 * 2;
constexpr size_t WS_ROPE = WS_MOD + (size_t)2 * 3 * 3072 * 4;
constexpr size_t WS_MISC = WS_ROPE + 8192;
constexpr size_t WS_XN = WS_MISC + 4096;
constexpr size_t WS_U = WS_XN + (size_t)MTOT * 1024 * 2;
constexpr size_t WS_HCTX = WS_U + (size_t)MTOT * UP * 2;
constexpr size_t WS_Q = WS_HCTX + (size_t)512 * 1024 * 4;
constexpr size_t WS_K = WS_Q + (size_t)16 * NKEY * 32 * 2;
constexpr size_t WS_VT = WS_K + (size_t)16 * NKEY * 32 * 2;
constexpr size_t WS_GLA = WS_VT + (size_t)8 * 64 * NKEY * 2;
constexpr size_t WS_GLAD = WS_GLA + (size_t)16 * NCH * 2048 * 4;
constexpr size_t WS_SSD = WS_GLAD + (size_t)16 * NCH * 32 * 4;
constexpr size_t WS_SSDD = WS_SSD + (size_t)16 * NCH * 4096 * 4;
constexpr size_t WS_LRUA = WS_SSDD + 16384;
constexpr size_t WS_LRUU = WS_LRUA + (size_t)4 * NCH * 256 * 4;
constexpr size_t WS_BAR = WS_LRUU + (size_t)4 * NCH * 256 * 4;
constexpr size_t WS_LRUW = WS_BAR + 16384;
constexpr size_t WS_END = WS_LRUW + (size_t)64 * 4096 * 2;
static_assert(WS_END <= (size_t)256 * 1024 * 1024, "workspace");

#define GAS __attribute__((address_space(1)))
struct Params {
  const GAS float *x, *c, *ctx, *c_ctx, *w_mod, *b_mod, *norm_w, *w_in, *w_out, *gla_w2, *gla_b2, *gla_norm_w, *lru_conv_w, *lru_conv_b,
      *lru_wa, *lru_ba, *lru_wx, *lru_bx, *lru_lam, *diff_lam, *diff_subln_w, *ssd_conv_w, *ssd_conv_b, *ssd_dt_bias, *ssd_a_log, *ssd_d,
      *ssd_norm_w, *final_norm_w;
  GAS float* out;
  GAS unsigned char* ws;
};

DI unsigned pk2(float a, float b) { fl2_t v = {a, b}; return __builtin_bit_cast(unsigned, __builtin_convertvector(v, bf2_t)); }
DI u16 f2bf(float a) { return (u16)(pk2(a, 0.f) & 0xffffu); }
DI float bf2f(u16 x) { return __uint_as_float(((unsigned)x) << 16); }
DI float bflo(unsigned x) { return __uint_as_float(x << 16); }
DI float bfhi(unsigned x) { return __uint_as_float(x & 0xffff0000u); }
DI bf16x8 mk8(unsigned a, unsigned b, unsigned c, unsigned d) { u32x4 v = {a, b, c, d}; return __builtin_bit_cast(bf16x8, v); }
DI bf16x8 pack8(float a0, float a1, float a2, float a3, float a4, float a5, float a6, float a7) { return mk8(pk2(a0, a1), pk2(a2, a3), pk2(a4, a5), pk2(a6, a7)); }
template <class T> DI T* gp(GAS T* p) { return (T*)p; }
typedef __attribute__((ext_vector_type(4))) float f32x4_t;
DI float4 ld_nt(const float4* p) { const f32x4_t v = __builtin_nontemporal_load((const f32x4_t*)p); return make_float4(v.x, v.y, v.z, v.w); }
typedef __attribute__((ext_vector_type(4))) unsigned u32x4_nt;
DI uint4 ld_nt(const uint4* p) { const u32x4_nt v = __builtin_nontemporal_load((const u32x4_nt*)p); return make_uint4(v.x, v.y, v.z, v.w); }
DI float ld_nt(const float* p) { return __builtin_nontemporal_load(p); }
DI u16 ld_nt(const u16* p) { return __builtin_nontemporal_load(p); }
DI int tidx() { int t = threadIdx.x; asm volatile("" : "+v"(t)); return t; }
DI int crow(int r, int hh) { return (r & 3) + 8 * (r >> 2) + 4 * hh; }
DI float siluf(float x) { return x * __builtin_amdgcn_rcpf(1.f + __expf(-x)); }
DI float sigmf(float x) { return __builtin_amdgcn_rcpf(1.f + __expf(-x)); }
DI float softplusf(float x) { return fmaxf(x, 0.f) + __logf(1.f + __expf(-fabsf(x))); }
DI float shx(float v, int m) { return __shfl_xor(v, m, 64); }
DI int blk_m0(int b, int cb) { return cb < 4 ? MLAT + b * 256 + cb * 64 : b * T + (cb - 4) * 64; }
DI int blk_ci(int cb, int dir) { return dir == 0 ? cb : (cb < 4 ? 3 - cb : 135 - cb); }

DI void p0_transpose(const float* src, int N, u16* dst, int k0, int n0, float* lds) {
  const int tid = tidx();
  float v[8];
#pragma unroll
  for (int i = 0; i < 8; ++i) { const int e = tid + i * NTHREADS, kk = e >> 6, n = n0 + (e & 63); v[i] = (n < N) ? ld_nt(src + (size_t)(k0 + kk) * N + n) : 0.f; }
#pragma unroll
  for (int i = 0; i < 8; ++i) { const int e = tid + i * NTHREADS; lds[(e >> 6) * 65 + (e & 63)] = v[i]; }
  __syncthreads();
#pragma unroll
  for (int e = tid; e < 2048; e += NTHREADS) { int nn = e >> 5, kp = (e & 31) * 2; *(unsigned*)(dst + (size_t)(n0 + nn) * 1024 + k0 + kp) = pk2(lds[kp * 65 + nn], lds[(kp + 1) * 65 + nn]); }
  __syncthreads();
}

DI void p0_mod(const Params& P, int l, int n0, float* lds) {
  const int tid = tidx(), col = tid & 63, kg = tid >> 6;
  for (int e = tid; e < 1024; e += NTHREADS) { lds[e] = siluf(P.c[e]); lds[1024 + e] = siluf(P.c[1024 + e]); lds[2048 + e] = siluf(P.c_ctx[e]); }
  __syncthreads();
  float a0 = 0.f, a1 = 0.f, a2 = 0.f;
  const float* wm = gp(P.w_mod + (size_t)l * 1024 * 3072 + n0 + col);
  for (int k0 = kg * 128; k0 < kg * 128 + 128; k0 += 16) {
    float w[16];
#pragma unroll
    for (int j = 0; j < 16; ++j) w[j] = wm[(size_t)(k0 + j) * 3072];
#pragma unroll
    for (int j = 0; j < 16; ++j) { a0 += lds[k0 + j] * w[j]; a1 += lds[1024 + k0 + j] * w[j]; a2 += lds[2048 + k0 + j] * w[j]; }
  }
  float* red = lds + 3072;
  red[(kg * 3 + 0) * 64 + col] = a0; red[(kg * 3 + 1) * 64 + col] = a1; red[(kg * 3 + 2) * 64 + col] = a2;
  __syncthreads();
  if (tid < 192) {
    int j = tid >> 6; float sacc = P.b_mod[l * 3072 + n0 + col];
    for (int g = 0; g < 8; ++g) sacc += red[(g * 3 + j) * 64 + col];
    ((float*)(P.ws + WS_MOD))[(l * 3 + j) * 3072 + n0 + col] = sacc;
  }
  __syncthreads();
}

DI void phase_p0(const Params& P, char* lds) {
  float* fl = (float*)lds;
  for (int t0 = blockIdx.x; t0 < 2273; t0 += gridDim.x) {
    if (t0 >= 2209) {
      const int mid = t0 - 2209, gate = mid & 1, ldg = mid >> 1, tid = tidx();
      const float* wsrc = gp((gate ? P.lru_wx : P.lru_wa) + (size_t)ldg * 4096);
      const int lane = tid & 63, ct = (tid >> 6) & 1, ks = tid >> 7, c31 = lane & 31, hh = lane >> 5;
      float v[8];
#pragma unroll
      for (int e = 0; e < 8; ++e) v[e] = wsrc[(ks * 16 + hh * 8 + e) * 64 + ct * 32 + c31];
      uint4 o; o.x = pk2(v[0], v[1]); o.y = pk2(v[2], v[3]); o.z = pk2(v[4], v[5]); o.w = pk2(v[6], v[7]);
      *(uint4*)((u16*)(P.ws + WS_LRUW) + (size_t)mid * 4096 + tid * 8) = o;
      continue;
    }
    const int t = t0 < 96 ? 2112 + t0 : (t0 < 2208 ? t0 - 96 : t0);
    if (t < 1600) { int l = t / 800, rem = t % 800; p0_transpose(gp(P.w_in + (size_t)l * 1024 * 3112), 3112, (u16*)(P.ws + WS_WINT) + (size_t)l * UP * 1024, (rem & 15) * 64, (rem >> 4) * 64, fl); }
    else if (t < 2112) { int t2 = t - 1600; int l = t2 >> 8, rem = t2 & 255; p0_transpose(gp(P.w_out + (size_t)l * 1024 * 1024), 1024, (u16*)(P.ws + WS_WOUT) + (size_t)l * 1024 * 1024, (rem & 15) * 64, (rem >> 4) * 64, fl); }
    else if (t < 2208) { int t2 = t - 2112; p0_mod(P, t2 / 48, (t2 % 48) * 64, fl); }
    else {
      float* rope = (float*)(P.ws + WS_ROPE);
      const int tid = tidx();
      for (int e = tid; e < 1024; e += NTHREADS) { int pos = e >> 3, f = e & 7; float inv = exp2f(-(float)f * (13.287712379549449f / 8.f)); float ang = (float)pos * inv; rope[e] = __cosf(ang); rope[1024 + e] = __sinf(ang); }
      if (tid < 64) ((unsigned*)(P.ws + WS_MISC))[tid] = 0u;
    }
  }
}

DI const float* h_row(const Params& P, int l, int m) {
  if (l == 0) return gp(m < MLAT ? P.x + (size_t)m * 1024 : P.ctx + (size_t)(m - MLAT) * 1024);
  return m < MLAT ? (const float*)(P.out + (size_t)m * 1024) : (const float*)(P.ws + WS_HCTX) + (size_t)(m - MLAT) * 1024;
}

DI void phase_norm(const Params& P, int l) {
  const int tid_ = tidx(); const int w = tid_ >> 6, lane = tid_ & 63;
  u16* xn = (u16*)(P.ws + WS_XN);
  for (int row = blockIdx.x * 8 + w; row < MTOT; row += gridDim.x * 8) {
    const float4* src = (const float4*)h_row(P, l, row);
    const int j = row < MLAT ? (row >> 13) : 2;
    const float* mod = (const float*)(P.ws + WS_MOD) + (l * 3 + j) * 3072;
    float4 v[4]; float ss = 0.f;
#pragma unroll
    for (int i = 0; i < 4; ++i) { v[i] = ld_nt(src + i * 64 + lane); ss += v[i].x * v[i].x + v[i].y * v[i].y + v[i].z * v[i].z + v[i].w * v[i].w; }
#pragma unroll
    for (int s = 32; s >= 1; s >>= 1) ss += shx(ss, s);
    const float rstd = rsqrtf(ss * (1.f / 1024.f) + 1e-6f);
#pragma unroll
    for (int i = 0; i < 4; ++i) {
      const int k = (i * 64 + lane) * 4;
      float4 nw = *(const float4*)(P.norm_w + l * 1024 + k), sc = *(const float4*)(mod + 1024 + k), sh = *(const float4*)(mod + k);
      float y0 = v[i].x * rstd * nw.x * (1.f + sc.x) + sh.x, y1 = v[i].y * rstd * nw.y * (1.f + sc.y) + sh.y;
      float y2 = v[i].z * rstd * nw.z * (1.f + sc.z) + sh.z, y3 = v[i].w * rstd * nw.w * (1.f + sc.w) + sh.w;
      uint2 o; o.x = pk2(y0, y1); o.y = pk2(y2, y3);
      *(uint2*)(xn + (size_t)row * 1024 + k) = o;
    }
  }
}

DI void phase_final_norm(const Params& P) {
  const int tid_ = tidx(); const int w = tid_ >> 6, lane = tid_ & 63;
  for (int row = blockIdx.x * 8 + w; row < MLAT; row += gridDim.x * 8) {
    float4* src = (float4*)(P.out + (size_t)row * 1024);
    float4 v[4]; float ss = 0.f;
#pragma unroll
    for (int i = 0; i < 4; ++i) { v[i] = ld_nt(src + i * 64 + lane); ss += v[i].x * v[i].x + v[i].y * v[i].y + v[i].z * v[i].z + v[i].w * v[i].w; }
#pragma unroll
    for (int s = 32; s >= 1; s >>= 1) ss += shx(ss, s);
    const float rstd = rsqrtf(ss * (1.f / 1024.f) + 1e-6f);
#pragma unroll
    for (int i = 0; i < 4; ++i) {
      float4 nw = *(const float4*)(P.final_norm_w + (i * 64 + lane) * 4);
      float4 o; o.x = v[i].x * rstd * nw.x; o.y = v[i].y * rstd * nw.y; o.z = v[i].z * rstd * nw.z; o.w = v[i].w * rstd * nw.w;
      { const f32x4_t ov = {o.x, o.y, o.z, o.w}; __builtin_nontemporal_store(ov, (f32x4_t*)(src + i * 64 + lane)); }
    }
  }
}

constexpr int GS = 72;
template <int EPI>
DI void gemm_phase(const Params& P, int l, const u16* A, const u16* Bt, int mtiles, int ntiles, char* lds) {
  const int tid = tidx(), w = tid >> 6, lane = tid & 63, c31 = lane & 31, hh = lane >> 5, wm = w >> 1, wn = w & 1;
  const int lrow = tid >> 3, lcol = (tid & 7) * 8;
  const int ntot = mtiles * ntiles;
  const bool swz = (gridDim.x == 256);
  const int xcd = blockIdx.x & 7, jloc = blockIdx.x >> 3;
  const int per = (ntot + 7) >> 3, qbeg = xcd * per, qend = min(ntot, qbeg + per);
  for (int it = 0;; ++it) {
    int tm, tn;
    if (swz) {
      const int q = qbeg + jloc + 32 * it;
      if (q >= qend) break;
      const int band = q / (4 * ntiles), within = q - band * 4 * ntiles;
      const int rows = min(4, mtiles - band * 4);
      tn = within / rows; tm = band * 4 + (within - tn * rows);
    } else {
      const int tile = blockIdx.x + it * gridDim.x;
      if (tile >= ntot) break;
      tm = tile / ntiles; tn = tile % ntiles;
    }
    const int m0 = tm * 256, n0 = tn * 128;
    f32x16 acc[2][2];
#pragma unroll
    for (int i = 0; i < 2; ++i)
#pragma unroll
      for (int j = 0; j < 2; ++j)
#pragma unroll
        for (int r = 0; r < 16; ++r) acc[i][j][r] = 0.f;
    const u16* ga = A + (size_t)(m0 + lrow) * 1024 + lcol;
    const u16* gb = Bt + (size_t)(n0 + lrow) * 1024 + lcol;
    uint4 ra0, ra1, ra2, ra3, rb0, rb1, rc0, rc1, rc2, rc3, rd0, rd1;
#define G_LOAD(A0, A1, A2, A3, B0, B1, ko) { A0 = *(const uint4*)(ga + (ko)); A1 = *(const uint4*)(ga + (size_t)64 * 1024 + (ko)); A2 = *(const uint4*)(ga + (size_t)128 * 1024 + (ko)); A3 = *(const uint4*)(ga + (size_t)192 * 1024 + (ko)); \
      B0 = *(const uint4*)(gb + (ko)); B1 = *(const uint4*)(gb + (size_t)64 * 1024 + (ko)); }
#define G_STORE(A0, A1, A2, A3, B0, B1, buf) { u16* nA = (u16*)(lds + (buf) * 55296); u16* nB = (u16*)(lds + (buf) * 55296 + 36864); \
      *(uint4*)(nA + (lrow) * GS + lcol) = A0; *(uint4*)(nA + (lrow + 64) * GS + lcol) = A1; *(uint4*)(nA + (lrow + 128) * GS + lcol) = A2; *(uint4*)(nA + (lrow + 192) * GS + lcol) = A3; \
      *(uint4*)(nB + (lrow) * GS + lcol) = B0; *(uint4*)(nB + (lrow + 64) * GS + lcol) = B1; }
#define G_READ(buf) { const u16* sA = (const u16*)(lds + (buf) * 55296); const u16* sB = (const u16*)(lds + (buf) * 55296 + 36864); \
      _Pragma("unroll") for (int ks = 0; ks < 4; ++ks) { \
        af[ks][0] = *(const bf16x8*)(sA + (wm * 64 + c31) * GS + ks * 16 + hh * 8); af[ks][1] = *(const bf16x8*)(sA + (wm * 64 + 32 + c31) * GS + ks * 16 + hh * 8); \
        bfr[ks][0] = *(const bf16x8*)(sB + (wn * 64 + c31) * GS + ks * 16 + hh * 8); bfr[ks][1] = *(const bf16x8*)(sB + (wn * 64 + 32 + c31) * GS + ks * 16 + hh * 8); } \
      __builtin_amdgcn_sched_barrier(0); }
#define G_MMA() { __builtin_amdgcn_sched_barrier(0); \
      _Pragma("unroll") for (int ks = 0; ks < 4; ++ks) { \
        acc[0][0] = MFMA32(af[ks][0], bfr[ks][0], acc[0][0]); acc[0][1] = MFMA32(af[ks][0], bfr[ks][1], acc[0][1]); \
        acc[1][0] = MFMA32(af[ks][1], bfr[ks][0], acc[1][0]); acc[1][1] = MFMA32(af[ks][1], bfr[ks][1], acc[1][1]); } \
      __builtin_amdgcn_sched_barrier(0); }
    bf16x8 af[4][2], bfr[4][2];
#define S0 ra0, ra1, ra2, ra3, rb0, rb1
#define S1 rc0, rc1, rc2, rc3, rd0, rd1
#define GX(M, ...) M(__VA_ARGS__)
#define TK(t) (min((t), 15) * 64)
    if (w < 4) {
      GX(G_LOAD, S0, 0); GX(G_LOAD, S1, 64);
      GX(G_STORE, S0, 0); GX(G_STORE, S1, 1);
      GX(G_LOAD, S0, 128); GX(G_LOAD, S1, 192);
      __syncthreads();
      G_READ(0);
#pragma unroll 1
      for (int kt = 0; kt < 16; kt += 2) {
        G_MMA();
        __syncthreads();
        G_READ(1);
        if (kt + 2 < 16) GX(G_STORE, S0, 0);
        GX(G_LOAD, S0, TK(kt + 4));
        __syncthreads();
        G_MMA();
        __syncthreads();
        if (kt + 2 < 16) { G_READ(0); }
        if (kt + 3 < 16) GX(G_STORE, S1, 1);
        GX(G_LOAD, S1, TK(kt + 5));
        __syncthreads();
      }
    } else {
      GX(G_LOAD, S0, 0);
      GX(G_STORE, S0, 0);
      GX(G_LOAD, S1, 64); GX(G_LOAD, S0, 128);
      __syncthreads();
#pragma unroll 1
      for (int kt = 0; kt < 16; kt += 2) {
        G_READ(0);
        GX(G_STORE, S1, 1);
        GX(G_LOAD, S1, TK(kt + 3));
        __syncthreads();
        G_MMA();
        __syncthreads();
        G_READ(1);
        if (kt + 2 < 16) GX(G_STORE, S0, 0);
        GX(G_LOAD, S0, TK(kt + 4));
        __syncthreads();
        G_MMA();
        __syncthreads();
      }
    }
#undef GX
#undef S0
#undef S1
#undef TK
#undef G_READ
#undef G_MMA
#undef G_LOAD
#undef G_STORE
#undef G_COMPUTE
    if (EPI == 0) {
      u16* st = (u16*)(lds + 55296 + w * 9216);
#pragma unroll
      for (int i = 0; i < 2; ++i)
#pragma unroll
        for (int j = 0; j < 2; ++j)
#pragma unroll
          for (int r = 0; r < 16; ++r) st[(i * 32 + crow(r, hh)) * 72 + j * 32 + c31] = f2bf(acc[i][j][r]);
      u16* U = (u16*)(P.ws + WS_U) + (size_t)(m0 + wm * 64) * UP + n0 + wn * 64;
#pragma unroll
      for (int q = 0; q < 8; ++q) {
        const int idx = q * 64 + lane, row = idx >> 3, part = idx & 7;
        *(uint4*)(U + (size_t)row * UP + part * 8) = *(const uint4*)(st + row * 72 + part * 8);
      }
      __syncthreads();
    } else {
      float* st = (float*)(lds + w * 17408);
#pragma unroll
      for (int i = 0; i < 2; ++i)
#pragma unroll
        for (int j = 0; j < 2; ++j)
#pragma unroll
          for (int r = 0; r < 16; ++r) st[(i * 32 + crow(r, hh)) * 68 + j * 32 + c31] = acc[i][j][r];
      const int mrow0 = m0 + wm * 64, ncol = n0 + wn * 64 + (lane & 15) * 4;
      const int jm = mrow0 < MLAT ? (mrow0 >> 13) : 2;
      const float4 gate = *(const float4*)((const float*)(P.ws + WS_MOD) + (l * 3 + jm) * 3072 + 2048 + ncol);
#pragma unroll
      for (int half = 0; half < 2; ++half) {
        float4 hv[8];
#pragma unroll
        for (int q = 0; q < 8; ++q) { const int row = (half * 8 + q) * 4 + (lane >> 4); hv[q] = ld_nt((const float4*)(h_row(P, l, mrow0 + row) + ncol)); }
#pragma unroll
        for (int q = 0; q < 8; ++q) {
          const int row = (half * 8 + q) * 4 + (lane >> 4), m = mrow0 + row;
          const float4 a = *(const float4*)(st + row * 68 + (lane & 15) * 4);
          float4 o; o.x = hv[q].x + gate.x * a.x; o.y = hv[q].y + gate.y * a.y; o.z = hv[q].z + gate.z * a.z; o.w = hv[q].w + gate.w * a.w;
          float* dst = m < MLAT ? (float*)(P.out + (size_t)m * 1024 + ncol) : (float*)(P.ws + WS_HCTX) + (size_t)(m - MLAT) * 1024 + ncol;
          *(float4*)dst = o;
        }
      }
      __syncthreads();
    }
  }
}

DI void attn_prep(const Params& P, int l, int unit, char* lds) {
  const int tid = tidx(); const int gid = unit * NTHREADS + tid;
  const int m = gid >> 3, h = (gid >> 1) & 3, c = gid & 1;
  const u16* urow = (const u16*)(P.ws + WS_U) + (size_t)m * UP;
  float q[32], k[32];
  {
    const uint4* qs = (const uint4*)(urow + UC_Q + h * 64 + c * 32); const uint4* ks = (const uint4*)(urow + UC_K + h * 64 + c * 32);
#pragma unroll
    for (int i = 0; i < 4; ++i) {
      uint4 a = qs[i], b = ks[i];
      q[i * 8 + 0] = bflo(a.x); q[i * 8 + 1] = bfhi(a.x); q[i * 8 + 2] = bflo(a.y); q[i * 8 + 3] = bfhi(a.y); q[i * 8 + 4] = bflo(a.z); q[i * 8 + 5] = bfhi(a.z); q[i * 8 + 6] = bflo(a.w); q[i * 8 + 7] = bfhi(a.w);
      k[i * 8 + 0] = bflo(b.x); k[i * 8 + 1] = bfhi(b.x); k[i * 8 + 2] = bflo(b.y); k[i * 8 + 3] = bfhi(b.y); k[i * 8 + 4] = bflo(b.z); k[i * 8 + 5] = bfhi(b.z); k[i * 8 + 6] = bflo(b.w); k[i * 8 + 7] = bfhi(b.w);
    }
  }
  const bool lat = m < MLAT;
  const int b = lat ? (m >> 13) : ((m - MLAT) >> 8), t = lat ? (m & 8191) : ((m - MLAT) & 255);
  if (lat) {
    const float* rc = (const float*)(P.ws + WS_ROPE); const float* rs = rc + 1024;
#pragma unroll
    for (int a = 0; a < 2; ++a) {
      const int pos = a ? (t & 63) : (t >> 6);
#pragma unroll
      for (int f = 0; f < 8; ++f) {
        const float cs = rc[pos * 8 + f], sn = rs[pos * 8 + f];
        float x0 = q[a * 16 + f], x1 = q[a * 16 + 8 + f]; q[a * 16 + f] = x0 * cs - x1 * sn; q[a * 16 + 8 + f] = x1 * cs + x0 * sn;
        x0 = k[a * 16 + f]; x1 = k[a * 16 + 8 + f]; k[a * 16 + f] = x0 * cs - x1 * sn; k[a * 16 + 8 + f] = x1 * cs + x0 * sn;
      }
    }
  }
  const int pos = lat ? t : 8192 + t;
  const float QS = 0.17677669529663687f * 1.4426950408889634f;
  float k2 = 0.f;
  u16* qd = (u16*)(P.ws + WS_Q) + ((size_t)((b * 4 + h) * 2 + c) * NKEY + pos) * 32;
  u16* kd = (u16*)(P.ws + WS_K) + ((size_t)((b * 4 + h) * 2 + c) * NKEY + pos) * 32;
#pragma unroll
  for (int i = 0; i < 4; ++i) {
    uint4 a, bb;
    a.x = pk2(q[i * 8 + 0] * QS, q[i * 8 + 1] * QS); a.y = pk2(q[i * 8 + 2] * QS, q[i * 8 + 3] * QS); a.z = pk2(q[i * 8 + 4] * QS, q[i * 8 + 5] * QS); a.w = pk2(q[i * 8 + 6] * QS, q[i * 8 + 7] * QS);
    bb.x = pk2(k[i * 8 + 0], k[i * 8 + 1]); bb.y = pk2(k[i * 8 + 2], k[i * 8 + 3]); bb.z = pk2(k[i * 8 + 4], k[i * 8 + 5]); bb.w = pk2(k[i * 8 + 6], k[i * 8 + 7]);
    ((uint4*)qd)[i] = a; ((uint4*)kd)[i] = bb;
  }
#pragma unroll
  for (int i = 0; i < 32; ++i) k2 += k[i] * k[i];
  k2 = fmaxf(k2, shx(k2, 8)); k2 = fmaxf(k2, shx(k2, 16)); k2 = fmaxf(k2, shx(k2, 32));
  float* kred = (float*)(lds + 40960);
  if ((tid & 63) < 8) kred[(tid >> 6) * 8 + (tid & 7)] = k2;
  {
    u16* vt = (u16*)lds;
    const uint4* vs = (const uint4*)(urow + UC_V + h * 64 + c * 32);
    const int p64 = pos & 63, within = p64 & 15, hh = (within >> 2) & 1, jj = ((within >> 3) << 2) | (within & 3);
    const int col = (p64 & ~15) + 8 * hh + jj;
    u16* vd = vt + (h * 64 + c * 32) * 72 + col;
#pragma unroll
    for (int i = 0; i < 4; ++i) {
      uint4 a = vs[i];
      vd[(i * 8 + 0) * 72] = (u16)(a.x & 0xffff); vd[(i * 8 + 1) * 72] = (u16)(a.x >> 16);
      vd[(i * 8 + 2) * 72] = (u16)(a.y & 0xffff); vd[(i * 8 + 3) * 72] = (u16)(a.y >> 16);
      vd[(i * 8 + 4) * 72] = (u16)(a.z & 0xffff); vd[(i * 8 + 5) * 72] = (u16)(a.z >> 16);
      vd[(i * 8 + 6) * 72] = (u16)(a.w & 0xffff); vd[(i * 8 + 7) * 72] = (u16)(a.w >> 16);
    }
    __syncthreads();
    const int m0u = unit * 64;
    const int bu = m0u < MLAT ? (m0u >> 13) : ((m0u - MLAT) >> 8), pos0 = m0u < MLAT ? (m0u & 8191) : 8192 + ((m0u - MLAT) & 255);
    u16* Vg = (u16*)(P.ws + WS_VT) + (size_t)(bu * 4) * 64 * NKEY + pos0;
#pragma unroll
    for (int q = 0; q < 4; ++q) {
      const int idx = tid + q * NTHREADS, row = idx >> 3, part = idx & 7;
      *(uint4*)(Vg + (size_t)row * NKEY + part * 8) = *(const uint4*)(vt + row * 72 + part * 8);
    }
    if (tid < 8) {
      float mx = 0.f;
#pragma unroll
      for (int w8 = 0; w8 < 8; ++w8) mx = fmaxf(mx, kred[w8 * 8 + tid]);
      atomicMax((unsigned*)(P.ws + WS_MISC) + ((l * 2 + bu) * 4 + (tid >> 1)) * 2 + (tid & 1), __float_as_uint(mx));
    }
    __syncthreads();
  }
}

constexpr int QP = 136, GP = 129, GLA_SG = 2 * 64 * QP * 2 + 64 * 256 * 2, GLA_SLR = GLA_SG + 2 * 64 * GP * 4;
DI void gla_stage(const Params& P, int l, int b, int cb, char* lds) {
  u16* sq = (u16*)lds; u16* sk = sq + 64 * QP; u16* sv = sk + 64 * QP; float* sg = (float*)(lds + GLA_SG); float* slr = (float*)(lds + GLA_SLR);
  const int tid = tidx(), m0 = blk_m0(b, cb);
  const u16* U = (const u16*)(P.ws + WS_U);
#pragma unroll
  for (int e = tid; e < 1024; e += NTHREADS) {
    int t = e >> 4, part = e & 15; const u16* row = U + (size_t)(m0 + t) * UP;
    *(uint4*)(sq + t * QP + part * 8) = *(const uint4*)(row + UA_Q + part * 8);
    *(uint4*)(sk + t * QP + part * 8) = *(const uint4*)(row + UA_K + part * 8);
  }
#pragma unroll
  for (int e = tid; e < 2048; e += NTHREADS) { int t = e >> 5, part = e & 31; *(uint4*)(sv + t * 256 + part * 8) = *(const uint4*)(U + (size_t)(m0 + t) * UP + UA_V + part * 8); }
  {
    int t = tid >> 3, part = tid & 7;
    uint2 v = *(const uint2*)(U + (size_t)(m0 + t) * UP + UA_LRF + part * 4);
    int dir = part >> 2, r0 = (part & 3) * 4; float* d = slr + (dir * 64 + t) * 16 + r0;
    d[0] = bflo(v.x); d[1] = bfhi(v.x); d[2] = bflo(v.y); d[3] = bfhi(v.y);
  }
  __syncthreads();
  {
    const int hk = tid & 127, tq = tid >> 7;
#pragma unroll
    for (int dir = 0; dir < 2; ++dir) {
      float wv[16];
#pragma unroll
      for (int r = 0; r < 16; ++r) wv[r] = P.gla_w2[((l * 2 + dir) * 16 + r) * 128 + hk];
      const float bb = P.gla_b2[(l * 2 + dir) * 128 + hk];
      for (int t = tq; t < 64; t += 4) {
        const float* lr = slr + (dir * 64 + t) * 16; float z = bb;
#pragma unroll
        for (int r = 0; r < 16; ++r) z += lr[r] * wv[r];
        const float ls = fminf(z, 0.f) - __logf(1.f + __expf(-fabsf(z)));
        sg[(dir * 64 + t) * GP + hk] = ls * (1.f / 16.f);
      }
    }
  }
  __syncthreads();
  if (tid < 256) {
    const int dir = tid >> 7, hk = tid & 127; float s = 0.f;
    float* col = sg + dir * 64 * GP + hk; float v[64];
#pragma unroll
    for (int t = 0; t < 64; ++t) v[t] = col[t * GP];
    if (dir == 0) {
#pragma unroll
      for (int t = 0; t < 64; ++t) { s += v[t]; col[t * GP] = s; }
    } else {
#pragma unroll
      for (int t = 63; t >= 0; --t) { s += v[t]; col[t * GP] = s; }
    }
  }
  __syncthreads();
}

DI void gla_local(const Params& P, int l, int b, int cb, char* lds) {
  gla_stage(P, l, b, cb, lds);
  const u16* sk = (const u16*)lds + 64 * QP; const u16* sv = sk + 64 * QP; const float* sg = (const float*)(lds + GLA_SG);
  const int tid = tidx(), w = tid >> 6, lane = tid & 63, c31 = lane & 31, hh = lane >> 5, dir = w >> 2, h = w & 3;
  const float* g = sg + dir * 64 * GP;
  const float glast = g[(dir ? 0 : 63) * GP + h * 32 + c31];
  f32x16 acc[2];
#pragma unroll
  for (int r = 0; r < 16; ++r) { acc[0][r] = 0.f; acc[1][r] = 0.f; }
#pragma unroll
  for (int ks = 0; ks < 4; ++ks) {
    float av[8];
#pragma unroll
    for (int e = 0; e < 8; ++e) { const int j = ks * 16 + hh * 8 + e; av[e] = bf2f(sk[j * QP + h * 32 + c31]) * __expf(glast - g[j * GP + h * 32 + c31]); }
    const bf16x8 a = pack8(av[0], av[1], av[2], av[3], av[4], av[5], av[6], av[7]);
#pragma unroll
    for (int vt = 0; vt < 2; ++vt) {
      bf16x8 bv;
#pragma unroll
      for (int e = 0; e < 8; ++e) bv[e] = (short)sv[(ks * 16 + hh * 8 + e) * 256 + h * 64 + vt * 32 + c31];
      acc[vt] = MFMA32(a, bv, acc[vt]);
    }
  }
  const int seq = (b * 2 + dir) * 4 + h, ci = blk_ci(cb, dir);
  u16* dst = (u16*)(P.ws + WS_GLA) + (size_t)(seq * NCH + ci) * 2048;
#pragma unroll
  for (int vt = 0; vt < 2; ++vt)
#pragma unroll
    for (int r = 0; r < 16; ++r) dst[crow(r, hh) * 64 + vt * 32 + c31] = f2bf(acc[vt][r]);
  if (hh == 0) ((float*)(P.ws + WS_GLAD))[(seq * NCH + ci) * 32 + c31] = __expf(glast);
  __syncthreads();
}

DI void gla_out(const Params& P, int l, int b, int cb, char* lds) {
  gla_stage(P, l, b, cb, lds);
  const u16* sq = (const u16*)lds; const u16* sk = sq + 64 * QP; const u16* sv = sk + 64 * QP; const float* sg = (const float*)(lds + GLA_SG);
  const int tid = tidx(), w = tid >> 6, lane = tid & 63, c31 = lane & 31, hh = lane >> 5, dir = w >> 2, h = w & 3;
  const float* g = sg + dir * 64 * GP;
  const int seq = (b * 2 + dir) * 4 + h, ci = blk_ci(cb, dir), m0 = blk_m0(b, cb);
  const u16* Sin = (const u16*)(P.ws + WS_GLA) + (size_t)(seq * NCH + ci) * 2048;
  f32x16 o[2][2];
#pragma unroll
  for (int a = 0; a < 2; ++a)
#pragma unroll
    for (int bb = 0; bb < 2; ++bb)
#pragma unroll
      for (int r = 0; r < 16; ++r) o[a][bb][r] = 0.f;
  bf16x8 qg[2][2];
#pragma unroll
  for (int it = 0; it < 2; ++it)
#pragma unroll
    for (int ks = 0; ks < 2; ++ks) {
      float v[8]; const int i = it * 32 + c31;
#pragma unroll
      for (int e = 0; e < 8; ++e) { const int kk = h * 32 + ks * 16 + hh * 8 + e; v[e] = bf2f(sq[i * QP + kk]) * __expf(g[i * GP + kk]) * 0.17677669529663687f; }
      qg[it][ks] = pack8(v[0], v[1], v[2], v[3], v[4], v[5], v[6], v[7]);
    }
#pragma unroll
  for (int ks = 0; ks < 2; ++ks)
#pragma unroll
    for (int vt = 0; vt < 2; ++vt) {
      bf16x8 sa;
#pragma unroll
      for (int e = 0; e < 8; ++e) sa[e] = (short)ld_nt(Sin + (ks * 16 + hh * 8 + e) * 64 + vt * 32 + c31);
#pragma unroll
      for (int it = 0; it < 2; ++it) o[vt][it] = MFMA32(sa, qg[it][ks], o[vt][it]);
    }
#pragma unroll
  for (int jt = 0; jt < 2; ++jt) {
    bf16x8 kg[2];
#pragma unroll
    for (int ks = 0; ks < 2; ++ks) {
      float v[8]; const int j = jt * 32 + c31;
#pragma unroll
      for (int e = 0; e < 8; ++e) { const int kk = h * 32 + ks * 16 + hh * 8 + e; v[e] = bf2f(sk[j * QP + kk]) * __expf(-g[j * GP + kk]); }
      kg[ks] = pack8(v[0], v[1], v[2], v[3], v[4], v[5], v[6], v[7]);
    }
#pragma unroll
    for (int it = 0; it < 2; ++it) {
      const bool skip = dir == 0 ? (jt > it) : (jt < it);
      if (skip) continue;
      f32x16 s;
#pragma unroll
      for (int r = 0; r < 16; ++r) s[r] = 0.f;
      s = MFMA32(kg[0], qg[it][0], s); s = MFMA32(kg[1], qg[it][1], s);
      const int i = it * 32 + c31;
#pragma unroll
      for (int r = 0; r < 16; ++r) { const int j = jt * 32 + crow(r, hh); const bool keep = dir == 0 ? (j <= i) : (j >= i); s[r] = keep ? s[r] : 0.f; }
      const bf16x8 p0 = pack8(s[0], s[1], s[2], s[3], s[4], s[5], s[6], s[7]), p1 = pack8(s[8], s[9], s[10], s[11], s[12], s[13], s[14], s[15]);
#pragma unroll
      for (int s2 = 0; s2 < 2; ++s2)
#pragma unroll
        for (int vt = 0; vt < 2; ++vt) {
          bf16x8 va;
#pragma unroll
          for (int e = 0; e < 8; ++e) { const int j = jt * 32 + 16 * s2 + 8 * (e >> 2) + 4 * hh + (e & 3); va[e] = (short)sv[j * 256 + h * 64 + vt * 32 + c31]; }
          o[vt][it] = MFMA32(va, s2 ? p1 : p0, o[vt][it]);
        }
    }
  }
  __syncthreads();
  float* xb = (float*)(lds + GLA_SG);
  if (dir == 1) {
#pragma unroll
    for (int vt = 0; vt < 2; ++vt)
#pragma unroll
      for (int it = 0; it < 2; ++it)
#pragma unroll
        for (int r = 0; r < 16; ++r) xb[(it * 32 + c31) * 257 + h * 64 + vt * 32 + crow(r, hh)] = o[vt][it][r];
  }
  __syncthreads();
  if (dir == 0) {
#pragma unroll
    for (int vt = 0; vt < 2; ++vt)
#pragma unroll
      for (int it = 0; it < 2; ++it)
#pragma unroll
        for (int r = 0; r < 16; ++r) xb[(it * 32 + c31) * 257 + h * 64 + vt * 32 + crow(r, hh)] += o[vt][it][r];
  }
  __syncthreads();
  {
    const u16* U = (const u16*)(P.ws + WS_U); u16* Y = (u16*)(P.ws + WS_XN);
#pragma unroll
    for (int q = 0; q < 4; ++q) {
      const int idx = tid + q * NTHREADS, row = idx >> 5, ch0 = (idx & 31) * 8; const size_t m = (size_t)(m0 + row);
      const uint4 gv = ld_nt((const uint4*)(U + m * UP + UA_G + ch0));
      float v[8]; float ss = 0.f;
#pragma unroll
      for (int e = 0; e < 8; ++e) { v[e] = xb[row * 257 + ch0 + e]; ss += v[e] * v[e]; }
      ss += shx(ss, 1); ss += shx(ss, 2); ss += shx(ss, 4);
      const float rstd = rsqrtf(ss * (1.f / 64.f) + 1e-6f);
      const float4 n0 = *(const float4*)(P.gla_norm_w + l * 64 + (ch0 & 63)), n1 = *(const float4*)(P.gla_norm_w + l * 64 + (ch0 & 63) + 4);
      uint4 ov;
      ov.x = pk2(v[0] * rstd * n0.x * siluf(bflo(gv.x)), v[1] * rstd * n0.y * siluf(bfhi(gv.x)));
      ov.y = pk2(v[2] * rstd * n0.z * siluf(bflo(gv.y)), v[3] * rstd * n0.w * siluf(bfhi(gv.y)));
      ov.z = pk2(v[4] * rstd * n1.x * siluf(bflo(gv.z)), v[5] * rstd * n1.y * siluf(bfhi(gv.z)));
      ov.w = pk2(v[6] * rstd * n1.z * siluf(bflo(gv.w)), v[7] * rstd * n1.w * siluf(bfhi(gv.w)));
      *(uint4*)(Y + m * 1024 + ch0) = ov;
    }
  }
  __syncthreads();
}

constexpr int SXP = 520;
DI void ssd_stage(const Params& P, int l, int b, int cb, char* lds) {
  u16* sx = (u16*)lds; float* scum = (float*)(lds + 132352); float* sdt = scum + 512;
  const int tid = tidx(), m0 = blk_m0(b, cb);
  const u16* U = (const u16*)(P.ws + WS_U);
  const int tseq0 = cb < 4 ? cb * 64 : (cb - 4) * 64, slen = cb < 4 ? 256 : T, mseq0 = cb < 4 ? MLAT + b * 256 : b * T;
  {
    const int ch0 = (tid & 63) * 8;
    float wt[4][8], bs[8];
    { const float4 b0 = *(const float4*)(P.ssd_conv_b + l * 512 + ch0), b1 = *(const float4*)(P.ssd_conv_b + l * 512 + ch0 + 4);
      bs[0] = b0.x; bs[1] = b0.y; bs[2] = b0.z; bs[3] = b0.w; bs[4] = b1.x; bs[5] = b1.y; bs[6] = b1.z; bs[7] = b1.w; }
#pragma unroll
    for (int j = 0; j < 4; ++j) {
      const float* wj = gp(P.ssd_conv_w + (l * 4 + j) * 512 + ch0); const float4 w0 = *(const float4*)wj, w1 = *(const float4*)(wj + 4);
      wt[j][0] = w0.x; wt[j][1] = w0.y; wt[j][2] = w0.z; wt[j][3] = w0.w; wt[j][4] = w1.x; wt[j][5] = w1.y; wt[j][6] = w1.z; wt[j][7] = w1.w;
    }
#pragma unroll 2
    for (int t = tid >> 6; t < 64; t += 8) {
      float acc[8];
#pragma unroll
      for (int i = 0; i < 8; ++i) acc[i] = bs[i];
#pragma unroll
      for (int j = 0; j < 4; ++j) {
        const int ts = tseq0 + t - 2 + j;
        if (ts >= 0 && ts < slen) {
          const uint4 v = *(const uint4*)(U + (size_t)(mseq0 + ts) * UP + UD_XBC + ch0);
          acc[0] += bflo(v.x) * wt[j][0]; acc[1] += bfhi(v.x) * wt[j][1]; acc[2] += bflo(v.y) * wt[j][2]; acc[3] += bfhi(v.y) * wt[j][3];
          acc[4] += bflo(v.z) * wt[j][4]; acc[5] += bfhi(v.z) * wt[j][5]; acc[6] += bflo(v.w) * wt[j][6]; acc[7] += bfhi(v.w) * wt[j][7];
        }
      }
      uint4 o; o.x = pk2(siluf(acc[0]), siluf(acc[1])); o.y = pk2(siluf(acc[2]), siluf(acc[3])); o.z = pk2(siluf(acc[4]), siluf(acc[5])); o.w = pk2(siluf(acc[6]), siluf(acc[7]));
      *(uint4*)(sx + t * SXP + ch0) = o;
    }
  }
  {
    const int dir = tid >> 8, t = (tid >> 2) & 63, hd = tid & 3;
    const float raw = bf2f(U[(size_t)(m0 + t) * UP + UD_DTF + dir * 4 + hd]);
    const float dt = softplusf(raw + P.ssd_dt_bias[(l * 2 + dir) * 4 + hd]);
    const float a = -__expf(P.ssd_a_log[(l * 2 + dir) * 4 + hd]);
    sdt[(dir * 64 + t) * 4 + hd] = dt; scum[(dir * 64 + t) * 4 + hd] = dt * a;
  }
  __syncthreads();
  if (tid < 8) {
    const int dir = tid >> 2, hd = tid & 3; float s = 0.f;
    float* col = scum + dir * 256 + hd; float v[64];
#pragma unroll
    for (int t = 0; t < 64; ++t) v[t] = col[t * 4];
    if (dir == 0) {
#pragma unroll
      for (int t = 0; t < 64; ++t) { s += v[t]; col[t * 4] = s; }
    } else {
#pragma unroll
      for (int t = 63; t >= 0; --t) { s += v[t]; col[t * 4] = s; }
    }
  }
  __syncthreads();
}

DI void ssd_local(const Params& P, int l, int b, int cb, char* lds) {
  ssd_stage(P, l, b, cb, lds);
  const u16* sx = (const u16*)lds; const float* scum = (const float*)(lds + 132352); const float* sdt = scum + 512;
  const int tid = tidx(), w = tid >> 6, lane = tid & 63, c31 = lane & 31, hh = lane >> 5, dir = w >> 2, h = w & 3, grp = h >> 1;
  const float cl = scum[(dir * 64 + (dir ? 0 : 63)) * 4 + h];
  f32x16 acc[2][2];
#pragma unroll
  for (int a = 0; a < 2; ++a)
#pragma unroll
    for (int bb = 0; bb < 2; ++bb)
#pragma unroll
      for (int r = 0; r < 16; ++r) acc[a][bb][r] = 0.f;
#pragma unroll
  for (int ks = 0; ks < 4; ++ks) {
    float wgt[8];
#pragma unroll
    for (int e = 0; e < 8; ++e) { const int s = ks * 16 + hh * 8 + e; wgt[e] = __expf(cl - scum[(dir * 64 + s) * 4 + h]) * sdt[(dir * 64 + s) * 4 + h]; }
    bf16x8 bn[2];
#pragma unroll
    for (int nt = 0; nt < 2; ++nt)
#pragma unroll
      for (int e = 0; e < 8; ++e) bn[nt][e] = (short)sx[(ks * 16 + hh * 8 + e) * SXP + 256 + grp * 64 + nt * 32 + c31];
#pragma unroll
    for (int pt = 0; pt < 2; ++pt) {
      float v[8];
#pragma unroll
      for (int e = 0; e < 8; ++e) v[e] = bf2f(sx[(ks * 16 + hh * 8 + e) * SXP + h * 64 + pt * 32 + c31]) * wgt[e];
      const bf16x8 a = pack8(v[0], v[1], v[2], v[3], v[4], v[5], v[6], v[7]);
#pragma unroll
      for (int nt = 0; nt < 2; ++nt) acc[pt][nt] = MFMA32(a, bn[nt], acc[pt][nt]);
    }
  }
  const int seq = (b * 2 + dir) * 4 + h, ci = blk_ci(cb, dir);
  u16* dst = (u16*)(P.ws + WS_SSD) + (size_t)(seq * NCH + ci) * 4096;
#pragma unroll
  for (int pt = 0; pt < 2; ++pt)
#pragma unroll
    for (int nt = 0; nt < 2; ++nt)
#pragma unroll
      for (int r = 0; r < 16; ++r) dst[(pt * 32 + crow(r, hh)) * 64 + nt * 32 + c31] = f2bf(acc[pt][nt][r]);
  if (lane == 0) ((float*)(P.ws + WS_SSDD))[seq * NCH + ci] = __expf(cl);
  __syncthreads();
}

DI void ssd_out(const Params& P, int l, int b, int cb, char* lds) {
  ssd_stage(P, l, b, cb, lds);
  const u16* sx = (const u16*)lds; float* xb = (float*)(lds + 66560); const float* scum = (const float*)(lds + 132352); const float* sdt = scum + 512; float* ssq = (float*)(lds + 136448);
  const int tid = tidx(), w = tid >> 6, lane = tid & 63, c31 = lane & 31, hh = lane >> 5, dir = w >> 2, h = w & 3, grp = h >> 1;
  const int seq = (b * 2 + dir) * 4 + h, ci = blk_ci(cb, dir), m0 = blk_m0(b, cb);
  const u16* Sin = (const u16*)(P.ws + WS_SSD) + (size_t)(seq * NCH + ci) * 4096;
  f32x16 y[2][2];
#pragma unroll
  for (int a = 0; a < 2; ++a)
#pragma unroll
    for (int bb = 0; bb < 2; ++bb)
#pragma unroll
      for (int r = 0; r < 16; ++r) y[a][bb][r] = 0.f;
#pragma unroll
  for (int lt = 0; lt < 2; ++lt) {
    const int tl = lt * 32 + c31;
    const float cuml = scum[(dir * 64 + tl) * 4 + h];
    const float ecl = __expf(cuml);
#pragma unroll
    for (int ks = 0; ks < 4; ++ks) {
      const uint4 cv = *(const uint4*)(sx + tl * SXP + 384 + grp * 64 + ks * 16 + hh * 8);
      const bf16x8 cmf = pack8(bflo(cv.x) * ecl, bfhi(cv.x) * ecl, bflo(cv.y) * ecl, bfhi(cv.y) * ecl, bflo(cv.z) * ecl, bfhi(cv.z) * ecl, bflo(cv.w) * ecl, bfhi(cv.w) * ecl);
#pragma unroll
      for (int pt = 0; pt < 2; ++pt) {
        const uint4 sraw = ld_nt((const uint4*)(Sin + (pt * 32 + c31) * 64 + ks * 16 + hh * 8)); const bf16x8 sa = mk8(sraw.x, sraw.y, sraw.z, sraw.w);
        y[pt][lt] = MFMA32(sa, cmf, y[pt][lt]);
      }
    }
#pragma unroll
    for (int st = 0; st < 2; ++st) {
      const bool skip = dir == 0 ? (st > lt) : (st < lt);
      if (skip) continue;
      f32x16 cbt;
#pragma unroll
      for (int r = 0; r < 16; ++r) cbt[r] = 0.f;
#pragma unroll
      for (int ks = 0; ks < 4; ++ks) {
        const bf16x8 bmf = *(const bf16x8*)(sx + (st * 32 + c31) * SXP + 256 + grp * 64 + ks * 16 + hh * 8);
        const bf16x8 cmf = *(const bf16x8*)(sx + tl * SXP + 384 + grp * 64 + ks * 16 + hh * 8);
        cbt = MFMA32(bmf, cmf, cbt);
      }
#pragma unroll
      for (int r = 0; r < 16; ++r) {
        const int s = st * 32 + crow(r, hh); const bool keep = dir == 0 ? (s <= tl) : (s >= tl);
        const float dec = __expf(fminf(cuml - scum[(dir * 64 + s) * 4 + h], 0.f)) * sdt[(dir * 64 + s) * 4 + h];
        cbt[r] = keep ? cbt[r] * dec : 0.f;
      }
      const bf16x8 p0 = pack8(cbt[0], cbt[1], cbt[2], cbt[3], cbt[4], cbt[5], cbt[6], cbt[7]), p1 = pack8(cbt[8], cbt[9], cbt[10], cbt[11], cbt[12], cbt[13], cbt[14], cbt[15]);
#pragma unroll
      for (int s2 = 0; s2 < 2; ++s2)
#pragma unroll
        for (int pt = 0; pt < 2; ++pt) {
          bf16x8 xa;
#pragma unroll
          for (int e = 0; e < 8; ++e) { const int s = st * 32 + 16 * s2 + 8 * (e >> 2) + 4 * hh + (e & 3); xa[e] = (short)sx[s * SXP + h * 64 + pt * 32 + c31]; }
          y[pt][lt] = MFMA32(xa, s2 ? p1 : p0, y[pt][lt]);
        }
    }
  }
  if (dir == 1) {
#pragma unroll
    for (int pt = 0; pt < 2; ++pt)
#pragma unroll
      for (int lt = 0; lt < 2; ++lt)
#pragma unroll
        for (int r = 0; r < 16; ++r) xb[(lt * 32 + c31) * 257 + h * 64 + pt * 32 + crow(r, hh)] = y[pt][lt][r];
  }
  __syncthreads();
  if (dir == 0) {
    const float dsk = P.ssd_d[l * 4 + h];
#pragma unroll
    for (int lt = 0; lt < 2; ++lt) {
      const int tl = lt * 32 + c31;
#pragma unroll
      for (int pt = 0; pt < 2; ++pt)
#pragma unroll
        for (int r = 0; r < 16; ++r) {
          const int p = pt * 32 + crow(r, hh);
          xb[tl * 257 + h * 64 + p] += y[pt][lt][r] + dsk * bf2f(sx[tl * SXP + h * 64 + p]);
        }
    }
  }
  __syncthreads();
  {
    const u16* U = (const u16*)(P.ws + WS_U); u16* Y = (u16*)(P.ws + WS_XN);
#pragma unroll
    for (int q = 0; q < 4; ++q) {
      const int idx = tid + q * NTHREADS, row = idx >> 5, ch0 = (idx & 31) * 8; const size_t m = (size_t)(m0 + row);
      const uint4 zv = ld_nt((const uint4*)(U + m * UP + UD_Z + ch0));
      const float zz[8] = {bflo(zv.x), bfhi(zv.x), bflo(zv.y), bfhi(zv.y), bflo(zv.z), bfhi(zv.z), bflo(zv.w), bfhi(zv.w)};
      float v[8]; float ss = 0.f;
#pragma unroll
      for (int e = 0; e < 8; ++e) { v[e] = xb[row * 257 + ch0 + e] * siluf(zz[e]); ss += v[e] * v[e]; }
      ss += shx(ss, 1); ss += shx(ss, 2); ss += shx(ss, 4); ss += shx(ss, 8); ss += shx(ss, 16);
      const float rstd = rsqrtf(ss * (1.f / 256.f) + 1e-6f);
      const float4 n0 = *(const float4*)(P.ssd_norm_w + l * 256 + ch0), n1 = *(const float4*)(P.ssd_norm_w + l * 256 + ch0 + 4);
      uint4 ov;
      ov.x = pk2(v[0] * rstd * n0.x, v[1] * rstd * n0.y); ov.y = pk2(v[2] * rstd * n0.z, v[3] * rstd * n0.w);
      ov.z = pk2(v[4] * rstd * n1.x, v[5] * rstd * n1.y); ov.w = pk2(v[6] * rstd * n1.z, v[7] * rstd * n1.w);
      *(uint4*)(Y + m * 1024 + 768 + ch0) = ov;
    }
  }
  __syncthreads();
}

constexpr int LXP = 264;
DI float neg_expm1f(float x) { return x > -0.01f ? -x * (1.f + x * (0.5f + x * (1.f / 6.f))) : 1.f - __expf(x); }

DI void lru_stage(const Params& P, int l, int b, int cb, char* lds) {
  u16* sxc = (u16*)lds;
  const int tid = tidx();
  const u16* U = (const u16*)(P.ws + WS_U);
  const int tseq0 = cb < 4 ? cb * 64 : (cb - 4) * 64, slen = cb < 4 ? 256 : T, mseq0 = cb < 4 ? MLAT + b * 256 : b * T;
  {
    const int ch0 = (tid & 31) * 8;
    float wt[4][8], bs[8];
    { const float4 b0 = *(const float4*)(P.lru_conv_b + l * 256 + ch0), b1 = *(const float4*)(P.lru_conv_b + l * 256 + ch0 + 4);
      bs[0] = b0.x; bs[1] = b0.y; bs[2] = b0.z; bs[3] = b0.w; bs[4] = b1.x; bs[5] = b1.y; bs[6] = b1.z; bs[7] = b1.w; }
#pragma unroll
    for (int j = 0; j < 4; ++j) {
      const float* wj = gp(P.lru_conv_w + (l * 4 + j) * 256 + ch0); const float4 w0 = *(const float4*)wj, w1 = *(const float4*)(wj + 4);
      wt[j][0] = w0.x; wt[j][1] = w0.y; wt[j][2] = w0.z; wt[j][3] = w0.w; wt[j][4] = w1.x; wt[j][5] = w1.y; wt[j][6] = w1.z; wt[j][7] = w1.w;
    }
#pragma unroll 2
    for (int t = tid >> 5; t < 64; t += 16) {
      float acc[8];
#pragma unroll
      for (int i = 0; i < 8; ++i) acc[i] = bs[i];
#pragma unroll
      for (int j = 0; j < 4; ++j) {
        const int ts = tseq0 + t - 2 + j;
        if (ts >= 0 && ts < slen) {
          const uint4 v = *(const uint4*)(U + (size_t)(mseq0 + ts) * UP + UB_X + ch0);
          acc[0] += bflo(v.x) * wt[j][0]; acc[1] += bfhi(v.x) * wt[j][1]; acc[2] += bflo(v.y) * wt[j][2]; acc[3] += bfhi(v.y) * wt[j][3];
          acc[4] += bflo(v.z) * wt[j][4]; acc[5] += bfhi(v.z) * wt[j][5]; acc[6] += bflo(v.w) * wt[j][6]; acc[7] += bfhi(v.w) * wt[j][7];
        }
      }
      uint4 o; o.x = pk2(acc[0], acc[1]); o.y = pk2(acc[2], acc[3]); o.z = pk2(acc[4], acc[5]); o.w = pk2(acc[6], acc[7]);
      *(uint4*)(sxc + t * LXP + ch0) = o;
    }
  }
  __syncthreads();
}

DI void lru_gates(const Params& P, int l, int dir, int g, int ct, const u16* sxc, f32x16 (&av)[2], f32x16 (&uv)[2]) {
  const int lane = tidx() & 63, c31 = lane & 31, hh = lane >> 5;
#pragma unroll
  for (int a = 0; a < 2; ++a)
#pragma unroll
    for (int r = 0; r < 16; ++r) { av[a][r] = 0.f; uv[a][r] = 0.f; }
  const u16* wfa_p = (const u16*)(P.ws + WS_LRUW) + (size_t)((((l * 2 + dir) * 4 + g) * 2 + 0) * 4096) + (ct * 64 + lane) * 8;
  const u16* wfx_p = wfa_p + 4096;
#pragma unroll
  for (int ks = 0; ks < 4; ++ks) {
    const bf16x8 wfa = *(const bf16x8*)(wfa_p + ks * 1024), wfx = *(const bf16x8*)(wfx_p + ks * 1024);
#pragma unroll
    for (int tt = 0; tt < 2; ++tt) {
      const bf16x8 xa = *(const bf16x8*)(sxc + (tt * 32 + c31) * LXP + g * 64 + ks * 16 + hh * 8);
      av[tt] = MFMA32(xa, wfa, av[tt]); uv[tt] = MFMA32(xa, wfx, uv[tt]);
    }
  }
  const int ch = g * 64 + ct * 32 + c31;
  const float ba = P.lru_ba[(l * 2 + dir) * 256 + ch], bx = P.lru_bx[(l * 2 + dir) * 256 + ch];
  const float sp = softplusf(-P.lru_lam[(l * 2 + dir) * 256 + ch]);
#pragma unroll
  for (int tt = 0; tt < 2; ++tt)
#pragma unroll
    for (int r = 0; r < 16; ++r) {
      const float rg = sigmf(av[tt][r] + ba), ig = sigmf(uv[tt][r] + bx);
      const float la = -8.f * rg * sp;
      const float xv = bf2f(sxc[(tt * 32 + crow(r, hh)) * LXP + ch]);
      av[tt][r] = __expf(la);
      uv[tt][r] = __builtin_amdgcn_sqrtf(neg_expm1f(2.f * la)) * ig * xv;
    }
}

template <int REV>
DI void lru_scan(f32x16 (&av)[2], f32x16 (&uv)[2], float& hc, float& ap) {
  const int hh = (tidx() & 63) >> 5;
  const bool first = (hh == (REV ? 1 : 0));
  ap = 1.f;
#pragma unroll
  for (int tti = 0; tti < 2; ++tti) {
    const int tt = REV ? 1 - tti : tti;
#pragma unroll
    for (int ii = 0; ii < 4; ++ii) {
      const int i = REV ? 3 - ii : ii;
      float GA = 1.f, GU = 0.f;
#pragma unroll
      for (int ee = 0; ee < 4; ++ee) { const int r = 4 * i + (REV ? 3 - ee : ee); GU = av[tt][r] * GU + uv[tt][r]; GA *= av[tt][r]; }
      const float PA = shx(GA, 32), PU = shx(GU, 32);
      float hcur = first ? hc : PA * hc + PU;
#pragma unroll
      for (int ee = 0; ee < 4; ++ee) { const int r = 4 * i + (REV ? 3 - ee : ee); hcur = av[tt][r] * hcur + uv[tt][r]; uv[tt][r] = hcur; }
      const float pairA = GA * PA, pairU = first ? PA * GU + PU : GA * PU + GU;
      hc = pairA * hc + pairU; ap *= pairA;
    }
  }
}

DI void lru_local(const Params& P, int l, int b, int cb, char* lds) {
  lru_stage(P, l, b, cb, lds);
  const int tid = tidx(), w = tid >> 6, lane = tid & 63, c31 = lane & 31, hh = lane >> 5, dir = w >> 2, g = w & 3;
  const int ci = blk_ci(cb, dir);
#pragma unroll 1
  for (int ct = 0; ct < 2; ++ct) {
    f32x16 av[2], uv[2];
    lru_gates(P, l, dir, g, ct, (const u16*)lds, av, uv);
    float hc = 0.f, ap;
    if (dir) lru_scan<1>(av, uv, hc, ap); else lru_scan<0>(av, uv, hc, ap);
    if (hh == 0) {
      const int ch = g * 64 + ct * 32 + c31;
      ((float*)(P.ws + WS_LRUA))[((b * 2 + dir) * NCH + ci) * 256 + ch] = ap;
      ((float*)(P.ws + WS_LRUU))[((b * 2 + dir) * NCH + ci) * 256 + ch] = hc;
    }
  }
  __syncthreads();
}

DI void lru_out(const Params& P, int l, int b, int cb, char* lds) {
  lru_stage(P, l, b, cb, lds);
  const int tid = tidx(), w = tid >> 6, lane = tid & 63, c31 = lane & 31, hh = lane >> 5, dir = w >> 2, g = w & 3;
  const int ci = blk_ci(cb, dir), m0 = blk_m0(b, cb);
  float* xb = (float*)(lds + 34816);
  f32x16 hres[2][2];
#pragma unroll
  for (int ct = 0; ct < 2; ++ct) {
    f32x16 av[2], uv[2];
    lru_gates(P, l, dir, g, ct, (const u16*)lds, av, uv);
    float hc = ((const float*)(P.ws + WS_LRUU))[((b * 2 + dir) * NCH + ci) * 256 + g * 64 + ct * 32 + c31], ap;
    if (dir) lru_scan<1>(av, uv, hc, ap); else lru_scan<0>(av, uv, hc, ap);
    if (dir == 1) {
#pragma unroll
      for (int tt = 0; tt < 2; ++tt)
#pragma unroll
        for (int r = 0; r < 16; ++r) xb[(tt * 32 + crow(r, hh)) * 257 + g * 64 + ct * 32 + c31] = uv[tt][r];
    }
    hres[ct][0] = uv[0]; hres[ct][1] = uv[1];
  }
  __syncthreads();
  if (dir == 0) {
#pragma unroll
    for (int ct = 0; ct < 2; ++ct)
#pragma unroll
      for (int tt = 0; tt < 2; ++tt)
#pragma unroll
        for (int r = 0; r < 16; ++r) xb[(tt * 32 + crow(r, hh)) * 257 + g * 64 + ct * 32 + c31] += hres[ct][tt][r];
  }
  __syncthreads();
  {
    const u16* U = (const u16*)(P.ws + WS_U); u16* Y = (u16*)(P.ws + WS_XN);
#pragma unroll
    for (int q = 0; q < 4; ++q) {
      const int idx = tid + q * NTHREADS, row = idx >> 5, ch0 = (idx & 31) * 8; const size_t m = (size_t)(m0 + row);
      const uint4 gv = ld_nt((const uint4*)(U + m * UP + UB_G + ch0));
      const float* xr = xb + row * 257 + ch0;
      uint4 ov;
      ov.x = pk2(xr[0] * siluf(bflo(gv.x)), xr[1] * siluf(bfhi(gv.x))); ov.y = pk2(xr[2] * siluf(bflo(gv.y)), xr[3] * siluf(bfhi(gv.y)));
      ov.z = pk2(xr[4] * siluf(bflo(gv.z)), xr[5] * siluf(bfhi(gv.z))); ov.w = pk2(xr[6] * siluf(bflo(gv.w)), xr[7] * siluf(bfhi(gv.w)));
      *(uint4*)(Y + m * 1024 + 256 + ch0) = ov;
    }
  }
  __syncthreads();
}

template <int PS, int DS>
DI void scan_bf16(u16* p, const float* d) {
  float s = 0.f;
  u16 ua[12], ub[12]; float da[12], db[12];
#pragma unroll
  for (int j = 0; j < 12; ++j) { ua[j] = p[(size_t)j * PS]; da[j] = d[j * DS]; }
#pragma unroll 1
  for (int g = 0; g < 11; g += 2) {
    if (g + 1 < 11) {
#pragma unroll
      for (int j = 0; j < 12; ++j) { ub[j] = p[(size_t)((g + 1) * 12 + j) * PS]; db[j] = d[((g + 1) * 12 + j) * DS]; }
    }
#pragma unroll
    for (int j = 0; j < 12; ++j) { p[(size_t)(g * 12 + j) * PS] = f2bf(s); s = da[j] * s + bf2f(ua[j]); }
    if (g + 2 < 11) {
#pragma unroll
      for (int j = 0; j < 12; ++j) { ua[j] = p[(size_t)((g + 2) * 12 + j) * PS]; da[j] = d[((g + 2) * 12 + j) * DS]; }
    }
    if (g + 1 < 11) {
#pragma unroll
      for (int j = 0; j < 12; ++j) { p[(size_t)((g + 1) * 12 + j) * PS] = f2bf(s); s = db[j] * s + bf2f(ub[j]); }
    }
  }
}

DI void phase_scans(const Params& P) {
  const int tid_ = tidx(); const int w = tid_ >> 6, lane = tid_ & 63;
  for (int unit = blockIdx.x + gridDim.x * w; unit < 1552; unit += gridDim.x * 8) {
    if (unit < 512) {
      const int item = unit * 64 + lane, seq = item >> 11, kv = item & 2047;
      scan_bf16<2048, 32>((u16*)(P.ws + WS_GLA) + (size_t)seq * NCH * 2048 + kv, (const float*)(P.ws + WS_GLAD) + seq * NCH * 32 + (kv >> 6));
    } else if (unit < 1536) {
      const int item = (unit - 512) * 64 + lane, seq = item >> 12, pn = item & 4095;
      scan_bf16<4096, 1>((u16*)(P.ws + WS_SSD) + (size_t)seq * NCH * 4096 + pn, (const float*)(P.ws + WS_SSDD) + seq * NCH);
    } else {
      const int item = (unit - 1536) * 64 + lane, bd = item >> 8, ch = item & 255;
      float* pu = (float*)(P.ws + WS_LRUU) + (size_t)bd * NCH * 256 + ch; const float* pa = (const float*)(P.ws + WS_LRUA) + (size_t)bd * NCH * 256 + ch;
      float s = 0.f;
      for (int c0 = 0; c0 < NCH; c0 += 12) {
        float uu[12], dd[12];
#pragma unroll
        for (int j = 0; j < 12; ++j) { uu[j] = pu[(c0 + j) * 256]; dd[j] = pa[(c0 + j) * 256]; }
#pragma unroll
        for (int j = 0; j < 12; ++j) { pu[(c0 + j) * 256] = s; s = dd[j] * s + uu[j]; }
      }
    }
  }
}

DI void attn_tile(const Params& P, int l, int b, int h, int qpos0, int key0, int ntile, float lam, float lam_init, char* lds) {
  const int tid = tidx(), w = tid >> 6, lane = tid & 63, c31 = lane & 31, hh = lane >> 5;
  const u16* Qg = (const u16*)(P.ws + WS_Q) + (size_t)((b * 4 + h) * 2) * NKEY * 32;
  const u16* Kg = (const u16*)(P.ws + WS_K) + (size_t)((b * 4 + h) * 2) * NKEY * 32;
  const u16* Vg = (const u16*)(P.ws + WS_VT) + (size_t)((b * 4 + h) * 64) * NKEY;
  const int qp = qpos0 + w * 32 + c31;
  bf16x8 qf[2][2]; float bq[2];
#pragma unroll
  for (int c = 0; c < 2; ++c)
#pragma unroll
    for (int ks = 0; ks < 2; ++ks) qf[c][ks] = *(const bf16x8*)(Qg + ((size_t)c * NKEY + qp) * 32 + ks * 16 + hh * 8);
#pragma unroll
  for (int c = 0; c < 2; ++c) {
    float s = 0.f;
#pragma unroll
    for (int ks = 0; ks < 2; ++ks)
#pragma unroll
      for (int e = 0; e < 8; ++e) { const float v = bf2f((u16)qf[c][ks][e]); s += v * v; }
    s += shx(s, 32);
    const float km = ((const float*)(P.ws + WS_MISC))[((l * 2 + b) * 4 + h) * 2 + c];
    bq[c] = sqrtf(s * km) * 1.002f + 1e-3f;
  }
  u16* sK = (u16*)lds; u16* sV = (u16*)(lds + 20480);
  const int kc = tid >> 8, kr = (tid >> 2) & 63, kpart = tid & 3, vdv = tid >> 3, vpart = tid & 7;
  const u16* kp = Kg + ((size_t)kc * NKEY + key0 + kr) * 32 + kpart * 8;
  const u16* vp = Vg + (size_t)vdv * NKEY + key0 + vpart * 8;
  uint4 rk = *(const uint4*)kp, rv = *(const uint4*)vp;
  *(uint4*)(sK + (kc * 64 + kr) * 40 + kpart * 8) = rk; *(uint4*)(sV + vdv * 72 + vpart * 8) = rv;
  __syncthreads();
  f32x16 O[2][2]; float ls[2] = {0.f, 0.f};
#pragma unroll
  for (int a = 0; a < 2; ++a)
#pragma unroll
    for (int bb = 0; bb < 2; ++bb)
#pragma unroll
      for (int r = 0; r < 16; ++r) O[a][bb][r] = 0.f;
  if (__builtin_amdgcn_readfirstlane(tid) >= 256) __builtin_amdgcn_s_setprio(1);
#pragma unroll 1
  for (int kt = 0; kt < ntile; ++kt) {
    const int cur = kt & 1;
    if (kt + 1 < ntile) { rk = *(const uint4*)(kp + (size_t)(kt + 1) * 2048); rv = *(const uint4*)(vp + (kt + 1) * 64); }
    const u16* cK = sK + cur * 5120; const u16* cV = sV + cur * 4608;
#pragma unroll
    for (int kt2 = 0; kt2 < 2; ++kt2) {
      const bf16x8 ka0 = *(const bf16x8*)(cK + (kt2 * 32 + c31) * 40 + hh * 8), ka1 = *(const bf16x8*)(cK + (kt2 * 32 + c31) * 40 + 16 + hh * 8);
      const bf16x8 kb0 = *(const bf16x8*)(cK + (64 + kt2 * 32 + c31) * 40 + hh * 8), kb1 = *(const bf16x8*)(cK + (64 + kt2 * 32 + c31) * 40 + 16 + hh * 8);
      f32x16 Sa, Sb;
#pragma unroll
      for (int r = 0; r < 16; ++r) { Sa[r] = -bq[0]; Sb[r] = -bq[1]; }
      Sa = MFMA32(ka0, qf[0][0], Sa); Sb = MFMA32(kb0, qf[1][0], Sb);
      Sa = MFMA32(ka1, qf[0][1], Sa); Sb = MFMA32(kb1, qf[1][1], Sb);
      const bf16x8 v00 = *(const bf16x8*)(cV + (c31) * 72 + (kt2 * 2) * 16 + hh * 8), v01 = *(const bf16x8*)(cV + (c31) * 72 + (kt2 * 2 + 1) * 16 + hh * 8);
      const bf16x8 v10 = *(const bf16x8*)(cV + (32 + c31) * 72 + (kt2 * 2) * 16 + hh * 8), v11 = *(const bf16x8*)(cV + (32 + c31) * 72 + (kt2 * 2 + 1) * 16 + hh * 8);
      {
        float p[16];
#pragma unroll
        for (int r = 0; r < 16; ++r) { p[r] = __builtin_amdgcn_exp2f(Sa[r]); ls[0] += p[r]; }
        const bf16x8 p0 = pack8(p[0], p[1], p[2], p[3], p[4], p[5], p[6], p[7]), p1 = pack8(p[8], p[9], p[10], p[11], p[12], p[13], p[14], p[15]);
        O[0][0] = MFMA32(v00, p0, O[0][0]); O[0][1] = MFMA32(v10, p0, O[0][1]);
        O[0][0] = MFMA32(v01, p1, O[0][0]); O[0][1] = MFMA32(v11, p1, O[0][1]);
      }
      {
        float p[16];
#pragma unroll
        for (int r = 0; r < 16; ++r) { p[r] = __builtin_amdgcn_exp2f(Sb[r]); ls[1] += p[r]; }
        const bf16x8 p0 = pack8(p[0], p[1], p[2], p[3], p[4], p[5], p[6], p[7]), p1 = pack8(p[8], p[9], p[10], p[11], p[12], p[13], p[14], p[15]);
        O[1][0] = MFMA32(v00, p0, O[1][0]); O[1][1] = MFMA32(v10, p0, O[1][1]);
        O[1][0] = MFMA32(v01, p1, O[1][0]); O[1][1] = MFMA32(v11, p1, O[1][1]);
      }
    }
    if (kt + 1 < ntile) { *(uint4*)(sK + (cur ^ 1) * 5120 + (kc * 64 + kr) * 40 + kpart * 8) = rk; *(uint4*)(sV + (cur ^ 1) * 4608 + vdv * 72 + vpart * 8) = rv; }
    __syncthreads();
  }
  __builtin_amdgcn_s_setprio(0);
  ls[0] += shx(ls[0], 32); ls[1] += shx(ls[1], 32);
  const float i0 = 1.f / ls[0], i1 = lam / ls[1];
  float ss = 0.f;
#pragma unroll
  for (int dt = 0; dt < 2; ++dt)
#pragma unroll
    for (int r = 0; r < 16; ++r) { const float o = O[0][dt][r] * i0 - O[1][dt][r] * i1; O[0][dt][r] = o; ss += o * o; }
  ss += shx(ss, 32);
  const float rstd = rsqrtf(ss * (1.f / 64.f) + 1e-6f) * (1.f - lam_init);
  const size_t m = (qpos0 < 8192) ? (size_t)(b * T + qp) : (size_t)(MLAT + b * 256 + (qp - 8192));
  const u16* U = (const u16*)(P.ws + WS_U); u16* Y = (u16*)(P.ws + WS_XN);
#pragma unroll
  for (int dt = 0; dt < 2; ++dt)
#pragma unroll
    for (int q4 = 0; q4 < 4; ++q4) {
      const int d0 = dt * 32 + 8 * q4 + 4 * hh;
      const uint2 gv = *(const uint2*)(U + m * UP + UC_G + h * 64 + d0);
      const float4 nw = *(const float4*)(P.diff_subln_w + l * 64 + d0);
      const float y0 = O[0][dt][4 * q4 + 0] * rstd * nw.x * siluf(bflo(gv.x)), y1 = O[0][dt][4 * q4 + 1] * rstd * nw.y * siluf(bfhi(gv.x));
      const float y2 = O[0][dt][4 * q4 + 2] * rstd * nw.z * siluf(bflo(gv.y)), y3 = O[0][dt][4 * q4 + 3] * rstd * nw.w * siluf(bfhi(gv.y));
      uint2 ov; ov.x = pk2(y0, y1); ov.y = pk2(y2, y3);
      *(uint2*)(Y + m * 1024 + 512 + h * 64 + d0) = ov;
    }
  __syncthreads();
}

DI void phase_attn(const Params& P, int l, char* lds, int lo, int hi, int shift) {
  const int lane = tidx() & 63;
  const float lam_init = 0.8f - 0.6f * __expf(-0.3f * (float)l);
  float a = 0.f, bsum = 0.f;
  if (lane < 32) { const float* lv = gp(P.diff_lam + l * 128); a = lv[lane] * lv[32 + lane]; bsum = lv[64 + lane] * lv[96 + lane]; }
#pragma unroll
  for (int s = 32; s >= 1; s >>= 1) { a += shx(a, s); bsum += shx(bsum, s); }
  const float lam = __expf(a) - __expf(bsum) + lam_init;
  int first = (int)blockIdx.x + shift; first = first >= (int)gridDim.x ? first - (int)gridDim.x : first;
  for (int id0 = lo + first; id0 < hi; id0 += gridDim.x) {
    int tb, th, tq0, tk0, tn;
    if (id0 < 256) {
      const int id = (gridDim.x == 256) ? ((id0 & 7) * 32 + (id0 >> 3)) : id0;
      tb = id >> 7; th = (id >> 5) & 3; tq0 = (id & 31) * 256; tk0 = 0; tn = 132;
    } else {
      const int id = id0 - 256;
      tb = id >> 2; th = id & 3; tq0 = 8192; tk0 = 8192; tn = 4;
    }
    attn_tile(P, l, tb, th, tq0, tk0, tn, lam, lam_init, lds);
  }
}

#define XB_TMO      128
#define XB_XCNT(j)  (256  + 64 * (j))
#define XB_XSUB(j)  (1280 + 64 * (j))
#define XB_XGEN(j)  (2304 + 64 * (j))
#define XB_TOP      3328
#define XB_TOPGEN   3392
#define XCD_BAR_WORDS 3456
#define XB_SPIN_CAP (1u << 18)
#define LAS __attribute__((address_space(3)))
DI unsigned xb_ld(unsigned* p) { return __hip_atomic_load(p, __ATOMIC_RELAXED, __HIP_MEMORY_SCOPE_AGENT); }
DI unsigned xb_add(unsigned* p, unsigned v) { return __hip_atomic_fetch_add(p, v, __ATOMIC_RELAXED, __HIP_MEMORY_SCOPE_AGENT); }
DI unsigned xb_xcc_id() { return (unsigned)__builtin_amdgcn_s_getreg((3 << 11) | 20) & 0xFu; }
#define XB_SPIN(cond, bar) do { unsigned _sp = 0; while (cond) { __builtin_amdgcn_s_sleep(1); \
    if ((++_sp & 255u) == 0u) { if (xb_ld(&(bar)[XB_TMO])) break; if (_sp > XB_SPIN_CAP) { atomicAdd(&(bar)[XB_TMO], 1u); break; } } } } while (0)
struct XcdBarrier { unsigned* bar; unsigned x; volatile LAS unsigned* st; };
DI XcdBarrier xcd_barrier_post(unsigned* bar, volatile LAS unsigned* st) {
  XcdBarrier b; b.bar = bar; b.x = xb_xcc_id(); b.st = st;
  if (threadIdx.x == 0) (void)xb_add(&bar[XB_XCNT(b.x)], 1u);
  return b;
}
DI void xcd_barrier_complete(unsigned* bar, unsigned x, unsigned& nloc, unsigned& nx) {
  const unsigned G = gridDim.x * gridDim.y * gridDim.z;
  unsigned sum, cnt, mine, sp = 0u;
  for (;;) {
    sum = 0u; cnt = 0u; mine = 0u;
#pragma unroll
    for (unsigned j = 0; j < 16; ++j) { const unsigned c = xb_ld(&bar[XB_XCNT(j)]); sum += c; cnt += (c > 0u) ? 1u : 0u; mine = (j == x) ? c : mine; }
    if (sum == G) break;
    __builtin_amdgcn_s_sleep(1);
    if ((++sp & 255u) == 0u) { if (xb_ld(&bar[XB_TMO])) break; if (sp > XB_SPIN_CAP) { atomicAdd(&bar[XB_TMO], 1u); break; } }
  }
  nloc = mine > 0u ? mine : 1u; nx = cnt > 0u ? cnt : 1u;
}
DI void xcd_barrier(const XcdBarrier& b) {
  asm volatile("s_waitcnt vmcnt(0)" ::: "memory");
  __syncthreads();
  if (threadIdx.x == 0) {
    unsigned* bar = b.bar;
    __builtin_amdgcn_s_waitcnt(0);
    unsigned nloc = b.st[0], nx = b.st[1];
    if (nloc == 0u) { xcd_barrier_complete(bar, b.x, nloc, nx); b.st[0] = nloc; b.st[1] = nx; }
    const unsigned old = xb_add(&bar[XB_XSUB(b.x)], 1u);
    const unsigned gen = old / nloc;
    if (old + 1u == (gen + 1u) * nloc) {
      __builtin_amdgcn_fence(__ATOMIC_RELEASE, "agent");
      asm volatile("s_waitcnt vmcnt(0)" ::: "memory");
      const unsigned og = xb_add(&bar[XB_TOP], 1u);
      const unsigned tg = og / nx;
      if (og + 1u == (tg + 1u) * nx) xb_add(&bar[XB_TOPGEN], 1u);
      else XB_SPIN(xb_ld(&bar[XB_TOPGEN]) == tg, bar);
      __builtin_amdgcn_fence(__ATOMIC_ACQUIRE, "agent");
      xb_add(&bar[XB_XGEN(b.x)], 1u);
      asm volatile("s_waitcnt vmcnt(0)" ::: "memory");
    } else {
      XB_SPIN(xb_ld(&bar[XB_XGEN(b.x)]) == gen, bar);
      __builtin_amdgcn_fence(__ATOMIC_ACQUIRE, "agent");
      asm volatile("s_waitcnt vmcnt(0)" ::: "memory");
    }
  }
  __syncthreads();
}

__global__ void __launch_bounds__(NTHREADS) fwd_megakernel(Params Parg) {
  extern __shared__ __attribute__((aligned(16))) char lds[];
  __shared__ Params sP;
  __shared__ uint4 xb_words;
  if (threadIdx.x == 0) { sP = Parg; xb_words = make_uint4(0u, 0u, 0u, 0u); }
  __syncthreads();
  const Params& P = sP;
  cg::grid_group grid = cg::this_grid();
  if (blockDim.x == 12345u) grid.sync();
  (void)xcd_barrier_post((unsigned*)(Parg.ws + WS_BAR), (volatile LAS unsigned*)&xb_words);
#define GRID_BAR() do { XcdBarrier xb_; xb_.bar = (unsigned*)(P.ws + WS_BAR); xb_.x = xb_xcc_id(); xb_.st = (volatile LAS unsigned*)&xb_words; xcd_barrier(xb_); } while (0)
  MARK(0); phase_p0(P, lds);
  GRID_BAR();
#pragma unroll 1
  for (int l = 0; l < 2; ++l) {
    MARK(1); phase_norm(P, l);
    GRID_BAR(); MARK(2);
    gemm_phase<0>(P, l, (const u16*)(P.ws + WS_XN), (const u16*)(P.ws + WS_WINT) + (size_t)l * UP * 1024, 66, 25, lds);
    GRID_BAR();
    MARK(3);
    for (int t = blockIdx.x; t < 1056; t += gridDim.x) {
      const int ty = t / 264, idx = t % 264, b = idx / 132, cb = idx % 132;
      if (ty == 0) ssd_local(P, l, b, cb, lds);
      else if (ty == 1) lru_local(P, l, b, cb, lds);
      else if (ty == 2) gla_local(P, l, b, cb, lds);
      else attn_prep(P, l, idx, lds);
    }
    GRID_BAR();
    MARK(4); phase_scans(P);
    MARK(5); phase_attn(P, l, lds, 0, 256, 0); MARK(6);
    GRID_BAR();
    if (l == 0) phase_attn(P, l, lds, 256, 264, 8);
    {
      const int per = (l == 0) ? 264 : 256;
      for (int t = blockIdx.x; t < 3 * per; t += gridDim.x) {
        const int ty = t / per, idx = t % per;
        const int b = (l == 0) ? idx / 132 : (idx >> 7), cb = (l == 0) ? idx % 132 : 4 + (idx & 127);
        if (ty == 0) ssd_out(P, l, b, cb, lds);
        else if (ty == 1) lru_out(P, l, b, cb, lds);
        else gla_out(P, l, b, cb, lds);
      }
    }
    GRID_BAR();
    MARK(7); gemm_phase<1>(P, l, (const u16*)(P.ws + WS_XN), (const u16*)(P.ws + WS_WOUT) + (size_t)l * 1024 * 1024, l == 0 ? 66 : 64, 8, lds);
    GRID_BAR();
  }
  MARK(8); phase_final_norm(P);
}

extern "C" void kernel_launch(void* const* d_in, const int* in_sizes, int n_in, void* d_out, int out_size, void* d_ws, size_t ws_size, hipStream_t stream) {
  static int grid_blocks = 0;
  if (!grid_blocks) {
    int dev = 0, cus = 0, per_cu = 0;
    hipGetDevice(&dev);
    hipDeviceGetAttribute(&cus, hipDeviceAttributeMultiprocessorCount, dev);
    hipFuncSetAttribute((const void*)fwd_megakernel, hipFuncAttributeMaxDynamicSharedMemorySize, LDS_BYTES);
    hipOccupancyMaxActiveBlocksPerMultiprocessor(&per_cu, (const void*)fwd_megakernel, NTHREADS, LDS_BYTES);
    if (per_cu < 1) { fprintf(stderr, "occupancy query returned %d\n", per_cu); per_cu = 1; }
    if (per_cu > 1) per_cu = 1;
    grid_blocks = cus * per_cu;
  }
  Params p{};
  const float** pf = (const float**)&p;
  for (int i = 0; i < 28; ++i) pf[i] = (const float*)d_in[i];
  pf[28] = (const float*)d_out; pf[29] = (const float*)d_ws;
  hipMemsetAsync((char*)d_ws + WS_BAR, 0, XCD_BAR_WORDS * 4, stream);
  void* args[] = {&p};
  hipError_t e = hipLaunchCooperativeKernel((const void*)fwd_megakernel, dim3(grid_blocks), dim3(NTHREADS), args, LDS_BYTES, stream);
  if (e != hipSuccess) fprintf(stderr, "cooperative launch failed: %s (grid %d)\n", hipGetErrorString(e), grid_blocks);
}
```
